# Optimizing an MI355X kernel written in HIP

```python
import jax
import jax.numpy as jnp
from jax import lax
import numpy as np

D_MODEL = 2048
BATCH = 16
SEQ = 256
DEPTH = 4
DEC_BATCH = 8
DEC_SEQ = 1024
PAST_LEN = 512

GRID_W = 64
N_EVEN = (DEPTH + 1) // 2
N_ODD = DEPTH // 2
N_MOD = 9
D_FF = 5632
EPS = 1e-6
Q_BLOCK = 128
ROPE_THETA = 10000.0

LRU_W = D_MODEL // 2
LRU_BLOCKS = 16
LRU_BW = LRU_W // LRU_BLOCKS
CONV_W = 4
LRU_C = 8.0
NA_HEADS = 16
NA_DH = 64
NA_W = NA_HEADS * NA_DH
NA_KR = 8
NA_KC = 16
GQA_HEADS = 16
GQA_KV_HEADS = 4
GQA_DH = 64
GQA_GROUP = GQA_HEADS // GQA_KV_HEADS
GQA_Q_W = GQA_HEADS * GQA_DH
GQA_KV_W = GQA_KV_HEADS * GQA_DH
MLA_HEADS = 8
MLA_Q_RANK = 512
MLA_KV_RANK = 512
MLA_NOPE = 128
MLA_ROPE = 64
MLA_V = 128
MLA_QK = MLA_NOPE + MLA_ROPE

AB_IN = 2 * LRU_W + 3 * NA_W
AB_OUT = LRU_W + NA_W
CD_IN = GQA_Q_W + 2 * GQA_KV_W + MLA_Q_RANK + MLA_KV_RANK + MLA_ROPE
CD_OUT = GQA_Q_W + MLA_HEADS * MLA_V

kernel_name = 'hybrid_diffusion_trunk_ctx_and_denoise_step'


def rmsnorm(x, gain):
    xf = x.astype(jnp.float32)
    y = xf * lax.rsqrt(jnp.mean(xf * xf, axis=-1, keepdims=True) + EPS)
    return (y * gain.astype(jnp.float32)).astype(x.dtype)


def adaln(x, gain, shift, scale):
    return rmsnorm(x, gain) * (1 + scale) + shift


def modulation(cond, w_mod, b_mod):
    m = jax.nn.silu(cond) @ w_mod + b_mod
    m = m.reshape(cond.shape[0], 1, N_MOD, D_MODEL)
    return tuple(m[:, :, j] for j in range(N_MOD))


def swiglu(h, w_in, w_out):
    g, u = jnp.split(h @ w_in, 2, axis=-1)
    return (jax.nn.silu(g) * u) @ w_out


def axial_rope(x):
    seq_len, dim = x.shape[1], x.shape[-1]
    half = dim // 2
    nf = half // 2
    t = jnp.arange(seq_len)
    inv_freq = 1.0 / (ROPE_THETA ** (jnp.arange(nf, dtype=jnp.float32) / nf))

    def rotate(xs, pos):
        ang = pos.astype(jnp.float32)[:, None] * inv_freq[None, :]
        cos = jnp.cos(ang)[None, :, None, :]
        sin = jnp.sin(ang)[None, :, None, :]
        xf = xs.astype(jnp.float32)
        x1, x2 = xf[..., :nf], xf[..., nf:]
        return jnp.concatenate([x1 * cos - x2 * sin, x2 * cos + x1 * sin], axis=-1)

    out = jnp.concatenate([rotate(x[..., :half], t // GRID_W), rotate(x[..., half:], t % GRID_W)], axis=-1)
    return out.astype(x.dtype)


def block_attention(q, k, v, scale):
    b, lq, hk, g, dq = q.shape
    nb = lq // Q_BLOCK
    qb = q.reshape(b, nb, Q_BLOCK, hk, g, dq).transpose(1, 0, 2, 3, 4, 5)

    def one_block(qblk):
        s = jnp.einsum('bqhgd,bkhd->bhgqk', qblk, k).astype(jnp.float32) * scale
        p = jax.nn.softmax(s, axis=-1).astype(v.dtype)
        return jnp.einsum('bhgqk,bkhd->bqhgd', p, v)

    o = lax.map(one_block, qb)
    return o.transpose(1, 0, 2, 3, 4, 5).reshape(b, lq, hk * g * v.shape[-1])


def centred_dwconv(x, w, b):
    seq_len = x.shape[1]
    left = CONV_W // 2
    xp = jnp.pad(x, ((0, 0), (left, CONV_W - 1 - left), (0, 0)))
    y = b
    for j in range(CONV_W):
        y = y + xp[:, j:j + seq_len] * w[j]
    return y


def rglru(xc, h0, wa, ba, wx, bx, lam, reverse):
    b, l, _ = xc.shape
    xb = xc.reshape(b, l, LRU_BLOCKS, LRU_BW)
    r = jax.nn.sigmoid(jnp.einsum('blni,nij->blnj', xb, wa).reshape(b, l, LRU_W) + ba)
    gi = jax.nn.sigmoid(jnp.einsum('blni,nij->blnj', xb, wx).reshape(b, l, LRU_W) + bx)
    log_a = -LRU_C * r.astype(jnp.float32) * jax.nn.softplus(-lam.astype(jnp.float32))
    a = jnp.exp(log_a)
    u = jnp.sqrt(-jnp.expm1(2.0 * log_a)) * (gi * xc).astype(jnp.float32)

    def combine(left, right):
        return (left[0] * right[0], right[0] * left[1] + right[1])

    a_cum, u_cum = lax.associative_scan(combine, (a, u), axis=1, reverse=reverse)
    h = a_cum * h0.astype(jnp.float32)[:, None, :] + u_cum
    last = h[:, 0] if reverse else h[:, -1]
    return h.astype(xc.dtype), last.astype(xc.dtype)


def lru_mixer(xa, ga, h0f, h0b, lp):
    xc = centred_dwconv(xa, lp['conv_w'], lp['conv_b'])
    hf, lf = rglru(xc, h0f, lp['wa'][0], lp['ba'][0], lp['wx'][0], lp['bx'][0], lp['lam'][0], False)
    hb, lb = rglru(xc, h0b, lp['wa'][1], lp['ba'][1], lp['wx'][1], lp['bx'][1], lp['lam'][1], True)
    return (hf + hb) * jax.nn.gelu(ga), lf, lb


def neighbourhood_attention(q, k, v, k_ctx, v_ctx, bias_tab):
    b, l, h, dh = q.shape
    rows_n = l // GRID_W
    kr = min(NA_KR, rows_n)
    scale = dh ** -0.5
    rows = jnp.arange(rows_n)
    r_start = jnp.clip(rows - kr // 2, 0, rows_n - kr)
    row_idx = r_start[:, None] + jnp.arange(kr)[None, :]
    qg = q.reshape(b, rows_n, GRID_W, h, dh)
    kg = k.reshape(b, rows_n, GRID_W, h, dh)[:, row_idx]
    vg = v.reshape(b, rows_n, GRID_W, h, dh)[:, row_idx]
    cols = jnp.arange(GRID_W)
    c_start = jnp.clip(cols - NA_KC // 2, 0, GRID_W - NA_KC)
    col_ok = (cols[None, :] >= c_start[:, None]) & (cols[None, :] < c_start[:, None] + NA_KC)
    rel_r = row_idx - rows[:, None] + (NA_KR - 1)
    rel_c = jnp.clip(cols[None, :] - cols[:, None] + (NA_KC - 1), 0, 2 * NA_KC - 2)
    bias = bias_tab[:, rel_r[:, None, :, None], rel_c[None, :, None, :]].astype(jnp.float32)
    s_loc = jnp.einsum('brqhd,brikhd->bhrqik', qg, kg).astype(jnp.float32) * scale + bias[None]
    s_loc = jnp.where(col_ok[None, None, None, :, None, :], s_loc, -jnp.inf)
    s_loc = s_loc.reshape(b, h, rows_n, GRID_W, kr * GRID_W)
    s_ctx = jnp.einsum('brqhd,bchd->bhrqc', qg, k_ctx).astype(jnp.float32) * scale
    p = jax.nn.softmax(jnp.concatenate([s_loc, s_ctx], axis=-1), axis=-1).astype(v.dtype)
    p_loc = p[..., :kr * GRID_W].reshape(b, h, rows_n, GRID_W, kr, GRID_W)
    p_ctx = p[..., kr * GRID_W:]
    o = jnp.einsum('bhrqik,brikhd->brqhd', p_loc, vg) + jnp.einsum('bhrqc,bchd->brqhd', p_ctx, v_ctx)
    return o.reshape(b, l, h * dh)


def ab_split(h, w_in):
    b, l, _ = h.shape
    xa, ga, q, k, v = jnp.split(h @ w_in, [LRU_W, 2 * LRU_W, 2 * LRU_W + NA_W, 2 * LRU_W + 2 * NA_W], axis=-1)
    return (xa, ga, q.reshape(b, l, NA_HEADS, NA_DH), k.reshape(b, l, NA_HEADS, NA_DH),
            v.reshape(b, l, NA_HEADS, NA_DH))


def ab_context(h, lp):
    xa, ga, q, k, v = ab_split(h, lp['w_in'])
    zeros = jnp.zeros((h.shape[0], LRU_W), h.dtype)
    ya, sf, sb = lru_mixer(xa, ga, zeros, zeros, lp)
    yb = block_attention(q[:, :, :, None], k, v, NA_DH ** -0.5)
    y = jnp.concatenate([ya, yb], axis=-1) @ lp['w_out']
    return y, (sf, sb, k, v)


def ab_latent(h, lp, sf, sb, k_ctx, v_ctx):
    xa, ga, q, k, v = ab_split(h, lp['w_in'])
    ya, _, _ = lru_mixer(xa, ga, sf, sb, lp)
    yb = neighbourhood_attention(q, k, v, k_ctx, v_ctx, lp['na_bias'])
    return jnp.concatenate([ya, yb], axis=-1) @ lp['w_out'], None


def cd_split(h, lp):
    b, l, _ = h.shape
    idx = [GQA_Q_W, GQA_Q_W + GQA_KV_W, GQA_Q_W + 2 * GQA_KV_W, GQA_Q_W + 2 * GQA_KV_W + MLA_Q_RANK,
           GQA_Q_W + 2 * GQA_KV_W + MLA_Q_RANK + MLA_KV_RANK]
    qc, kc, vc, qa, ckv, kr = jnp.split(h @ lp['w_in'], idx, axis=-1)
    qc = rmsnorm(qc.reshape(b, l, GQA_HEADS, GQA_DH), lp['q_gain'])
    kc = rmsnorm(kc.reshape(b, l, GQA_KV_HEADS, GQA_DH), lp['k_gain'])
    vc = vc.reshape(b, l, GQA_KV_HEADS, GQA_DH)
    qd = (rmsnorm(qa, lp['mla_q_gain']) @ lp['w_uq']).reshape(b, l, MLA_HEADS, MLA_QK)
    ckv = rmsnorm(ckv, lp['mla_kv_gain'])
    return qc, kc, vc, qd, ckv, kr


def mla_kv(ckv, kr, lp):
    b, l, _ = ckv.shape
    k_nope = (ckv @ lp['w_uk']).reshape(b, l, MLA_HEADS, MLA_NOPE)
    v = (ckv @ lp['w_uv']).reshape(b, l, MLA_HEADS, MLA_V)
    k = jnp.concatenate([k_nope, jnp.broadcast_to(kr[:, :, None, :], (b, l, MLA_HEADS, MLA_ROPE))], axis=-1)
    return k, v


def cd_context(h, lp):
    qc, kc, vc, qd, ckv, kr = cd_split(h, lp)
    b, l = h.shape[0], h.shape[1]
    yc = block_attention(qc.reshape(b, l, GQA_KV_HEADS, GQA_GROUP, GQA_DH), kc, vc, GQA_DH ** -0.5)
    kd, vd = mla_kv(ckv, kr, lp)
    yd = block_attention(qd[:, :, :, None], kd, vd, MLA_QK ** -0.5)
    y = jnp.concatenate([yc, yd], axis=-1) @ lp['w_out']
    return y, (kc, vc, ckv, kr)


def cd_latent(h, lp, kc_ctx, vc_ctx, ckv_ctx, kr_ctx):
    qc, kc, vc, qd, ckv, kr = cd_split(h, lp)
    b, l = h.shape[0], h.shape[1]
    qc = axial_rope(qc)
    kc = axial_rope(kc)
    qd = jnp.concatenate([qd[..., :MLA_NOPE], axial_rope(qd[..., MLA_NOPE:])], axis=-1)
    kr = axial_rope(kr[:, :, None, :])[:, :, 0]
    k_all = jnp.concatenate([kc, kc_ctx], axis=1)
    v_all = jnp.concatenate([vc, vc_ctx], axis=1)
    yc = block_attention(qc.reshape(b, l, GQA_KV_HEADS, GQA_GROUP, GQA_DH), k_all, v_all, GQA_DH ** -0.5)
    kd, vd = mla_kv(jnp.concatenate([ckv, ckv_ctx], axis=1), jnp.concatenate([kr, kr_ctx], axis=1), lp)
    yd = block_attention(qd[:, :, :, None], kd, vd, MLA_QK ** -0.5)
    return jnp.concatenate([yc, yd], axis=-1) @ lp['w_out'], None


def trunk_layer(x, mods, gains, ffn_in, ffn_out, mixer):
    sh1, sc1, g1, sh2, sc2, g2, sh3, sc3, g3 = mods
    x = x + 0.5 * g1 * swiglu(adaln(x, gains[0], sh1, sc1), ffn_in[0], ffn_out[0])
    y, ctx_tensors = mixer(adaln(x, gains[1], sh2, sc2))
    x = x + g2 * y
    x = x + 0.5 * g3 * swiglu(adaln(x, gains[2], sh3, sc3), ffn_in[1], ffn_out[1])
    return x, ctx_tensors


def setup_inputs(seed: int = 0) -> dict:
    key = jax.random.key(seed)
    keys = jax.random.split(key, 64)
    counter = [0]

    def nxt():
        k = keys[counter[0]]
        counter[0] += 1
        return k

    def nrm(shape, std):
        return jax.random.normal(nxt(), shape, jnp.float32) * std

    def gain(shape):
        return 1.0 + nrm(shape, 0.05)

    u = jax.random.uniform(nxt(), (N_EVEN, 2, LRU_W), jnp.float32, 0.9, 0.999)
    base = u ** (1.0 / LRU_C)
    lru_lambda = jnp.log(base) - jnp.log1p(-base)
    return {
        'x_prompt': nrm((BATCH, SEQ, D_MODEL), 1.0),
        'x_sample': nrm((DEC_BATCH, DEC_SEQ, D_MODEL), 1.0),
        'state_lru_fwd': nrm((DEC_BATCH, N_EVEN, LRU_W), 0.5),
        'state_lru_bwd': nrm((DEC_BATCH, N_EVEN, LRU_W), 0.5),
        'cache_na_k': nrm((DEC_BATCH, N_EVEN, PAST_LEN, NA_HEADS, NA_DH), 1.0),
        'cache_na_v': nrm((DEC_BATCH, N_EVEN, PAST_LEN, NA_HEADS, NA_DH), 1.0),
        'cache_gqa_k': nrm((DEC_BATCH, N_ODD, PAST_LEN, GQA_KV_HEADS, GQA_DH), 1.0),
        'cache_gqa_v': nrm((DEC_BATCH, N_ODD, PAST_LEN, GQA_KV_HEADS, GQA_DH), 1.0),
        'cache_mla_ckv': nrm((DEC_BATCH, N_ODD, PAST_LEN, MLA_KV_RANK), 1.0),
        'cache_mla_krope': nrm((DEC_BATCH, N_ODD, PAST_LEN, MLA_ROPE), 1.0),
        'c': nrm((DEC_BATCH, D_MODEL), 1.0),
        'c_ctx': nrm((D_MODEL,), 1.0),
        'w_mod': nrm((DEPTH, D_MODEL, N_MOD * D_MODEL), 0.5 * D_MODEL ** -0.5),
        'b_mod': nrm((DEPTH, N_MOD * D_MODEL), 0.02),
        'norm_gain': gain((DEPTH, 3, D_MODEL)),
        'w_ffn_in': nrm((DEPTH, 2, D_MODEL, 2 * D_FF), D_MODEL ** -0.5),
        'w_ffn_out': nrm((DEPTH, 2, D_FF, D_MODEL), D_FF ** -0.5),
        'w_in_ab': nrm((N_EVEN, D_MODEL, AB_IN), D_MODEL ** -0.5),
        'conv_w': nrm((N_EVEN, CONV_W, LRU_W), CONV_W ** -0.5),
        'conv_b': nrm((N_EVEN, LRU_W), 0.02),
        'lru_wa': nrm((N_EVEN, 2, LRU_BLOCKS, LRU_BW, LRU_BW), LRU_BW ** -0.5),
        'lru_ba': nrm((N_EVEN, 2, LRU_W), 0.1),
        'lru_wx': nrm((N_EVEN, 2, LRU_BLOCKS, LRU_BW, LRU_BW), LRU_BW ** -0.5),
        'lru_bx': nrm((N_EVEN, 2, LRU_W), 0.1),
        'lru_lambda': lru_lambda,
        'na_bias': nrm((N_EVEN, NA_HEADS, 2 * NA_KR - 1, 2 * NA_KC - 1), 0.5),
        'w_out_ab': nrm((N_EVEN, AB_OUT, D_MODEL), AB_OUT ** -0.5),
        'w_in_cd': nrm((N_ODD, D_MODEL, CD_IN), D_MODEL ** -0.5),
        'gqa_q_gain': gain((N_ODD, GQA_DH)),
        'gqa_k_gain': gain((N_ODD, GQA_DH)),
        'mla_q_gain': gain((N_ODD, MLA_Q_RANK)),
        'mla_kv_gain': gain((N_ODD, MLA_KV_RANK)),
        'mla_w_uq': nrm((N_ODD, MLA_Q_RANK, MLA_HEADS * MLA_QK), MLA_Q_RANK ** -0.5),
        'mla_w_uk': nrm((N_ODD, MLA_KV_RANK, MLA_HEADS * MLA_NOPE), MLA_KV_RANK ** -0.5),
        'mla_w_uv': nrm((N_ODD, MLA_KV_RANK, MLA_HEADS * MLA_V), MLA_KV_RANK ** -0.5),
        'w_out_cd': nrm((N_ODD, CD_OUT, D_MODEL), CD_OUT ** -0.5),
        'final_gain': gain((D_MODEL,)),
    }


def reference(x_prompt, x_sample, state_lru_fwd, state_lru_bwd, cache_na_k, cache_na_v, cache_gqa_k,
              cache_gqa_v, cache_mla_ckv, cache_mla_krope, c, c_ctx, w_mod, b_mod, norm_gain, w_ffn_in,
              w_ffn_out, w_in_ab, conv_w, conv_b, lru_wa, lru_ba, lru_wx, lru_bx, lru_lambda, na_bias,
              w_out_ab, w_in_cd, gqa_q_gain, gqa_k_gain, mla_q_gain, mla_kv_gain, mla_w_uq, mla_w_uk,
              mla_w_uv, w_out_cd, final_gain):
    xp, xs = x_prompt, x_sample
    st_f, st_b, na_k, na_v, gq_k, gq_v, ml_c, ml_r = [], [], [], [], [], [], [], []
    for layer in range(DEPTH):
        mod_p = modulation(c_ctx[None, :], w_mod[layer], b_mod[layer])
        mod_s = modulation(c, w_mod[layer], b_mod[layer])
        gains, f_in, f_out = norm_gain[layer], w_ffn_in[layer], w_ffn_out[layer]
        j = layer // 2
        if layer % 2 == 0:
            lp = {'w_in': w_in_ab[j], 'conv_w': conv_w[j], 'conv_b': conv_b[j], 'wa': lru_wa[j],
                  'ba': lru_ba[j], 'wx': lru_wx[j], 'bx': lru_bx[j], 'lam': lru_lambda[j],
                  'na_bias': na_bias[j], 'w_out': w_out_ab[j]}
            xp, ctx = trunk_layer(xp, mod_p, gains, f_in, f_out, lambda h: ab_context(h, lp))
            xs, _ = trunk_layer(xs, mod_s, gains, f_in, f_out,
                                lambda h: ab_latent(h, lp, state_lru_fwd[:, j], state_lru_bwd[:, j],
                                                    cache_na_k[:, j], cache_na_v[:, j]))
            st_f.append(ctx[0])
            st_b.append(ctx[1])
            na_k.append(ctx[2])
            na_v.append(ctx[3])
        else:
            lp = {'w_in': w_in_cd[j], 'q_gain': gqa_q_gain[j], 'k_gain': gqa_k_gain[j],
                  'mla_q_gain': mla_q_gain[j], 'mla_kv_gain': mla_kv_gain[j], 'w_uq': mla_w_uq[j],
                  'w_uk': mla_w_uk[j], 'w_uv': mla_w_uv[j], 'w_out': w_out_cd[j]}
            xp, ctx = trunk_layer(xp, mod_p, gains, f_in, f_out, lambda h: cd_context(h, lp))
            xs, _ = trunk_layer(xs, mod_s, gains, f_in, f_out,
                                lambda h: cd_latent(h, lp, cache_gqa_k[:, j], cache_gqa_v[:, j],
                                                    cache_mla_ckv[:, j], cache_mla_krope[:, j]))
            gq_k.append(ctx[0])
            gq_v.append(ctx[1])
            ml_c.append(ctx[2])
            ml_r.append(ctx[3])
    y_prompt = rmsnorm(xp, final_gain)
    y_sample = rmsnorm(xs, final_gain)
    new_state_lru_fwd = jnp.stack(st_f, axis=1)
    new_state_lru_bwd = jnp.stack(st_b, axis=1)
    new_cache_na_k = jnp.stack(na_k, axis=1)
    new_cache_na_v = jnp.stack(na_v, axis=1)
    new_cache_gqa_k = jnp.stack(gq_k, axis=1)
    new_cache_gqa_v = jnp.stack(gq_v, axis=1)
    new_cache_mla_ckv = jnp.stack(ml_c, axis=1)
    new_cache_mla_krope = jnp.stack(ml_r, axis=1)
    return (y_prompt, y_sample, new_state_lru_fwd, new_state_lru_bwd, new_cache_na_k, new_cache_na_v,
            new_cache_gqa_k, new_cache_gqa_v, new_cache_mla_ckv, new_cache_mla_krope)
```

```cpp
#include <hip/hip_runtime.h>
#include <cstdio>
#include <cstdint>
namespace pg8 {
#define PG8_LAS __attribute__((address_space(3)))
typedef unsigned short bf16_t;
typedef short bf16x8 __attribute__((ext_vector_type(8)));
typedef float f32x4 __attribute__((ext_vector_type(4)));
typedef unsigned u32x4 __attribute__((ext_vector_type(4)));
constexpr int BM = 256, BK = 64, HALF = 128, HTB = HALF * BK * 2  , STAGE_BYTES = 8 * HTB, NXCD = 8, WGM = 4;

__host__ __device__ __forceinline__ int lds_byte(int r, int c) { const int st = (r >> 4) * 2 + (c >> 5), rr = r & 15, cc = c & 31, ob = rr * 64 + cc * 2; return st * 1024 + (ob ^ (((ob >> 9) & 1) << 5)); }
__host__ __device__ __forceinline__ void stage_rc(int b, int& R, int& C) { const int st = b / 1024, sb = b % 1024, swz = sb ^ (((sb >> 9) & 1) << 5); R = (st >> 1) * 16 + swz / 64; C = (st & 1) * 32 + (swz % 64) / 2; }
__host__ __device__ __forceinline__ int perm32(int rho) { const int n = rho >> 4, i = rho & 15; return 8 * (i >> 2) + 4 * n + (i & 3); }

struct Unit { int pm, pn, mh; };
struct Gemm { const bf16_t* A; const bf16_t* Bt; int M, N, K; };

struct StaticOrder {
    int nM, nN, nwg, G, c, wgm;
    __host__ __device__ void init(int M, int N, int G_, int c_) { nM = M / BM; nN = N / BM; nwg = nM * nN; G = G_; c = c_; wgm = WGM; }
    __host__ __device__ void init_tm(int M, int N, int G_, int c_, int tm) { nM = M / tm; nN = N / BM; nwg = nM * nN; G = G_; c = c_; wgm = WGM; }
    __host__ __device__ bool next(int i, Unit& u) const {
        const long L = (long)i * G + c; if (L >= nwg) return false;
        int wgid = (int)L; { const int q = nwg / NXCD, r = nwg % NXCD, xcd = wgid % NXCD, off = wgid / NXCD; wgid = (xcd < r ? xcd * (q + 1) : r * (q + 1) + (xcd - r) * q) + off; }
        const int nig = wgm * nN, gid = wgid / nig, fm = gid * wgm, gsz = (nM - fm) < wgm ? (nM - fm) : wgm;
        u.pm = fm + ((wgid % nig) % gsz); u.pn = (wgid % nig) / gsz; u.mh = -1; return true;
    }
    __device__ __forceinline__ void a_ready(const Unit&) const {}
    __device__ __forceinline__ void done(const Unit&) const {}
};
struct HalfOrder : StaticOrder {
    __host__ __device__ bool next(int i, Unit& u) const {
        const int R = nwg / G, rem = nwg % G;
        if (i < R) { StaticOrder t = *this; return t.StaticOrder::next(i, u); }
        if (i > R || rem == 0) return false;
        if (2 * rem > G) { StaticOrder t = *this; return t.StaticOrder::next(R, u); }
        if (c >= 2 * rem) return false;
        StaticOrder t = *this; t.c = c >> 1;
        if (!t.StaticOrder::next(R, u)) return false;
        u.mh = c & 1; return true;
    }
};
__device__ __forceinline__ unsigned cvt_pk_bf16(float lo, float hi) { unsigned r; asm volatile("v_cvt_pk_bf16_f32 %0, %1, %2" : "=v"(r) : "v"(lo), "v"(hi)); return r; }
typedef float f32x2 __attribute__((ext_vector_type(2)));
template <class Epi, class Sched, bool ALIGN_EPI = false, bool SP2 = false, int TM = 256>
__device__ __forceinline__ void gemm_phase(PG8_LAS unsigned char* lds, const Gemm g, const Sched& S, const Epi& E) {
    static_assert(SP2, "half-M units are implemented in the SP2 loop only");
    static_assert(TM == 256 || TM == 192, "row tile");
    constexpr int HI_PIECES = TM == 256 ? 2 : 1, HI_M = TM == 256 ? 4 : 2;
    int tid_l = threadIdx.x; asm volatile("" : "+v"(tid_l));
    const int tid = tid_l, wid = __builtin_amdgcn_readfirstlane(tid >> 6), lane = tid & 63, wr = wid >> 2, wc = wid & 3, fr = lane & 15, fq = lane >> 4;
    const int K = g.K, nt = K / BK;
    unsigned voffA[2], voffB[2];
#pragma unroll
    for (int i = 0; i < 2; ++i) { int R, C; stage_rc(tid * 16 + i * 8192, R, C); const int Rb = Epi::PERM ? ((R & ~31) + perm32(R & 31)) : R;
        voffA[i] = (unsigned)(R * K + C) * 2u; voffB[i] = (unsigned)(Rb * K + C) * 2u; }
    const size_t kstep = (size_t)(BK * 2);
    const size_t hstep = (size_t)HALF * K * 2;
    const size_t tstep = 2 * hstep;
    const size_t tstepA = TM == 256 ? tstep : (size_t)192 * K * 2;
    const unsigned ldsw = (unsigned)wid * 1024u;
    const int aoff = lds_byte(wr * 64 + fr, fq * 8), boff = lds_byte(wc * 32 + fr, fq * 8), aoff_hi = TM == 256 ? aoff : lds_byte(wr * 32 + fr, fq * 8);
#define PG8_SA(b, h) (((b) * 2 + (h)) * HTB)
#define PG8_SB(b, h) ((4 + (b) * 2 + (h)) * HTB)
#define PG8_STAGE(bufoff, gbase, voff) do { _Pragma("unroll") for (int _i = 0; _i < 2; ++_i) \
        __builtin_amdgcn_global_load_lds((const unsigned*)((const char*)(gbase) + (voff)[_i]), (PG8_LAS unsigned*)(lds + (bufoff) + ldsw + _i * 8192), 16, 0, 0); } while (0)
#define PG8_STAGE_HI(bufoff, gbase, voff) do { _Pragma("unroll") for (int _i = 0; _i < HI_PIECES; ++_i) \
        __builtin_amdgcn_global_load_lds((const unsigned*)((const char*)(gbase) + (voff)[_i]), (PG8_LAS unsigned*)(lds + (bufoff) + ldsw + _i * 8192), 16, 0, 0); } while (0)
#define PG8_LDA_HI(dst, b) do { _Pragma("unroll") for (int m = 0; m < HI_M; ++m) _Pragma("unroll") for (int k = 0; k < 2; ++k) dst[m][k] = *(const PG8_LAS bf16x8*)(lds + PG8_SA(b, 1) + aoff_hi + m * 2048 + k * 1024); } while (0)
#define PG8_MMA_HI(bj, At, Bt) do { __builtin_amdgcn_s_setprio(1); _Pragma("unroll") for (int m = 0; m < HI_M; ++m) _Pragma("unroll") for (int n = 0; n < 2; ++n) _Pragma("unroll") for (int k = 0; k < 2; ++k) \
        acc[1][bj][m][n] = __builtin_amdgcn_mfma_f32_16x16x32_bf16(Bt[n][k], At[m][k], acc[1][bj][m][n], 0, 0, 0); __builtin_amdgcn_s_setprio(0); } while (0)
#define PG8_WAIT_LOOP do { if constexpr (TM == 256) asm volatile("s_waitcnt vmcnt(8)" ::: "memory"); else asm volatile("s_waitcnt vmcnt(7)" ::: "memory"); } while (0)
#define PG8_LDA(dst, b, h) do { _Pragma("unroll") for (int m = 0; m < 4; ++m) _Pragma("unroll") for (int k = 0; k < 2; ++k) dst[m][k] = *(const PG8_LAS bf16x8*)(lds + PG8_SA(b, h) + aoff + m * 2048 + k * 1024); } while (0)
#define PG8_LDB(dst, b, h) do { _Pragma("unroll") for (int n = 0; n < 2; ++n) _Pragma("unroll") for (int k = 0; k < 2; ++k) dst[n][k] = *(const PG8_LAS bf16x8*)(lds + PG8_SB(b, h) + boff + n * 2048 + k * 1024); } while (0)
#define PG8_MMA(ai, bj, At, Bt) do { __builtin_amdgcn_s_setprio(1); _Pragma("unroll") for (int m = 0; m < 4; ++m) _Pragma("unroll") for (int n = 0; n < 2; ++n) _Pragma("unroll") for (int k = 0; k < 2; ++k) \
        acc[ai][bj][m][n] = __builtin_amdgcn_mfma_f32_16x16x32_bf16(Bt[n][k], At[m][k], acc[ai][bj][m][n], 0, 0, 0); __builtin_amdgcn_s_setprio(0); } while (0)
#define PG8_WAIT_V(n) asm volatile("s_waitcnt vmcnt(" #n ")" ::: "memory")
#define PG8_WAIT_L(n) asm volatile("s_waitcnt lgkmcnt(" #n ")" ::: "memory")
#define PG8_BAR __builtin_amdgcn_s_barrier()
#define PG8_SCHED __builtin_amdgcn_sched_barrier(0)
    Unit cur, nxt; int ui = 0;
    if (!S.next(0, cur)) return;
    f32x4 acc[2][2][4][2];
#pragma unroll
    for (int a = 0; a < 2; ++a)
#pragma unroll
        for (int b = 0; b < 2; ++b)
#pragma unroll
            for (int m = 0; m < 4; ++m)
#pragma unroll
                for (int n = 0; n < 2; ++n) acc[a][b][m][n] = (f32x4){0.f, 0.f, 0.f, 0.f};
    bf16x8 At[4][2], B0[2][2], B1[2][2];
    bool c_half = cur.mh >= 0; size_t c_ahi = c_half ? 0 : hstep;
    const char* cA = (const char*)g.A + (size_t)cur.pm * tstepA + (cur.mh > 0 ? hstep : 0); const char* cB = (const char*)g.Bt + (size_t)cur.pn * tstep;
    S.a_ready(cur);
    if constexpr (SP2) {
        PG8_STAGE(PG8_SB(0, 0), cB, voffB); PG8_STAGE(PG8_SB(0, 1), cB + hstep, voffB); PG8_STAGE(PG8_SA(0, 0), cA, voffA); PG8_STAGE_HI(PG8_SA(0, 1), cA + c_ahi, voffA);
        if (wr == 1) PG8_BAR;
        if constexpr (TM == 256) PG8_WAIT_V(2); else PG8_WAIT_V(1);
        PG8_BAR;
        PG8_STAGE(PG8_SB(1, 0), cB + kstep, voffB); PG8_STAGE(PG8_SA(1, 0), cA + kstep, voffA); PG8_STAGE(PG8_SB(1, 1), cB + hstep + kstep, voffB);
        PG8_WAIT_V(6); PG8_BAR;
    } else {
        PG8_STAGE(PG8_SB(0, 0), cB, voffB); PG8_STAGE(PG8_SA(0, 0), cA, voffA); PG8_STAGE(PG8_SB(0, 1), cB + hstep, voffB); PG8_STAGE(PG8_SA(0, 1), cA + hstep, voffA);
        if (wr == 1) PG8_BAR;
        PG8_WAIT_V(4); PG8_BAR;
        PG8_STAGE(PG8_SB(1, 0), cB + kstep, voffB); PG8_STAGE(PG8_SA(1, 0), cA + kstep, voffA); PG8_STAGE(PG8_SB(1, 1), cB + hstep + kstep, voffB);
        PG8_WAIT_V(6); PG8_BAR;
    }
    for (;;) {
        const bool has_next = S.next(ui + 1, nxt);
        const char* nA = has_next ? (const char*)g.A + (size_t)nxt.pm * tstepA + (nxt.mh > 0 ? hstep : 0) : cA; const char* nB = has_next ? (const char*)g.Bt + (size_t)nxt.pn * tstep : cB;
        const bool n_half = has_next ? (nxt.mh >= 0) : c_half; const size_t n_ahi = n_half ? 0 : hstep;
        for (int t = 0; t < nt; t += 2) {
            const bool last = (t == nt - 2);
            const char* a1 = cA + (size_t)(t + 1) * kstep;
            const char* a2 = last ? nA : cA + (size_t)(t + 2) * kstep; const char* b2 = last ? nB : cB + (size_t)(t + 2) * kstep;
            const char* a3 = a2 + kstep; const char* b3 = b2 + kstep;
            if (last && has_next) S.a_ready(nxt);
            if constexpr (SP2) {
            PG8_LDA(At, 0, 0); PG8_LDB(B0, 0, 0); PG8_LDB(B1, 0, 1); PG8_STAGE_HI(PG8_SA(1, 1), a1 + c_ahi, voffA);
            PG8_WAIT_LOOP; PG8_WAIT_L(0); PG8_BAR; PG8_MMA(0, 0, At, B0); PG8_MMA(0, 1, At, B1); PG8_BAR; PG8_SCHED;
            if (!c_half) PG8_LDA_HI(At, 0); PG8_STAGE(PG8_SB(0, 0), b2, voffB); PG8_STAGE(PG8_SB(0, 1), b2 + hstep, voffB); PG8_STAGE(PG8_SA(0, 0), a2, voffA);
            PG8_WAIT_LOOP; PG8_WAIT_L(0); PG8_BAR; if (!c_half) { PG8_MMA_HI(0, At, B0); PG8_MMA_HI(1, At, B1); } PG8_BAR; PG8_SCHED;
            PG8_LDA(At, 1, 0); PG8_LDB(B0, 1, 0); PG8_LDB(B1, 1, 1); PG8_STAGE_HI(PG8_SA(0, 1), a2 + (last ? n_ahi : c_ahi), voffA);
            PG8_WAIT_LOOP; PG8_WAIT_L(0); PG8_BAR; PG8_MMA(0, 0, At, B0); PG8_MMA(0, 1, At, B1); PG8_BAR; PG8_SCHED;
            if (!c_half) PG8_LDA_HI(At, 1); PG8_STAGE(PG8_SB(1, 0), b3, voffB); PG8_STAGE(PG8_SB(1, 1), b3 + hstep, voffB); PG8_STAGE(PG8_SA(1, 0), a3, voffA);
            PG8_WAIT_LOOP; PG8_WAIT_L(0); PG8_BAR; if (!c_half) { PG8_MMA_HI(0, At, B0); PG8_MMA_HI(1, At, B1); } PG8_BAR; PG8_SCHED;
            } else {
            PG8_LDB(B0, 0, 0); PG8_SCHED; PG8_LDA(At, 0, 0); PG8_STAGE(PG8_SA(1, 1), a1 + hstep, voffA);
            PG8_WAIT_L(8); PG8_BAR; PG8_WAIT_L(0); PG8_MMA(0, 0, At, B0); PG8_BAR; PG8_SCHED;
            PG8_LDB(B1, 0, 1); PG8_STAGE(PG8_SB(0, 0), b2, voffB);
            PG8_BAR; PG8_WAIT_L(0); PG8_MMA(0, 1, At, B1); PG8_BAR;
            PG8_LDA(At, 0, 1); PG8_STAGE(PG8_SA(0, 0), a2, voffA);
            PG8_BAR; PG8_WAIT_L(0); PG8_MMA(1, 0, At, B0); PG8_BAR; PG8_SCHED;
            PG8_STAGE(PG8_SB(0, 1), b2 + hstep, voffB);
            PG8_WAIT_V(6); PG8_BAR; PG8_MMA(1, 1, At, B1); PG8_BAR;
            PG8_LDB(B0, 1, 0); PG8_SCHED; PG8_LDA(At, 1, 0); PG8_STAGE(PG8_SA(0, 1), a2 + hstep, voffA);
            PG8_WAIT_L(8); PG8_BAR; PG8_WAIT_L(0); PG8_MMA(0, 0, At, B0); PG8_BAR; PG8_SCHED;
            PG8_LDB(B1, 1, 1); PG8_STAGE(PG8_SB(1, 0), b3, voffB);
            PG8_BAR; PG8_WAIT_L(0); PG8_MMA(0, 1, At, B1); PG8_BAR;
            PG8_LDA(At, 1, 1); PG8_STAGE(PG8_SA(1, 0), a3, voffA);
            PG8_BAR; PG8_WAIT_L(0); PG8_MMA(1, 0, At, B0); PG8_BAR; PG8_SCHED;
            PG8_STAGE(PG8_SB(1, 1), b3 + hstep, voffB);
            PG8_WAIT_V(6); PG8_BAR; PG8_MMA(1, 1, At, B1); PG8_BAR;
            }
        }
        if constexpr (ALIGN_EPI) { if (wr == 0) PG8_BAR; }
        if constexpr (!Epi::AFTER_DRAIN) { E(acc, cur, wr, wc, fr, fq); S.done(cur); }
        if (!has_next) break;
#pragma unroll
        for (int a = 0; a < 2; ++a)
#pragma unroll
            for (int b = 0; b < 2; ++b)
#pragma unroll
                for (int m = 0; m < 4; ++m)
#pragma unroll
                    for (int n = 0; n < 2; ++n) acc[a][b][m][n] = (f32x4){0.f, 0.f, 0.f, 0.f};
        cur = nxt; cA = nA; cB = nB; c_half = n_half; c_ahi = n_ahi; ++ui;
        if constexpr (ALIGN_EPI) { if (wr == 1) PG8_BAR; }
    }
    PG8_WAIT_V(0);
    if constexpr (!ALIGN_EPI) { if (wr == 0) PG8_BAR; }
    PG8_BAR;
    if constexpr (Epi::AFTER_DRAIN) { E.fused(acc, cur, wr, wc, fr, fq, lds, wid, lane); S.done(cur); }
#undef PG8_SA
#undef PG8_SB
#undef PG8_STAGE
#undef PG8_LDA
#undef PG8_STAGE_HI
#undef PG8_LDA_HI
#undef PG8_MMA_HI
#undef PG8_WAIT_LOOP
#undef PG8_LDB
#undef PG8_MMA
#undef PG8_WAIT_V
#undef PG8_WAIT_L
#undef PG8_BAR
#undef PG8_SCHED
}
}

#define GAS __attribute__((address_space(1)))
#define LAS __attribute__((address_space(3)))
typedef unsigned short bf16;
typedef short bf16x8 __attribute__((ext_vector_type(8)));
typedef float f32x4 __attribute__((ext_vector_type(4)));
typedef unsigned u32x4 __attribute__((ext_vector_type(4)));
typedef unsigned u32x2 __attribute__((ext_vector_type(2)));
#define LDS_WAIT() asm volatile("s_waitcnt lgkmcnt(0)" ::: "memory")
#define VM_WAIT() asm volatile("s_waitcnt vmcnt(0)" ::: "memory")

#ifndef EN_P0
#define EN_P0 1
#endif
#ifndef EN_ADALN
#define EN_ADALN 1
#endif
#ifndef EN_G1
#define EN_G1 1
#endif
#ifndef EN_GAB
#define EN_GAB 1
#endif
#ifndef EN_L1
#define EN_L1 1
#endif
#ifndef EN_NA
#define EN_NA 1
#endif
#ifndef EN_DP
#define EN_DP 1
#endif
#ifndef EN_L3
#define EN_L3 1
#endif
#ifndef EN_GCD
#define EN_GCD 1
#endif
#ifndef EN_POST
#define EN_POST 1
#endif
#ifndef EN_GQD
#define EN_GQD 1
#endif
#ifndef EN_GKNV
#define EN_GKNV 1
#endif
#ifndef EN_GQA
#define EN_GQA 1
#endif
#ifndef EN_MLA
#define EN_MLA 1
#endif
#ifndef EN_RES
#define EN_RES 1
#endif
#ifndef EN_MIXRES
#define EN_MIXRES 1
#endif
#ifndef EN_FINAL
#define EN_FINAL 1
#endif
#ifndef DUP_MASK
#define DUP_MASK 0
#endif
#define REPS(k) (((DUP_MASK >> (k)) & 1) + 1)
#ifndef ATT_DEFER
#define ATT_DEFER 6.0f
#endif
#ifndef RES_TM
#define RES_TM 192
#endif
#ifndef MK_PER_PHASE
#define MK_PER_PHASE 0
#endif

constexpr int D = 2048, DFF = 5632, MP = 4096, MS = 8192, MT = 12288, MKV = 16384;
constexpr int NMODC = 9 * 2048;
constexpr float EPS = 1e-6f;
constexpr float LOG2E = 1.4426950408889634f;
constexpr float QS64 = 0.125f * LOG2E;
constexpr float QS192 = 0.07216878364870322f * LOG2E;
constexpr int NWAVES = 8;
constexpr int N_PHASES = 48;

constexpr size_t O_YP = 0, O_YS = O_YP + (size_t)MP * D, O_SF = O_YS + (size_t)MS * D, O_SB = O_SF + 16 * 2 * 1024, O_NAK = O_SB + 16 * 2 * 1024,
                 O_NAV = O_NAK + (size_t)16 * 2 * 256 * 1024, O_GK = O_NAV + (size_t)16 * 2 * 256 * 1024, O_GV = O_GK + (size_t)16 * 2 * 256 * 256,
                 O_CKV = O_GV + (size_t)16 * 2 * 256 * 256, O_KR = O_CKV + (size_t)16 * 2 * 256 * 512, O_END = O_KR + (size_t)16 * 2 * 256 * 64;

constexpr size_t MiB = 1u << 20;
constexpr size_t WS_CTL = 0, WS_MOD = 1 * MiB, CTL_ZERO_BYTES = 64 * 1024;
constexpr size_t WS_ROPE = 4 * MiB;
constexpr size_t WS_LRUW = 5 * MiB;
constexpr size_t WS_W1 = 8 * MiB;
constexpr size_t WS_W2 = WS_W1 + 352 * MiB;
constexpr size_t WS_WABI = WS_W2 + 176 * MiB;
constexpr size_t WS_WABO = WS_WABI + 40 * MiB;
constexpr size_t WS_WCDI = WS_WABO + 16 * MiB;
constexpr size_t WS_WCDO = WS_WCDI + 22 * MiB;
constexpr size_t WS_WUQ = WS_WCDO + 16 * MiB;
constexpr size_t WS_WUKV = WS_WUQ + 3 * MiB;
constexpr size_t WS_KCNA = WS_WUKV + 4 * MiB;
constexpr size_t WS_VTCNA = WS_KCNA + 16 * MiB;
constexpr size_t WS_KCG = WS_VTCNA + 16 * MiB;
constexpr size_t WS_VTCG = WS_KCG + 4 * MiB;
constexpr size_t WS_CKVALL = WS_VTCG + 4 * MiB;
constexpr size_t WS_KRALL = WS_CKVALL + 32 * MiB;
constexpr size_t WS_X = WS_KRALL + 4 * MiB;
constexpr size_t WS_H = WS_X + 96 * MiB;
constexpr size_t WS_ACT = WS_H + 48 * MiB;
constexpr size_t WS_YCAT = WS_ACT + 132 * MiB;
constexpr size_t WS_XAGA = WS_YCAT + 48 * MiB;
constexpr size_t WS_QB = WS_XAGA + 48 * MiB;
constexpr size_t WS_KB = WS_QB + 24 * MiB;
constexpr size_t WS_VT = WS_KB + 24 * MiB;
constexpr size_t WS_LRU = WS_VT + 24 * MiB;
constexpr size_t WS_AGG = WS_LRU + 96 * MiB;
constexpr size_t WS_RAW = WS_AGG + 4 * MiB;
constexpr size_t WS_QG = WS_RAW + 66 * MiB;
constexpr size_t WS_KG = WS_QG + 24 * MiB;
constexpr size_t WS_VGT = WS_KG + 6 * MiB;
constexpr size_t WS_QA = WS_VGT + 6 * MiB;
constexpr size_t WS_QD = WS_QA + 12 * MiB;
constexpr size_t WS_KN = WS_QD + 36 * MiB;
constexpr size_t WS_VDT = WS_KN + 32 * MiB;
constexpr size_t WS_END = WS_VDT + 32 * MiB;
constexpr int CW_RANK = 9216;
constexpr int CW_BAR = 4096;

constexpr int RING_BYTES = 131072;
constexpr int SCR_PER_WAVE = 16640;
constexpr int MISC_OFF = 135168;
constexpr int LDS_BYTES = 147456;
static_assert(NWAVES * SCR_PER_WAVE <= MISC_OFF && MISC_OFF + 256 <= LDS_BYTES, "LDS map");

typedef float f32x2_t __attribute__((ext_vector_type(2))); typedef __bf16 bf16x2_t __attribute__((ext_vector_type(2)));
__device__ __forceinline__ unsigned pkbf(float lo, float hi) { f32x2_t v = {lo, hi}; bf16x2_t b = __builtin_convertvector(v, bf16x2_t); return __builtin_bit_cast(unsigned, b); }
__device__ __forceinline__ float bflo(unsigned w) { return __uint_as_float(w << 16); }
__device__ __forceinline__ float bfhi(unsigned w) { return __uint_as_float(w & 0xffff0000u); }
__device__ __forceinline__ float fexp2(float x) { return __builtin_amdgcn_exp2f(x); }
__device__ __forceinline__ float frcp(float x) { return __builtin_amdgcn_rcpf(x); }
__device__ __forceinline__ float sigmoidf_(float x) { return frcp(1.0f + fexp2(-x * LOG2E)); }
__device__ __forceinline__ float wave_sum(float v) {
#pragma unroll
    for (int o = 1; o < 64; o <<= 1) v += __shfl_xor(v, o);
    return v;
}
__device__ __forceinline__ int cond_of_row(int m) { return m < MP ? 0 : 1 + ((m - MP) >> 10); }
__device__ __forceinline__ bf16x8 ld16(const bf16* p) { return *(const bf16x8*)p; }

#define XB_TMO      128
#define XB_XCNT(j)  (256  + 64 * (j))
#define XB_XSUB(j)  (1280 + 64 * (j))
#define XB_XGEN(j)  (2304 + 64 * (j))
#define XB_TOP      3328
#define XB_TOPGEN   3392
#define XCD_BAR_WORDS 3456
#define XB_SPIN_CAP (1u << 18)

__device__ __forceinline__ unsigned xb_ld(unsigned* p)              { return __hip_atomic_load(p, __ATOMIC_RELAXED, __HIP_MEMORY_SCOPE_AGENT); }
__device__ __forceinline__ unsigned xb_add(unsigned* p, unsigned v) { return __hip_atomic_fetch_add(p, v, __ATOMIC_RELAXED, __HIP_MEMORY_SCOPE_AGENT); }
__device__ __forceinline__ unsigned xb_xcc_id() { return (unsigned)__builtin_amdgcn_s_getreg((3 << 11) | 20) & 0xFu; }
#define XB_SPIN(cond, bar) do { unsigned _sp = 0; while (cond) { __builtin_amdgcn_s_sleep(1); \
    if ((++_sp & 255u) == 0u) { if (xb_ld(&(bar)[XB_TMO])) break; if (_sp > XB_SPIN_CAP) { atomicAdd(&(bar)[XB_TMO], 1u); break; } } } } while (0)

struct XcdBarrier {
    unsigned* bar; unsigned x;
    volatile LAS unsigned* st;
};

__device__ __forceinline__ XcdBarrier xcd_barrier_post(unsigned* bar, volatile LAS unsigned* st) {
    XcdBarrier b; b.bar = bar; b.x = xb_xcc_id(); b.st = st;
    if (threadIdx.x == 0) (void)xb_add(&bar[XB_XCNT(b.x)], 1u);
    return b;
}
__device__ __forceinline__ void xcd_barrier_complete(unsigned* bar, unsigned x, unsigned& nloc, unsigned& nx) {
    const unsigned G = gridDim.x * gridDim.y * gridDim.z;
    unsigned sum, cnt, mine, sp = 0u;
    for (;;) {
        sum = 0u; cnt = 0u; mine = 0u;
#pragma unroll
        for (unsigned j = 0; j < 16; ++j) { const unsigned c = xb_ld(&bar[XB_XCNT(j)]); sum += c; cnt += (c > 0u) ? 1u : 0u; mine = (j == x) ? c : mine; }
        if (sum == G) break;
        __builtin_amdgcn_s_sleep(1);
        if ((++sp & 255u) == 0u) { if (xb_ld(&bar[XB_TMO])) break; if (sp > XB_SPIN_CAP) { atomicAdd(&bar[XB_TMO], 1u); break; } }
    }
    nloc = mine > 0u ? mine : 1u; nx = cnt > 0u ? cnt : 1u;
}

__device__ __forceinline__ void xcd_barrier(const XcdBarrier& b) {
    asm volatile("s_waitcnt vmcnt(0)" ::: "memory");
    __syncthreads();
    if (threadIdx.x == 0) {
        unsigned* bar = b.bar;
        __builtin_amdgcn_s_waitcnt(0);
        unsigned nloc = b.st[0], nx = b.st[1];
        if (nloc == 0u) { xcd_barrier_complete(bar, b.x, nloc, nx); b.st[0] = nloc; b.st[1] = nx; }
        const unsigned old = xb_add(&bar[XB_XSUB(b.x)], 1u);
        const unsigned gen = old / nloc;
        if (old + 1u == (gen + 1u) * nloc) {
            __builtin_amdgcn_fence(__ATOMIC_RELEASE, "agent");
            asm volatile("s_waitcnt vmcnt(0)" ::: "memory");
            const unsigned og = xb_add(&bar[XB_TOP], 1u);
            const unsigned tg = og / nx;
            if (og + 1u == (tg + 1u) * nx) xb_add(&bar[XB_TOPGEN], 1u);
            else XB_SPIN(xb_ld(&bar[XB_TOPGEN]) == tg, bar);
            __builtin_amdgcn_fence(__ATOMIC_ACQUIRE, "agent");
            xb_add(&bar[XB_XGEN(b.x)], 1u);
            asm volatile("s_waitcnt vmcnt(0)" ::: "memory");
        } else {
            XB_SPIN(xb_ld(&bar[XB_XGEN(b.x)]) == gen, bar);
            __builtin_amdgcn_fence(__ATOMIC_ACQUIRE, "agent");
            asm volatile("s_waitcnt vmcnt(0)" ::: "memory");
        }
    }
    __syncthreads();
}

struct Args { const float* in[37]; float* out; unsigned char* ws; int ph_lo, ph_hi; };
struct Frame {
    LAS unsigned char* lds; volatile LAS unsigned* MISC; unsigned* ctl;
    int tid, lane, wave, vcu, G;
    float* out; unsigned char* ws; const Args* a;
};

__device__ __forceinline__ void tr_item(const float* src, size_t ldsrc, bf16* dst, size_t ldd, LAS float* scr, int lane) {
    float tv[64];
#pragma unroll
    for (int i = 0; i < 64; ++i) tv[i] = __builtin_nontemporal_load(src + (size_t)i * ldsrc + lane);
#pragma unroll
    for (int i = 0; i < 64; ++i) scr[i * 65 + lane] = tv[i];
    LDS_WAIT();
    const int c = lane & 7;
#pragma unroll
    for (int jn = 0; jn < 8; ++jn) { const int n = (lane >> 3) + 8 * jn; const LAS float* s = scr + (8 * c) * 65 + n;
        u32x4 o; o.x = pkbf(s[0 * 65], s[1 * 65]); o.y = pkbf(s[2 * 65], s[3 * 65]); o.z = pkbf(s[4 * 65], s[5 * 65]); o.w = pkbf(s[6 * 65], s[7 * 65]);
        *(u32x4*)(dst + (size_t)n * ldd + 8 * c) = o; }
    LDS_WAIT();
}
__device__ __forceinline__ void cvt_copy(const float* src, bf16* dst, size_t n4, int gt, int ngt) {
    for (size_t i = gt; i < n4; i += ngt) { const f32x4 v = ((const f32x4*)src)[i]; u32x2 o; o.x = pkbf(v.x, v.y); o.y = pkbf(v.z, v.w); ((u32x2*)dst)[i] = o; }
}

__device__ __forceinline__ void p0_prologue(Frame& F) {
    LAS float* scr = (LAS float*)(F.lds + F.wave * SCR_PER_WAVE);
    const int gw = F.vcu * NWAVES + F.wave, NGW = F.G * NWAVES, lane = F.lane;
    unsigned char* ws = F.ws;
    constexpr int I_W1 = 8 * 32 * 176, I_W2 = 8 * 88 * 32, I_ABI = 2 * 32 * 80, I_ABO = 2 * 32 * 32, I_CDI = 2 * 32 * 41, I_CDO = 2 * 32 * 32, I_UQ = 2 * 8 * 24, I_UK = 2 * 8 * 16, I_UV = I_UK,
                  I_LRU = 128, I_VNA = 16 * 8 * 16;
    constexpr int NITEMS = I_W1 + I_W2 + I_ABI + I_ABO + I_CDI + I_CDO + I_UQ + I_UK + I_UV + I_LRU + I_VNA;
    for (int it = gw; it < NITEMS; it += NGW) {
        int r = it;
        if (r < I_W1) { const int mat = r / (32 * 176), q = r % (32 * 176), kb = q / 176, nb = q % 176; const int k0 = 64 * kb, n0 = 64 * nb;
            const int drow = n0 < DFF ? 256 * (n0 >> 7) + (n0 & 127) : 256 * ((n0 - DFF) >> 7) + 128 + ((n0 - DFF) & 127);
            tr_item(F.a->in[15] + (size_t)mat * 2048 * 11264 + (size_t)k0 * 11264 + n0, 11264, (bf16*)(ws + WS_W1) + (size_t)mat * 11264 * 2048 + (size_t)drow * 2048 + k0, 2048, scr, lane); continue; } r -= I_W1;
        if (r < I_W2) { const int mat = r / (88 * 32), q = r % (88 * 32), kb = q / 32, nb = q % 32; const int k0 = 64 * kb, n0 = 64 * nb;
            tr_item(F.a->in[16] + (size_t)mat * 5632 * 2048 + (size_t)k0 * 2048 + n0, 2048, (bf16*)(ws + WS_W2) + (size_t)mat * 2048 * 5632 + (size_t)n0 * 5632 + k0, 5632, scr, lane); continue; } r -= I_W2;
        if (r < I_ABI) { const int mat = r / (32 * 80), q = r % (32 * 80), kb = q / 80, nb = q % 80; const int k0 = 64 * kb, n0 = 64 * nb;
            tr_item(F.a->in[17] + (size_t)mat * 2048 * 5120 + (size_t)k0 * 5120 + n0, 5120, (bf16*)(ws + WS_WABI) + (size_t)mat * 5120 * 2048 + (size_t)n0 * 2048 + k0, 2048, scr, lane); continue; } r -= I_ABI;
        if (r < I_ABO) { const int mat = r / 1024, q = r % 1024, kb = q / 32, nb = q % 32; const int k0 = 64 * kb, n0 = 64 * nb;
            tr_item(F.a->in[26] + (size_t)mat * 2048 * 2048 + (size_t)k0 * 2048 + n0, 2048, (bf16*)(ws + WS_WABO) + (size_t)mat * 2048 * 2048 + (size_t)n0 * 2048 + k0, 2048, scr, lane); continue; } r -= I_ABO;
        if (r < I_CDI) { const int mat = r / (32 * 41), q = r % (32 * 41), kb = q / 41, nb = q % 41; const int k0 = 64 * kb, n0 = 64 * nb;
            tr_item(F.a->in[27] + (size_t)mat * 2048 * 2624 + (size_t)k0 * 2624 + n0, 2624, (bf16*)(ws + WS_WCDI) + (size_t)mat * 2816 * 2048 + (size_t)n0 * 2048 + k0, 2048, scr, lane); continue; } r -= I_CDI;
        if (r < I_CDO) { const int mat = r / 1024, q = r % 1024, kb = q / 32, nb = q % 32; const int k0 = 64 * kb, n0 = 64 * nb;
            tr_item(F.a->in[35] + (size_t)mat * 2048 * 2048 + (size_t)k0 * 2048 + n0, 2048, (bf16*)(ws + WS_WCDO) + (size_t)mat * 2048 * 2048 + (size_t)n0 * 2048 + k0, 2048, scr, lane); continue; } r -= I_CDO;
        if (r < I_UQ) { const int mat = r / (8 * 24), q = r % (8 * 24), kb = q / 24, nb = q % 24; const int k0 = 64 * kb, n0 = 64 * nb;
            tr_item(F.a->in[32] + (size_t)mat * 512 * 1536 + (size_t)k0 * 1536 + n0, 1536, (bf16*)(ws + WS_WUQ) + (size_t)mat * 1536 * 512 + (size_t)n0 * 512 + k0, 512, scr, lane); continue; } r -= I_UQ;
        if (r < I_UK) { const int mat = r / 128, q = r % 128, kb = q / 16, nb = q % 16; const int k0 = 64 * kb, n0 = 64 * nb;
            tr_item(F.a->in[33] + (size_t)mat * 512 * 1024 + (size_t)k0 * 1024 + n0, 1024, (bf16*)(ws + WS_WUKV) + (size_t)mat * 2048 * 512 + (size_t)n0 * 512 + k0, 512, scr, lane); continue; } r -= I_UK;
        if (r < I_UV) { const int mat = r / 128, q = r % 128, kb = q / 16, nb = q % 16; const int k0 = 64 * kb, n0 = 64 * nb;
            tr_item(F.a->in[34] + (size_t)mat * 512 * 1024 + (size_t)k0 * 1024 + n0, 1024, (bf16*)(ws + WS_WUKV) + (size_t)mat * 2048 * 512 + (size_t)(1024 + n0) * 512 + k0, 512, scr, lane); continue; } r -= I_UV;
        if (r < I_LRU) { const int ax = r & 1, blk = r >> 1;
            tr_item((ax ? F.a->in[22] : F.a->in[20]) + (size_t)blk * 4096, 64, (bf16*)(ws + WS_LRUW) + ((size_t)((blk >> 4) * 2 + ax) * 16 + (blk & 15)) * 4096, 64, scr, lane); continue; } r -= I_LRU;
        { const int mat = r / 128, q = r % 128, kb = q / 16, nb = q % 16; const int k0 = 64 * kb, n0 = 64 * nb;
            tr_item(F.a->in[5] + (size_t)mat * 512 * 1024 + (size_t)k0 * 1024 + n0, 1024, (bf16*)(ws + WS_VTCNA) + ((size_t)(mat * 2 + (k0 >> 8)) * 1024 + n0) * 256 + (k0 & 255), 256, scr, lane); }
    }
    const int gt = gw * 64 + lane, ngt = NGW * 64;
    { u32x2* X = (u32x2*)(ws + WS_X); const size_t np4 = (size_t)MP * D / 4, nt4 = (size_t)MT * D / 4;
      for (size_t i = gt; i < nt4; i += ngt) { const f32x4 v = i < np4 ? ((const f32x4*)F.a->in[0])[i] : ((const f32x4*)F.a->in[1])[i - np4]; u32x2 w; w.x = pkbf(v.x, v.y); w.y = pkbf(v.z, v.w); X[i] = w; } }
    cvt_copy(F.a->in[4], (bf16*)(ws + WS_KCNA), (size_t)8 * 2 * 512 * 1024 / 4, gt, ngt);
    for (size_t i = gt; i < (size_t)2 * 192 * 2048 / 8; i += ngt) { const size_t e = i * 8, mat = e / (192 * 2048), rem = e % (192 * 2048);
        *(u32x4*)((bf16*)(ws + WS_WCDI) + (mat * 2816 + 2624) * 2048 + rem) = (u32x4){0u, 0u, 0u, 0u}; }
    if (gt < 1024) { const int pos = gt >> 4, i = gt & 15; const float inv = exp2f(-(float)i * (13.287712379549449f / 16.0f)); const float ang = (float)pos * inv;
        ((float*)(ws + WS_ROPE))[gt] = cosf(ang); ((float*)(ws + WS_ROPE))[1024 + gt] = sinf(ang); }
    __syncthreads();
    LAS float* red = (LAS float*)F.lds;
    typedef float f32x2v __attribute__((ext_vector_type(2)));
    for (int u = F.vcu; u < 4 * 144; u += F.G) {
        const int L = u / 144, cc = u % 144;
        f32x2v acc[9];
#pragma unroll
        for (int c = 0; c < 9; ++c) acc[c] = (f32x2v){0.f, 0.f};
#pragma unroll 1
        for (int kq = 0; kq < 4; ++kq) {
            const int kbase = kq * 512 + F.wave * 64;
            float s[9];
#pragma unroll
            for (int c = 0; c < 9; ++c) { const float v = c == 0 ? F.a->in[11][kbase + lane] : F.a->in[10][(c - 1) * 2048 + kbase + lane]; s[c] = v * sigmoidf_(v); }
            const f32x2v* wp = (const f32x2v*)(F.a->in[12] + ((size_t)L * 2048 + kbase) * NMODC + cc * 128) + lane;
#pragma unroll 32
            for (int i = 0; i < 64; ++i) { const f32x2v w = __builtin_nontemporal_load(wp + (size_t)i * (NMODC / 2));
#pragma unroll
                for (int c = 0; c < 9; ++c) { const float sc = __builtin_bit_cast(float, __builtin_amdgcn_readlane(__builtin_bit_cast(int, s[c]), i)); acc[c] += w * sc; } }
        }
#pragma unroll
        for (int c = 0; c < 9; ++c) *(LAS f32x2v*)(red + (F.wave * 9 + c) * 128 + 2 * lane) = acc[c];
        __syncthreads();
        for (int o = F.tid; o < 9 * 128; o += NWAVES * 64) { float v = 0.f;
#pragma unroll
            for (int w = 0; w < 8; ++w) v += red[w * 9 * 128 + o];
            const int c = o >> 7, col = cc * 128 + (o & 127);
            ((float*)(ws + WS_MOD))[((size_t)L * 9 + c) * NMODC + col] = v + F.a->in[13][(size_t)L * NMODC + col]; }
        __syncthreads();
    }
}

__device__ __forceinline__ void unpk8(const u32x4& w, f32x4& a, f32x4& b) {
    a.x = bflo(w.x); a.y = bfhi(w.x); a.z = bflo(w.y); a.w = bfhi(w.y); b.x = bflo(w.z); b.y = bfhi(w.z); b.z = bflo(w.w); b.w = bfhi(w.w); }
__device__ __forceinline__ void adaln_phase(Frame& F, const float* gain, const float* modL, int jsh, int jsc) {
    const int gw = F.vcu * NWAVES + F.wave, NGW = F.G * NWAVES, lane = F.lane;
    const int per = (MT + NGW - 1) / NGW, r0 = gw * per, r1 = (r0 + per) < MT ? (r0 + per) : MT;
    const bf16* X = (const bf16*)(F.ws + WS_X); bf16* H = (bf16*)(F.ws + WS_H);
    int cur = -1; f32x4 gs[4][2], sh[4][2];
    for (int mb = r0; mb < r1; mb += 3) {
        u32x4 w[3][4];
#pragma unroll
        for (int i = 0; i < 3; ++i) { const int m = (mb + i) < r1 ? (mb + i) : (r1 - 1); const u32x4* xr = (const u32x4*)(X + (size_t)m * D) + lane;
#pragma unroll
            for (int j = 0; j < 4; ++j) w[i][j] = xr[64 * j]; }
#pragma unroll
        for (int i = 0; i < 3; ++i) { const int m = mb + i; if (m < r1) {
            const int cond = cond_of_row(m);
            if (cond != cur) { cur = cond;
#pragma unroll
                for (int j = 0; j < 4; ++j)
#pragma unroll
                    for (int h = 0; h < 2; ++h) { const int col = 8 * lane + 512 * j + 4 * h; const f32x4 g = *(const f32x4*)(gain + col), sc = *(const f32x4*)(modL + (size_t)cond * NMODC + jsc * 2048 + col);
                        gs[j][h] = g * (sc + 1.0f); sh[j][h] = *(const f32x4*)(modL + (size_t)cond * NMODC + jsh * 2048 + col); } }
            f32x4 v[4][2]; float ss = 0.f;
#pragma unroll
            for (int j = 0; j < 4; ++j) { unpk8(w[i][j], v[j][0], v[j][1]);
#pragma unroll
                for (int h = 0; h < 2; ++h) ss += (v[j][h].x * v[j][h].x + v[j][h].y * v[j][h].y) + (v[j][h].z * v[j][h].z + v[j][h].w * v[j][h].w); }
            const float rstd = 1.0f / sqrtf(wave_sum(ss) * (1.0f / D) + EPS);
            u32x4* o = (u32x4*)(H + (size_t)m * D) + lane;
#pragma unroll
            for (int j = 0; j < 4; ++j) { const f32x4 y0 = v[j][0] * rstd * gs[j][0] + sh[j][0], y1 = v[j][1] * rstd * gs[j][1] + sh[j][1];
                u32x4 q; q.x = pkbf(y0.x, y0.y); q.y = pkbf(y0.z, y0.w); q.z = pkbf(y1.x, y1.y); q.w = pkbf(y1.z, y1.w); o[64 * j] = q; } } }
    }
}
__device__ __forceinline__ void final_phase(Frame& F) {
    const int gw = F.vcu * NWAVES + F.wave, NGW = F.G * NWAVES, lane = F.lane;
    const bf16* X = (const bf16*)(F.ws + WS_X); const float* gain = F.a->in[36];
    f32x4 g[4][2];
#pragma unroll
    for (int j = 0; j < 4; ++j)
#pragma unroll
        for (int h = 0; h < 2; ++h) g[j][h] = *(const f32x4*)(gain + 8 * lane + 512 * j + 4 * h);
    for (int m = gw; m < MT; m += NGW) {
        const u32x4* xr = (const u32x4*)(X + (size_t)m * D) + lane; u32x4 w[4]; f32x4 v[4][2]; float ss = 0.f;
#pragma unroll
        for (int j = 0; j < 4; ++j) w[j] = xr[64 * j];
#pragma unroll
        for (int j = 0; j < 4; ++j) { unpk8(w[j], v[j][0], v[j][1]);
#pragma unroll
            for (int h = 0; h < 2; ++h) ss += (v[j][h].x * v[j][h].x + v[j][h].y * v[j][h].y) + (v[j][h].z * v[j][h].z + v[j][h].w * v[j][h].w); }
        const float rstd = 1.0f / sqrtf(wave_sum(ss) * (1.0f / D) + EPS);
        f32x4* o = (f32x4*)(F.out + O_YP + (size_t)m * D) + 2 * lane;
#pragma unroll
        for (int j = 0; j < 4; ++j) { o[128 * j] = v[j][0] * rstd * g[j][0]; o[128 * j + 1] = v[j][1] * rstd * g[j][1]; }
    }
}

typedef pg8::Unit Unit;
struct EpiSwiGLU {
    static constexpr bool PERM = true, AFTER_DRAIN = false;
    bf16* O;
    __device__ __forceinline__ void operator()(const f32x4 (&acc)[2][2][4][2], const Unit& u, int wr, int wc, int fr, int fq) const {
        const int row0 = u.pm * 256 + (u.mh > 0 ? 128 : 0) + wr * 64 + fr, col0 = u.pn * 128 + wc * 32 + 8 * fq; const int nai = u.mh < 0 ? 2 : 1;
#pragma unroll
        for (int ai = 0; ai < 2; ++ai) if (ai < nai)
#pragma unroll
            for (int m = 0; m < 4; ++m) { bf16* rowp = O + (size_t)(row0 + ai * 128 + m * 16) * DFF + col0;
                float r[8];
#pragma unroll
                for (int n = 0; n < 2; ++n)
#pragma unroll
                    for (int i = 0; i < 4; ++i) { const float g = acc[ai][0][m][n][i], uu = acc[ai][1][m][n][i]; r[4 * n + i] = g * sigmoidf_(g) * uu; }
                u32x4 w; w.x = pkbf(r[0], r[1]); w.y = pkbf(r[2], r[3]); w.z = pkbf(r[4], r[5]); w.w = pkbf(r[6], r[7]);
                *(u32x4*)rowp = w; }
    }
};
struct EpiResid {
    static constexpr bool PERM = true, AFTER_DRAIN = false;
    bf16* X; const float* gate; float s;
    __device__ __forceinline__ void operator()(const f32x4 (&acc)[2][2][4][2], const Unit& u, int wr, int wc, int fr, int fq) const {
        const int row0 = u.pm * 256 + (u.mh > 0 ? 128 : 0) + wr * 64 + fr, col0 = u.pn * 256 + wc * 32 + 8 * fq; const int nai = u.mh < 0 ? 2 : 1;
        const float* gp = gate + (size_t)cond_of_row(u.pm * 256) * NMODC + col0;
        f32x4 gv[2][2];
#pragma unroll
        for (int bj = 0; bj < 2; ++bj)
#pragma unroll
            for (int h = 0; h < 2; ++h) gv[bj][h] = *(const f32x4*)(gp + bj * 128 + 4 * h) * s;
#pragma unroll
        for (int ai = 0; ai < 2; ++ai) if (ai < nai) {
            u32x4 w[4][2];
#pragma unroll
            for (int m = 0; m < 4; ++m)
#pragma unroll
                for (int bj = 0; bj < 2; ++bj) w[m][bj] = *(const u32x4*)(X + (size_t)(row0 + ai * 128 + m * 16) * D + col0 + bj * 128);
#pragma unroll
            for (int m = 0; m < 4; ++m)
#pragma unroll
                for (int bj = 0; bj < 2; ++bj) { f32x4 x0, x1; unpk8(w[m][bj], x0, x1);
                    x0 = x0 + gv[bj][0] * acc[ai][bj][m][0]; x1 = x1 + gv[bj][1] * acc[ai][bj][m][1];
                    u32x4 q; q.x = pkbf(x0.x, x0.y); q.y = pkbf(x0.z, x0.w); q.z = pkbf(x1.x, x1.y); q.w = pkbf(x1.z, x1.w);
                    *(u32x4*)(X + (size_t)(row0 + ai * 128 + m * 16) * D + col0 + bj * 128) = q; } }
    }
};
struct EpiResid192 {
    static constexpr bool PERM = true, AFTER_DRAIN = false;
    bf16* X; const float* gate; float s;
    __device__ __forceinline__ void operator()(const f32x4 (&acc)[2][2][4][2], const Unit& u, int wr, int wc, int fr, int fq) const {
        const int col0 = u.pn * 256 + wc * 32 + 8 * fq;
#pragma unroll
        for (int ai = 0; ai < 2; ++ai) {
            const int rbase = u.pm * 192 + (ai ? 128 + wr * 32 : wr * 64), nm = ai ? 2 : 4;
            const float* gp = gate + (size_t)cond_of_row(rbase) * NMODC + col0;
            f32x4 gv[2][2];
#pragma unroll
            for (int bj = 0; bj < 2; ++bj)
#pragma unroll
                for (int h = 0; h < 2; ++h) gv[bj][h] = *(const f32x4*)(gp + bj * 128 + 4 * h) * s;
            u32x4 w[4][2];
#pragma unroll
            for (int m = 0; m < 4; ++m) if (m < nm)
#pragma unroll
                for (int bj = 0; bj < 2; ++bj) w[m][bj] = *(const u32x4*)(X + (size_t)(rbase + fr + m * 16) * D + col0 + bj * 128);
#pragma unroll
            for (int m = 0; m < 4; ++m) if (m < nm)
#pragma unroll
                for (int bj = 0; bj < 2; ++bj) { f32x4 x0, x1; unpk8(w[m][bj], x0, x1);
                    x0 = x0 + gv[bj][0] * acc[ai][bj][m][0]; x1 = x1 + gv[bj][1] * acc[ai][bj][m][1];
                    u32x4 q; q.x = pkbf(x0.x, x0.y); q.y = pkbf(x0.z, x0.w); q.z = pkbf(x1.x, x1.y); q.w = pkbf(x1.z, x1.w);
                    *(u32x4*)(X + (size_t)(rbase + fr + m * 16) * D + col0 + bj * 128) = q; } }
    }
};
struct EpiPlain {
    static constexpr bool PERM = true, AFTER_DRAIN = false;
    bf16* O; int ldc;
    __device__ __forceinline__ void operator()(const f32x4 (&acc)[2][2][4][2], const Unit& u, int wr, int wc, int fr, int fq) const {
        const int row0 = u.pm * 256 + (u.mh > 0 ? 128 : 0) + wr * 64 + fr, col0 = u.pn * 256 + wc * 32 + 8 * fq; const int nai = u.mh < 0 ? 2 : 1;
#pragma unroll
        for (int ai = 0; ai < 2; ++ai) if (ai < nai)
#pragma unroll
            for (int m = 0; m < 4; ++m) { bf16* rowp = O + (size_t)(row0 + ai * 128 + m * 16) * ldc + col0;
#pragma unroll
                for (int bj = 0; bj < 2; ++bj) { const f32x4 v0 = acc[ai][bj][m][0], v1 = acc[ai][bj][m][1];
                    u32x4 w; w.x = pkbf(v0[0], v0[1]); w.y = pkbf(v0[2], v0[3]); w.z = pkbf(v1[0], v1[1]); w.w = pkbf(v1[2], v1[3]);
                    *(u32x4*)(rowp + bj * 128) = w; } }
    }
};
__device__ __forceinline__ void vt_store8(bf16* VT, int C, int pm, int c, int r, const f32x4& v0, const f32x4& v1) {
    bf16* p = VT + ((size_t)pm * C + c) * 256 + r;
    const unsigned w0 = pkbf(v0[0], v0[1]), w1 = pkbf(v0[2], v0[3]), w2 = pkbf(v1[0], v1[1]), w3 = pkbf(v1[2], v1[3]);
    p[0 * 256] = (bf16)(w0 & 0xffffu); p[1 * 256] = (bf16)(w0 >> 16); p[2 * 256] = (bf16)(w1 & 0xffffu); p[3 * 256] = (bf16)(w1 >> 16);
    p[4 * 256] = (bf16)(w2 & 0xffffu); p[5 * 256] = (bf16)(w2 >> 16); p[6 * 256] = (bf16)(w3 & 0xffffu); p[7 * 256] = (bf16)(w3 >> 16);
}
struct EpiAB {
    static constexpr bool PERM = true, AFTER_DRAIN = false;
    bf16 *XAGA, *QB, *KB, *VT; float* ock; float* ocv; int j;
    __device__ __forceinline__ void operator()(const f32x4 (&acc)[2][2][4][2], const Unit& u, int wr, int wc, int fr, int fq) const {
        const int rt0 = wr * 64 + fr, ct0 = wc * 32 + 8 * fq;
        const int pn = u.pn, pm = u.pm;
        if (pn < 16) {
            char* dst; int ldc; float sc = 1.0f;
            if (pn < 8) { dst = (char*)(XAGA + pn * 256); ldc = 2048; } else if (pn < 12) { dst = (char*)(QB + (pn - 8) * 256); ldc = 1024; sc = QS64; } else { dst = (char*)(KB + (pn - 12) * 256); ldc = 1024; }
            dst += (size_t)pm * 256 * ldc * 2;
            const unsigned vo = (unsigned)(rt0 * ldc + ct0) * 2u;
            const bool cache = pn >= 12 && pm < 16;
            char* oc = (char*)(ock + ((size_t)(pm * 2 + j) * 256) * 1024 + (pn - 12) * 256);
            const unsigned vc = (unsigned)(rt0 * 1024 + ct0) * 4u;
#pragma unroll
            for (int ai = 0; ai < 2; ++ai)
#pragma unroll
                for (int m = 0; m < 4; ++m) { const int ro = ai * 128 + m * 16;
#pragma unroll
                    for (int bj = 0; bj < 2; ++bj) { const f32x4 v0 = acc[ai][bj][m][0] * sc, v1 = acc[ai][bj][m][1] * sc;
                        u32x4 w; w.x = pkbf(v0[0], v0[1]); w.y = pkbf(v0[2], v0[3]); w.z = pkbf(v1[0], v1[1]); w.w = pkbf(v1[2], v1[3]);
                        *(u32x4*)(dst + (size_t)(ro * ldc + bj * 128) * 2 + vo) = w;
                        if (cache) { char* o = oc + (size_t)(ro * 1024 + bj * 128) * 4; *(f32x4*)(o + vc) = v0; *(f32x4*)(o + vc + 16) = v1; } }
                    asm volatile("" ::: "memory"); }
        } else {
            const int c0 = (pn - 16) * 256;
            char* vt = (char*)(VT + ((size_t)pm * 1024 + c0) * 256);
            const unsigned vv = (unsigned)(ct0 * 256 + rt0) * 2u;
            char* oc = (char*)(ocv + ((size_t)(pm * 2 + j) * 256) * 1024 + c0);
            const unsigned vc = (unsigned)(rt0 * 1024 + ct0) * 4u;
#pragma unroll
            for (int ai = 0; ai < 2; ++ai)
#pragma unroll
                for (int m = 0; m < 4; ++m) { const int ro = ai * 128 + m * 16;
#pragma unroll
                    for (int bj = 0; bj < 2; ++bj) { const f32x4 v0 = acc[ai][bj][m][0], v1 = acc[ai][bj][m][1];
                        const unsigned w0 = pkbf(v0[0], v0[1]), w1 = pkbf(v0[2], v0[3]), w2 = pkbf(v1[0], v1[1]), w3 = pkbf(v1[2], v1[3]);
                        char* p = vt + (size_t)(bj * 128 * 256 + ro) * 2;
                        *(bf16*)(p + vv + 0 * 512) = (bf16)(w0 & 0xffffu); *(bf16*)(p + vv + 1 * 512) = (bf16)(w0 >> 16); *(bf16*)(p + vv + 2 * 512) = (bf16)(w1 & 0xffffu); *(bf16*)(p + vv + 3 * 512) = (bf16)(w1 >> 16);
                        *(bf16*)(p + vv + 4 * 512) = (bf16)(w2 & 0xffffu); *(bf16*)(p + vv + 5 * 512) = (bf16)(w2 >> 16); *(bf16*)(p + vv + 6 * 512) = (bf16)(w3 & 0xffffu); *(bf16*)(p + vv + 7 * 512) = (bf16)(w3 >> 16);
                        if (pm < 16) { char* o = oc + (size_t)(ro * 1024 + bj * 128) * 4; *(f32x4*)(o + vc) = v0; *(f32x4*)(o + vc + 16) = v1; } }
                    asm volatile("" ::: "memory"); }
        }
    }
};
struct EpiQD {
    static constexpr bool PERM = false, AFTER_DRAIN = false;
    bf16* QD; const float* rope;
    __device__ __forceinline__ void operator()(const f32x4 (&acc)[2][2][4][2], const Unit& u, int wr, int wc, int fr, int fq) const {
        const bool smp = u.pm >= 16; const int nai = u.mh < 0 ? 2 : 1, mho = u.mh > 0 ? 128 : 0;
#pragma unroll
        for (int ai = 0; ai < 2; ++ai) if (ai < nai)
#pragma unroll
            for (int m = 0; m < 4; ++m) { const int row = u.pm * 256 + mho + ai * 128 + wr * 64 + m * 16 + fr; const int t = (row - MP) & 1023;
#pragma unroll
                for (int bj = 0; bj < 2; ++bj) { const int cg = u.pn * 256 + bj * 128 + wc * 32; const int eg = cg % 192;
                    f32x4 x1 = acc[ai][bj][m][0], x2 = acc[ai][bj][m][1];
                    if (smp && eg >= 128) { const int pos = (eg == 160) ? (t & 63) : (t >> 6);
                        const f32x4 cs = *(const f32x4*)(rope + pos * 16 + 4 * fq), sn = *(const f32x4*)(rope + 1024 + pos * 16 + 4 * fq);
                        const f32x4 o1 = x1 * cs - x2 * sn, o2 = x2 * cs + x1 * sn; x1 = o1; x2 = o2; }
                    x1 = x1 * QS192; x2 = x2 * QS192;
                    bf16* p = QD + (size_t)row * 1536 + cg + 4 * fq;
                    u32x2 w1; w1.x = pkbf(x1[0], x1[1]); w1.y = pkbf(x1[2], x1[3]); *(u32x2*)p = w1;
                    u32x2 w2; w2.x = pkbf(x2[0], x2[1]); w2.y = pkbf(x2[2], x2[3]); *(u32x2*)(p + 16) = w2; } }
    }
};
struct EpiKNV {
    static constexpr bool PERM = true, AFTER_DRAIN = false;
    bf16 *KN, *VDT;
    __device__ __forceinline__ void operator()(const f32x4 (&acc)[2][2][4][2], const Unit& u, int wr, int wc, int fr, int fq) const {
        const int rt0 = wr * 64 + fr, ct0 = wc * 32 + 8 * fq;
        if (u.pn < 4) { char* dst = (char*)(KN + (size_t)u.pm * 256 * 1024 + u.pn * 256); const unsigned vo = (unsigned)(rt0 * 1024 + ct0) * 2u;
#pragma unroll
            for (int ai = 0; ai < 2; ++ai)
#pragma unroll
                for (int m = 0; m < 4; ++m) { const int ro = ai * 128 + m * 16;
#pragma unroll
                    for (int bj = 0; bj < 2; ++bj) { const f32x4 v0 = acc[ai][bj][m][0], v1 = acc[ai][bj][m][1];
                        u32x4 w; w.x = pkbf(v0[0], v0[1]); w.y = pkbf(v0[2], v0[3]); w.z = pkbf(v1[0], v1[1]); w.w = pkbf(v1[2], v1[3]);
                        *(u32x4*)(dst + (size_t)(ro * 1024 + bj * 128) * 2 + vo) = w; }
                    asm volatile("" ::: "memory"); }
        } else { char* vt = (char*)(VDT + ((size_t)u.pm * 1024 + (u.pn - 4) * 256) * 256); const unsigned vv = (unsigned)(ct0 * 256 + rt0) * 2u;
#pragma unroll
            for (int ai = 0; ai < 2; ++ai)
#pragma unroll
                for (int m = 0; m < 4; ++m) { const int ro = ai * 128 + m * 16;
#pragma unroll
                    for (int bj = 0; bj < 2; ++bj) { const f32x4 v0 = acc[ai][bj][m][0], v1 = acc[ai][bj][m][1];
                        const unsigned w0 = pkbf(v0[0], v0[1]), w1 = pkbf(v0[2], v0[3]), w2 = pkbf(v1[0], v1[1]), w3 = pkbf(v1[2], v1[3]);
                        char* p = vt + (size_t)(bj * 128 * 256 + ro) * 2;
                        *(bf16*)(p + vv + 0 * 512) = (bf16)(w0 & 0xffffu); *(bf16*)(p + vv + 1 * 512) = (bf16)(w0 >> 16); *(bf16*)(p + vv + 2 * 512) = (bf16)(w1 & 0xffffu); *(bf16*)(p + vv + 3 * 512) = (bf16)(w1 >> 16);
                        *(bf16*)(p + vv + 4 * 512) = (bf16)(w2 & 0xffffu); *(bf16*)(p + vv + 5 * 512) = (bf16)(w2 >> 16); *(bf16*)(p + vv + 6 * 512) = (bf16)(w3 & 0xffffu); *(bf16*)(p + vv + 7 * 512) = (bf16)(w3 >> 16); }
                    asm volatile("" ::: "memory"); }
        }
    }
};

__device__ __forceinline__ void prow16(float x, float& lo, float& hi) { auto s_ = __builtin_amdgcn_permlane16_swap(__float_as_uint(x), __float_as_uint(x), false, false); lo = __uint_as_float(s_[0]); hi = __uint_as_float(s_[1]); }
__device__ __forceinline__ void prow32(float x, float& lo, float& hi) { auto s_ = __builtin_amdgcn_permlane32_swap(__float_as_uint(x), __float_as_uint(x), false, false); lo = __uint_as_float(s_[0]); hi = __uint_as_float(s_[1]); }
__device__ __forceinline__ float rows_up16(float x, int fq) { float a, b, c, d, e, f; prow16(x, a, b); prow32(x, c, d); prow16(c, e, f); return fq == 2 ? f : a; }
__device__ __forceinline__ float rows_up32(float x) { float c, d; prow32(x, c, d); return c; }
__device__ __forceinline__ float rows_last(float x) { float c, d, e, f; prow32(x, c, d); prow16(d, e, f); return f; }
__device__ __forceinline__ float rows_dn16(float x, int fq) { float a, b, c, d, e, f; prow16(x, a, b); prow32(x, c, d); prow16(d, e, f); return fq == 1 ? e : b; }
__device__ __forceinline__ float rows_dn32(float x) { float c, d; prow32(x, c, d); return d; }
__device__ __forceinline__ float rows_first(float x) { float c, d, e, f; prow32(x, c, d); prow16(c, e, f); return e; }
__device__ __forceinline__ void lru_scan_store(const float (&a)[4][4], const float (&u)[4][4], bool rev, int fr, int fq, bf16* Ao, bf16* Ho, float& TAo, float& TUo) {
    float cA = 1.f, cU = 0.f;
#pragma unroll
    for (int mi = 0; mi < 4; ++mi) { const int mt = rev ? 3 - mi : mi;
        float ia[4], iu[4]; float A, U;
        if (!rev) { A = a[mt][0]; U = u[mt][0]; ia[0] = A; iu[0] = U;
#pragma unroll
            for (int r = 1; r < 4; ++r) { U = a[mt][r] * U + u[mt][r]; A *= a[mt][r]; ia[r] = A; iu[r] = U; } }
        else { A = a[mt][3]; U = u[mt][3]; ia[3] = A; iu[3] = U;
#pragma unroll
            for (int r = 2; r >= 0; --r) { U = a[mt][r] * U + u[mt][r]; A *= a[mt][r]; ia[r] = A; iu[r] = U; } }
        float PA = A, PU = U, qa, qu, EA, EU, TA, TU;
        if (!rev) {
            qa = rows_up16(PA, fq); qu = rows_up16(PU, fq); if (fq >= 1) { PU = PA * qu + PU; PA = qa * PA; }
            qa = rows_up32(PA); qu = rows_up32(PU); if (fq >= 2) { PU = PA * qu + PU; PA = qa * PA; }
            EA = rows_up16(PA, fq); EU = rows_up16(PU, fq); if (fq == 0) { EA = 1.f; EU = 0.f; }
            TA = rows_last(PA); TU = rows_last(PU);
        } else {
            qa = rows_dn16(PA, fq); qu = rows_dn16(PU, fq); if (fq <= 2) { PU = PA * qu + PU; PA = qa * PA; }
            qa = rows_dn32(PA); qu = rows_dn32(PU); if (fq <= 1) { PU = PA * qu + PU; PA = qa * PA; }
            EA = rows_dn16(PA, fq); EU = rows_dn16(PU, fq); if (fq == 3) { EA = 1.f; EU = 0.f; }
            TA = rows_first(PA); TU = rows_first(PU);
        }
        const float preA = cA * EA, preU = EA * cU + EU;
#pragma unroll
        for (int r = 0; r < 4; ++r) { const float Ac = preA * ia[r], Hc = ia[r] * preU + iu[r]; const size_t off = (size_t)(16 * mt + 4 * fq + r) * 1024;
            Ao[off] = (bf16)(pkbf(Ac, 0.f) & 0xffffu); Ho[off] = (bf16)(pkbf(Hc, 0.f) & 0xffffu); }
        cU = TA * cU + TU; cA = cA * TA;
    }
    TAo = cA; TUo = cU;
}
__device__ __forceinline__ void lru_l1_item(Frame& F, int j, int item, LAS float* scr) {
    const int tt = item >> 4, n = item & 15, lane = F.lane, fr = lane & 15, fq = lane >> 4;
    const int m0 = tt * 64;
    const int s0 = m0 < MP ? (m0 & ~255) : MP + ((m0 - MP) & ~1023);
    const int Lq = m0 < MP ? 256 : 1024, t0 = m0 - s0;
    const bf16* XA = (const bf16*)(F.ws + WS_XAGA);
    const float* convw = F.a->in[18] + (size_t)j * 4 * 1024; const float* convb = F.a->in[19] + (size_t)j * 1024;
    bf16x8 af[4][2];
#pragma unroll
    for (int ks = 0; ks < 2; ++ks) { const int ch0 = 64 * n + 32 * ks + 8 * fq;
        float w[4][8], cb[8];
#pragma unroll
        for (int jj = 0; jj < 4; ++jj) { const f32x4 a = *(const f32x4*)(convw + jj * 1024 + ch0), b = *(const f32x4*)(convw + jj * 1024 + ch0 + 4);
            w[jj][0] = a.x; w[jj][1] = a.y; w[jj][2] = a.z; w[jj][3] = a.w; w[jj][4] = b.x; w[jj][5] = b.y; w[jj][6] = b.z; w[jj][7] = b.w; }
        { const f32x4 a = *(const f32x4*)(convb + ch0), b = *(const f32x4*)(convb + ch0 + 4); cb[0] = a.x; cb[1] = a.y; cb[2] = a.z; cb[3] = a.w; cb[4] = b.x; cb[5] = b.y; cb[6] = b.z; cb[7] = b.w; }
        u32x4 xin[4][4];
#pragma unroll
        for (int mt = 0; mt < 4; ++mt)
#pragma unroll
            for (int jj = 0; jj < 4; ++jj) { int tq = t0 + 16 * mt + fr + jj - 2; tq = tq < 0 ? 0 : (tq > Lq - 1 ? Lq - 1 : tq); xin[mt][jj] = *(const u32x4*)(XA + (size_t)(s0 + tq) * 2048 + ch0); }
#pragma unroll
        for (int mt = 0; mt < 4; ++mt) { const int t = t0 + 16 * mt + fr;
            float acc[8];
#pragma unroll
            for (int e = 0; e < 8; ++e) acc[e] = cb[e];
#pragma unroll
            for (int jj = 0; jj < 4; ++jj) { const int tq = t + jj - 2; const bool in = tq >= 0 && tq < Lq;
                u32x4 xv = xin[mt][jj]; xv.x = in ? xv.x : 0u; xv.y = in ? xv.y : 0u; xv.z = in ? xv.z : 0u; xv.w = in ? xv.w : 0u;
                acc[0] += bflo(xv.x) * w[jj][0]; acc[1] += bfhi(xv.x) * w[jj][1]; acc[2] += bflo(xv.y) * w[jj][2]; acc[3] += bfhi(xv.y) * w[jj][3];
                acc[4] += bflo(xv.z) * w[jj][4]; acc[5] += bfhi(xv.z) * w[jj][5]; acc[6] += bflo(xv.w) * w[jj][6]; acc[7] += bfhi(xv.w) * w[jj][7]; }
            LAS float* sp = scr + (16 * mt + fr) * 65 + 32 * ks + 8 * fq;
#pragma unroll
            for (int e = 0; e < 8; ++e) sp[e] = acc[e];
            u32x4 pk; pk.x = pkbf(acc[0], acc[1]); pk.y = pkbf(acc[2], acc[3]); pk.z = pkbf(acc[4], acc[5]); pk.w = pkbf(acc[6], acc[7]);
            af[mt][ks] = __builtin_bit_cast(bf16x8, pk); } }
    LDS_WAIT();
#pragma unroll 1
    for (int dir = 0; dir < 2; ++dir) {
        const bf16* waT = (const bf16*)(F.ws + WS_LRUW) + ((size_t)((j * 2 + dir) * 2 + 0) * 16 + n) * 4096;
        const bf16* wxT = waT + (size_t)16 * 4096;
        bf16* Ao = (bf16*)(F.ws + WS_LRU) + (size_t)(dir * 2 + 0) * MT * 1024; bf16* Ho = (bf16*)(F.ws + WS_LRU) + (size_t)(dir * 2 + 1) * MT * 1024;
#pragma unroll 1
        for (int nt = 0; nt < 4; ++nt) {
            const int ch = 64 * n + 16 * nt + fr;
            bf16x8 ba[2], bx[2];
#pragma unroll
            for (int ks = 0; ks < 2; ++ks) { ba[ks] = ld16(waT + (16 * nt + fr) * 64 + 32 * ks + 8 * fq); bx[ks] = ld16(wxT + (16 * nt + fr) * 64 + 32 * ks + 8 * fq); }
            const float bav = F.a->in[21][(size_t)(j * 2 + dir) * 1024 + ch], bxv = F.a->in[23][(size_t)(j * 2 + dir) * 1024 + ch], lam = F.a->in[24][(size_t)(j * 2 + dir) * 1024 + ch];
            const float clam = -8.0f * log1pf(expf(-lam));
            float a[4][4], u[4][4];
#pragma unroll
            for (int mt = 0; mt < 4; ++mt) { f32x4 ra = (f32x4){0.f, 0.f, 0.f, 0.f}, ga = (f32x4){0.f, 0.f, 0.f, 0.f};
#pragma unroll
                for (int ks = 0; ks < 2; ++ks) { ra = __builtin_amdgcn_mfma_f32_16x16x32_bf16(af[mt][ks], ba[ks], ra, 0, 0, 0); ga = __builtin_amdgcn_mfma_f32_16x16x32_bf16(af[mt][ks], bx[ks], ga, 0, 0, 0); }
#pragma unroll
                for (int r = 0; r < 4; ++r) { const float rg = sigmoidf_(ra[r] + bav), gi = sigmoidf_(ga[r] + bxv); const float la = clam * rg;
                    const float av = fexp2(la * LOG2E), x2 = 2.0f * la;
                    const float m2s = -x2 * (1.0f + x2 * (0.5f + x2 * (0.16666667f + x2 * (0.041666668f + x2 * (0.0083333338f + x2 * 0.0013888889f)))));
                    const float m2 = x2 > -0.5f ? m2s : 1.0f - av * av;
                    const float mult = __builtin_amdgcn_sqrtf(m2); const float xcv = scr[(16 * mt + 4 * fq + r) * 65 + 16 * nt + fr];
                    a[mt][r] = av; u[mt][r] = mult * gi * xcv; } }
            float TA, TU;
            lru_scan_store(a, u, dir == 1, fr, fq, Ao + (size_t)m0 * 1024 + ch, Ho + (size_t)m0 * 1024 + ch, TA, TU);
            if (fq == 0) { float* ag = (float*)(F.ws + WS_AGG) + ((size_t)(tt * 2 + dir) * 2) * 1024 + ch; ag[0] = TA; ag[1024] = TU; }
        }
    }
    LDS_WAIT();
}
__device__ __forceinline__ float gelu_tanh(float x) { const float z = 0.7978845608028654f * (x + 0.044715f * x * x * x); const float e = fexp2(2.0f * LOG2E * z); const float th = 1.0f - 2.0f * frcp(e + 1.0f); return 0.5f * x * (1.0f + th); }
__device__ __forceinline__ void lru_l3_item(Frame& F, int j, int item) {
    const int tt = item >> 5, rs = (item >> 2) & 7, q = item & 3, lane = F.lane, c0 = 256 * q + 4 * lane;
    const int m0 = tt * 64; const bool smp = m0 >= MP;
    const int s0 = smp ? MP + ((m0 - MP) & ~1023) : (m0 & ~255);
    const int first = s0 >> 6, last = first + (smp ? 16 : 4) - 1;
    const float* AG = (const float*)(F.ws + WS_AGG);
    const bf16* AF = (const bf16*)(F.ws + WS_LRU); const bf16* HF = AF + (size_t)MT * 1024; const bf16* AB = HF + (size_t)MT * 1024; const bf16* HB = AB + (size_t)MT * 1024;
    const bf16* GA = (const bf16*)(F.ws + WS_XAGA) + 1024; bf16* Y = (bf16*)(F.ws + WS_YCAT);
    u32x2 af[8], hf[8], ab[8], hb[8], ga[8];
#pragma unroll
    for (int r = 0; r < 8; ++r) { const size_t m = (size_t)m0 + 8 * rs + r, o = m * 1024 + c0;
        af[r] = *(const u32x2*)(AF + o); hf[r] = *(const u32x2*)(HF + o); ab[r] = *(const u32x2*)(AB + o); hb[r] = *(const u32x2*)(HB + o); ga[r] = *(const u32x2*)(GA + m * 2048 + c0); }
    f32x4 cf = (f32x4){0.f, 0.f, 0.f, 0.f}, cb = cf;
    if (smp) { const int b = (m0 - MP) >> 10; cf = *(const f32x4*)(F.a->in[2] + ((size_t)b * 2 + j) * 1024 + c0); cb = *(const f32x4*)(F.a->in[3] + ((size_t)b * 2 + j) * 1024 + c0); }
    for (int p = first; p < tt; ++p) { const f32x4 A = *(const f32x4*)(AG + ((size_t)(p * 2 + 0) * 2 + 0) * 1024 + c0), U = *(const f32x4*)(AG + ((size_t)(p * 2 + 0) * 2 + 1) * 1024 + c0); cf = A * cf + U; }
    for (int p = last; p > tt; --p) { const f32x4 A = *(const f32x4*)(AG + ((size_t)(p * 2 + 1) * 2 + 0) * 1024 + c0), U = *(const f32x4*)(AG + ((size_t)(p * 2 + 1) * 2 + 1) * 1024 + c0); cb = A * cb + U; }
#pragma unroll
    for (int r = 0; r < 8; ++r) { const size_t m = (size_t)m0 + 8 * rs + r;
        f32x4 vf, vb, g;
        vf.x = bflo(af[r].x) * cf.x + bflo(hf[r].x); vf.y = bfhi(af[r].x) * cf.y + bfhi(hf[r].x); vf.z = bflo(af[r].y) * cf.z + bflo(hf[r].y); vf.w = bfhi(af[r].y) * cf.w + bfhi(hf[r].y);
        vb.x = bflo(ab[r].x) * cb.x + bflo(hb[r].x); vb.y = bfhi(ab[r].x) * cb.y + bfhi(hb[r].x); vb.z = bflo(ab[r].y) * cb.z + bflo(hb[r].y); vb.w = bfhi(ab[r].y) * cb.w + bfhi(hb[r].y);
        g.x = gelu_tanh(bflo(ga[r].x)); g.y = gelu_tanh(bfhi(ga[r].x)); g.z = gelu_tanh(bflo(ga[r].y)); g.w = gelu_tanh(bfhi(ga[r].y));
        const f32x4 y = (vf + vb) * g;
        u32x2 w; w.x = pkbf(y.x, y.y); w.y = pkbf(y.z, y.w);
        *(u32x2*)(Y + m * 2048 + c0) = w;
        if (!smp) { const int t = (int)(m - s0), b = s0 >> 8;
            if (t == 255) *(f32x4*)(F.out + O_SF + ((size_t)b * 2 + j) * 1024 + c0) = vf;
            if (t == 0) *(f32x4*)(F.out + O_SB + ((size_t)b * 2 + j) * 1024 + c0) = vb; }
    }
}

__device__ __forceinline__ float xrow16_max(float x) {
    auto s = __builtin_amdgcn_permlane16_swap(__float_as_uint(x), __float_as_uint(x), false, false); x = fmaxf(__uint_as_float(s[0]), __uint_as_float(s[1]));
    auto t = __builtin_amdgcn_permlane32_swap(__float_as_uint(x), __float_as_uint(x), false, false); return fmaxf(__uint_as_float(t[0]), __uint_as_float(t[1]));
}
__device__ __forceinline__ float xrow16_sum(float x) {
    auto s = __builtin_amdgcn_permlane16_swap(__float_as_uint(x), __float_as_uint(x), false, false); x = __uint_as_float(s[0]) + __uint_as_float(s[1]);
    auto t = __builtin_amdgcn_permlane32_swap(__float_as_uint(x), __float_as_uint(x), false, false); return __uint_as_float(t[0]) + __uint_as_float(t[1]);
}
template <int NKS, int NDT, int QT, class Src>
__device__ __forceinline__ void attn_core(const Src& S, const bf16x8 (&qf)[QT][NKS], f32x4 (&o)[QT][NDT], float (&lsum)[QT]) {
    float mrun[QT];
#pragma unroll
    for (int qt = 0; qt < QT; ++qt) { mrun[qt] = -1e30f; lsum[qt] = 0.f;
#pragma unroll
        for (int dt = 0; dt < NDT; ++dt) o[qt][dt] = (f32x4){0.f, 0.f, 0.f, 0.f}; }
    bf16x8 kf[2][NKS], vf[NDT];
    const int nt = S.ntiles();
    S.loadk(0, kf); S.loadv(0, vf);
#pragma unroll 1
    for (int i = 0; i < nt; ++i) {
        f32x4 sc[QT][2];
#pragma unroll
        for (int qt = 0; qt < QT; ++qt)
#pragma unroll
            for (int s = 0; s < 2; ++s) { f32x4 a = (f32x4){0.f, 0.f, 0.f, 0.f};
#pragma unroll
                for (int ks = 0; ks < NKS; ++ks) a = __builtin_amdgcn_mfma_f32_16x16x32_bf16(kf[s][ks], qf[qt][ks], a, 0, 0, 0);
                sc[qt][s] = a; }
        if (i + 1 < nt) S.loadk(i + 1, kf);
#pragma unroll
        for (int qt = 0; qt < QT; ++qt) {
            S.adjust(i, qt, sc[qt]);
            float tm = fmaxf(fmaxf(fmaxf(sc[qt][0][0], sc[qt][0][1]), fmaxf(sc[qt][0][2], sc[qt][0][3])), fmaxf(fmaxf(sc[qt][1][0], sc[qt][1][1]), fmaxf(sc[qt][1][2], sc[qt][1][3])));
            tm = xrow16_max(tm);
            const float mn = fmaxf(mrun[qt], tm), alpha = fexp2(mrun[qt] - mn); mrun[qt] = mn;
            float p[8]; float ps = 0.f;
#pragma unroll
            for (int s = 0; s < 2; ++s)
#pragma unroll
                for (int r = 0; r < 4; ++r) { p[4 * s + r] = fexp2(sc[qt][s][r] - mn); ps += p[4 * s + r]; }
            lsum[qt] = lsum[qt] * alpha + ps;
#pragma unroll
            for (int dt = 0; dt < NDT; ++dt) o[qt][dt] = o[qt][dt] * alpha;
            u32x4 pk; pk.x = pkbf(p[0], p[1]); pk.y = pkbf(p[2], p[3]); pk.z = pkbf(p[4], p[5]); pk.w = pkbf(p[6], p[7]);
            const bf16x8 pf = __builtin_bit_cast(bf16x8, pk);
#pragma unroll
            for (int dt = 0; dt < NDT; ++dt) o[qt][dt] = __builtin_amdgcn_mfma_f32_16x16x32_bf16(vf[dt], pf, o[qt][dt], 0, 0, 0);
        }
        if (i + 1 < nt) S.loadv(i + 1, vf);
    }
}
template <int NDT>
__device__ __forceinline__ void attn_store(const f32x4 (&o)[NDT], float lsum, bf16* yrow  , int fq) {
    const float l = xrow16_sum(lsum);
    const float inv = 1.0f / l;
#pragma unroll
    for (int dt = 0; dt < NDT; ++dt) { const f32x4 v = o[dt] * inv; u32x2 w; w.x = pkbf(v[0], v[1]); w.y = pkbf(v[2], v[3]); *(u32x2*)(yrow + 16 * dt + 4 * fq) = w; }
}
template <int NKS, int NDT, bool MLA>
struct SegSrc {
    const bf16 *kA, *kB, *rA, *rB, *vA, *vB;
    int nA, nt, ldk, vts, kap0, kap1;
    __device__ __forceinline__ int ntiles() const { return nt; }
    __device__ __forceinline__ void loadk(int i, bf16x8 (&kf)[2][NKS]) const {
        const bool sb = i >= nA; const int key0 = 32 * (sb ? i - nA : i); const bf16* kb = sb ? kB : kA;
        const bf16* p0 = kb + (size_t)(key0 + kap0) * ldk; const bf16* p1 = kb + (size_t)(key0 + kap1) * ldk;
#pragma unroll
        for (int ks = 0; ks < (MLA ? 4 : NKS); ++ks) { kf[0][ks] = ld16(p0 + 32 * ks); kf[1][ks] = ld16(p1 + 32 * ks); }
        if (MLA) { const bf16* rb = sb ? rB : rA; const bf16* r0 = rb + (size_t)(key0 + kap0) * 64; const bf16* r1 = rb + (size_t)(key0 + kap1) * 64;
#pragma unroll
            for (int ks = 4; ks < NKS; ++ks) { kf[0][ks] = ld16(r0 + 32 * (ks - 4)); kf[1][ks] = ld16(r1 + 32 * (ks - 4)); } }
    }
    __device__ __forceinline__ void loadv(int i, bf16x8 (&vf)[NDT]) const {
        const bool sb = i >= nA; const int key0 = 32 * (sb ? i - nA : i); const bf16* p = (sb ? vB : vA) + (size_t)(key0 >> 8) * vts + (key0 & 255);
#pragma unroll
        for (int dt = 0; dt < NDT; ++dt) vf[dt] = ld16(p + dt * 16 * 256);
    }
    __device__ __forceinline__ void adjust(int, int, f32x4 (&)[2]) const {}
};
struct NaSrc {
    const bf16 *kloc, *kctx, *vloc, *vctx; const float* bias;
    int r, rstart, cs, qcol, cstq, kap0, kap1, fq;
    __device__ __forceinline__ int ntiles() const { return 24; }
    __device__ __forceinline__ void loadk(int i, bf16x8 (&kf)[2][2]) const {
        const bf16* kb; int key0;
        if (i < 8) { kb = kloc; key0 = 64 * (rstart + i) + cs; } else { kb = kctx; key0 = 32 * (i - 8); }
        const bf16* p0 = kb + (size_t)(key0 + kap0) * 1024; const bf16* p1 = kb + (size_t)(key0 + kap1) * 1024;
        kf[0][0] = ld16(p0); kf[0][1] = ld16(p0 + 32); kf[1][0] = ld16(p1); kf[1][1] = ld16(p1 + 32);
    }
    __device__ __forceinline__ void loadv(int i, bf16x8 (&vf)[4]) const {
        const bf16* vb; int key0;
        if (i < 8) { vb = vloc; key0 = 64 * (rstart + i) + cs; } else { vb = vctx; key0 = 32 * (i - 8); }
        const bf16* p = vb + (size_t)(key0 >> 8) * (1024 * 256) + (key0 & 255);
#pragma unroll
        for (int dt = 0; dt < 4; ++dt) vf[dt] = ld16(p + dt * 16 * 256);
    }
    __device__ __forceinline__ void adjust(int i, int, f32x4 (&sc)[2]) const {
        if (i < 8) { const int relr = rstart + i - r + 7;
#pragma unroll
            for (int s = 0; s < 2; ++s)
#pragma unroll
                for (int g = 0; g < 4; ++g) { const int ck = cs + 8 * fq + 4 * s + g; const bool ok = ck >= cstq && ck < cstq + 16; int relc = ck - qcol + 15; relc = relc < 0 ? 0 : (relc > 30 ? 30 : relc);
                    const float bv = bias[relr * 31 + relc]; sc[s][g] = ok ? sc[s][g] + bv * LOG2E : -1e30f; } }
    }
};

__device__ __forceinline__ void na_item(Frame& F, int j, int item) {
    const int qi = item & 3, r = (item >> 2) & 15, h = (item >> 6) & 15, b = item >> 10, lane = F.lane, fr = lane & 15, fq = lane >> 4;
    const int srow = MP + b * 1024, c0 = 16 * qi, qcol = c0 + fr;
    const int cs = qi == 0 ? 0 : (qi == 1 ? 8 : (qi == 2 ? 24 : 32));
    const int rs = r - 4 < 0 ? 0 : (r - 4 > 8 ? 8 : r - 4);
    NaSrc S; S.r = r; S.rstart = rs; S.cs = cs; S.qcol = qcol; S.cstq = qcol - 8 < 0 ? 0 : (qcol - 8 > 48 ? 48 : qcol - 8); S.fq = fq;
    S.kap0 = 8 * (fr >> 2) + (fr & 3); S.kap1 = S.kap0 + 4;
    S.kloc = (const bf16*)(F.ws + WS_KB) + (size_t)srow * 1024 + h * 64 + 8 * fq;
    S.kctx = (const bf16*)(F.ws + WS_KCNA) + (size_t)(b * 2 + j) * 512 * 1024 + h * 64 + 8 * fq;
    S.vloc = (const bf16*)(F.ws + WS_VT) + ((size_t)(srow >> 8) * 1024 + h * 64 + fr) * 256 + 8 * fq;
    S.vctx = (const bf16*)(F.ws + WS_VTCNA) + ((size_t)((b * 2 + j) * 2) * 1024 + h * 64 + fr) * 256 + 8 * fq;
    S.bias = F.a->in[25] + (size_t)(j * 16 + h) * 15 * 31;
    const size_t qrow = (size_t)srow + 64 * r + qcol;
    bf16x8 qf[1][2]; const bf16* qp = (const bf16*)(F.ws + WS_QB) + qrow * 1024 + h * 64 + 8 * fq; qf[0][0] = ld16(qp); qf[0][1] = ld16(qp + 32);
    f32x4 o[1][4]; float ls[1];
    attn_core<2, 4, 1, NaSrc>(S, qf, o, ls);
    attn_store<4>(o[0], ls[0], (bf16*)(F.ws + WS_YCAT) + qrow * 2048 + 1024 + h * 64, fq);
}
template <int QT>
__device__ __forceinline__ void dense64_item(Frame& F, const bf16* Q, int ldq, size_t qrow0, int qstep, int qcol0, int qcstep, bf16* Y, int ycol0, int ycstep,
                                             const bf16* KA, const bf16* VA, int nA, const bf16* KB_, const bf16* VB_, int nB, int ldk, int vts) {
    const int lane = F.lane, fr = lane & 15, fq = lane >> 4;
    SegSrc<2, 4, false> S; S.kap0 = 8 * (fr >> 2) + (fr & 3); S.kap1 = S.kap0 + 4; S.nA = nA; S.nt = nA + nB; S.ldk = ldk; S.vts = vts;
    S.kA = KA + 8 * fq; S.kB = KB_ + 8 * fq; S.rA = nullptr; S.rB = nullptr; S.vA = VA + (size_t)fr * 256 + 8 * fq; S.vB = VB_ + (size_t)fr * 256 + 8 * fq;
    bf16x8 qf[QT][2];
#pragma unroll
    for (int qt = 0; qt < QT; ++qt) { const bf16* qp = Q + (qrow0 + (size_t)qstep * qt + fr) * ldq + qcol0 + qcstep * qt + 8 * fq; qf[qt][0] = ld16(qp); qf[qt][1] = ld16(qp + 32); }
    f32x4 o[QT][4]; float ls[QT];
    attn_core<2, 4, QT, SegSrc<2, 4, false>>(S, qf, o, ls);
#pragma unroll
    for (int qt = 0; qt < QT; ++qt) attn_store<4>(o[qt], ls[qt], Y + (qrow0 + (size_t)qstep * qt + fr) * 2048 + ycol0 + ycstep * qt, fq);
}
__device__ __forceinline__ void mla_item(Frame& F, int j, int h, size_t qrow0, size_t krowA, int nA, size_t krowB, int nB) {
    const int lane = F.lane, fr = lane & 15, fq = lane >> 4;
    const bf16* KN = (const bf16*)(F.ws + WS_KN); const bf16* KR = (const bf16*)(F.ws + WS_KRALL) + (size_t)j * MKV * 64; const bf16* VDT = (const bf16*)(F.ws + WS_VDT);
    SegSrc<6, 8, true> S; S.kap0 = 8 * (fr >> 2) + (fr & 3); S.kap1 = S.kap0 + 4; S.nA = nA; S.nt = nA + nB; S.ldk = 1024; S.vts = 1024 * 256;
    S.kA = KN + krowA * 1024 + h * 128 + 8 * fq; S.kB = KN + krowB * 1024 + h * 128 + 8 * fq;
    S.rA = KR + krowA * 64 + 8 * fq; S.rB = KR + krowB * 64 + 8 * fq;
    S.vA = VDT + ((size_t)(krowA >> 8) * 1024 + h * 128 + fr) * 256 + 8 * fq; S.vB = VDT + ((size_t)(krowB >> 8) * 1024 + h * 128 + fr) * 256 + 8 * fq;
    bf16x8 qf[1][6];
    { const bf16* qp = (const bf16*)(F.ws + WS_QD) + (qrow0 + fr) * 1536 + h * 192 + 8 * fq;
#pragma unroll
      for (int ks = 0; ks < 6; ++ks) qf[0][ks] = ld16(qp + 32 * ks); }
    f32x4 o[1][8]; float ls[1];
    attn_core<6, 8, 1, SegSrc<6, 8, true>>(S, qf, o, ls);
    attn_store<8>(o[0], ls[0], (bf16*)(F.ws + WS_YCAT) + (qrow0 + fr) * 2048 + 1024 + h * 128, fq);
}

constexpr int RING_D = 4;
template <int N> __device__ __forceinline__ void wait_vm() { asm volatile("s_waitcnt vmcnt(%0)" :: "n"(N) : "memory"); }
template <int NF8> struct RingPlan { const char* bA[NF8]; const char* bB[NF8]; unsigned voff[NF8]; unsigned pitch[NF8]; bool isv[NF8]; };
template <int NKS, int NDT, class Src>
__device__ __forceinline__ void ring_issue(LAS unsigned char* slot, const Src& S, const RingPlan<(2 * NKS + NDT + 7) / 8>& P, int t, int wave) {
    constexpr int NF = 2 * NKS + NDT, NF8 = (NF + 7) / 8;
    bool segB; unsigned key0; S.tile(t, segB, key0);
    const unsigned offv = S.voffset(key0);
#pragma unroll
    for (int k = 0; k < NF8; ++k) { const int f = wave + 8 * k;
        const char* ub = (segB ? P.bB[k] : P.bA[k]) + (P.isv[k] ? (size_t)offv : (size_t)key0 * P.pitch[k]);
        __builtin_amdgcn_global_load_lds((const unsigned*)(ub + P.voff[k]), (LAS unsigned*)(slot + f * 1024), 16, 0, 0); }
}
template <int NKS, int NDT, int QT, class Src>
__device__ __forceinline__ void attn_ring(LAS unsigned char* ring, const Src& S, const bf16x8 (&qf)[QT][NKS], f32x4 (&o)[QT][NDT], float (&lsum)[QT], int wave, int lane) {
    constexpr int NF = 2 * NKS + NDT, NF8 = (NF + 7) / 8, SLOTB = NF8 * 8 * 1024;
    static_assert(RING_D == 4, "the tile loop is unrolled by the ring depth so that every slot offset is a compile-time constant (else hipcc drains vmcnt ahead of the ds_reads)");
    float mrun[QT]; f32x4 osum[QT];
#pragma unroll
    for (int qt = 0; qt < QT; ++qt) { mrun[qt] = 0.f; osum[qt] = (f32x4){0.f, 0.f, 0.f, 0.f};
#pragma unroll
        for (int dt = 0; dt < NDT; ++dt) o[qt][dt] = (f32x4){0.f, 0.f, 0.f, 0.f}; }
    bool first = true;
    const bf16x8 ones = __builtin_bit_cast(bf16x8, (u32x4){0x3F803F80u, 0x3F803F80u, 0x3F803F80u, 0x3F803F80u});
    const int nt = S.ntiles();
    RingPlan<NF8> P;
#pragma unroll
    for (int k = 0; k < NF8; ++k) { const int f = wave + 8 * k; S.plan(f < NF ? f : f - 8, P.bA[k], P.bB[k], P.voff[k], P.pitch[k], P.isv[k]); }
    asm volatile("s_waitcnt vmcnt(0) lgkmcnt(0)" ::: "memory"); __builtin_amdgcn_s_barrier(); asm volatile("" ::: "memory");
#pragma unroll
    for (int t = 0; t < RING_D - 1; ++t) ring_issue<NKS, NDT, Src>(ring + t * SLOTB, S, P, t, wave);
    f32x4 scE[QT][2], scO[QT][2];
#define ATT_SPROD(dst, slotidx) do { const LAS unsigned char* sl_ = ring + (slotidx) * SLOTB + lane * 16; bf16x8 kf[2][NKS]; \
        _Pragma("unroll") for (int s = 0; s < 2; ++s) _Pragma("unroll") for (int ks = 0; ks < NKS; ++ks) kf[s][ks] = *(const LAS bf16x8*)(sl_ + (s * NKS + ks) * 1024); \
        _Pragma("unroll") for (int qt = 0; qt < QT; ++qt) _Pragma("unroll") for (int s = 0; s < 2; ++s) { const float nm = -mrun[qt]; f32x4 a = (f32x4){nm, nm, nm, nm}; \
            _Pragma("unroll") for (int ks = 0; ks < NKS; ++ks) a = __builtin_amdgcn_mfma_f32_16x16x32_bf16(kf[s][ks], qf[qt][ks], a, 0, 0, 0); dst[qt][s] = a; } } while (0)
    wait_vm<(RING_D - 2) * NF8>(); __builtin_amdgcn_s_barrier(); asm volatile("" ::: "memory");
    bool cur_ok = S.active(0);
    if (cur_ok) ATT_SPROD(scE, 0);
#pragma unroll 1
    for (int i0 = 0; i0 < nt; i0 += RING_D) {
#pragma unroll
        for (int ph = 0; ph < RING_D; ++ph) { const int i = i0 + ph;
        f32x4 (&scC)[QT][2] = (ph & 1) ? scO : scE; f32x4 (&scN)[QT][2] = (ph & 1) ? scE : scO;
        if (i + 1 < nt) { if (i + 2 < nt) wait_vm<NF8>(); else wait_vm<0>(); }
        asm volatile("s_waitcnt lgkmcnt(0)" ::: "memory");
        __builtin_amdgcn_s_barrier(); asm volatile("" ::: "memory");
        if (i + RING_D - 1 < nt) ring_issue<NKS, NDT, Src>(ring + ((ph + RING_D - 1) & (RING_D - 1)) * SLOTB, S, P, i + RING_D - 1, wave);
        const bool nxt_ok = (i + 1 < nt) && S.active(i + 1);
        if (nxt_ok) ATT_SPROD(scN, (ph + 1) & (RING_D - 1));
        if (cur_ok) {
            const LAS unsigned char* slot = ring + ph * SLOTB + lane * 16;
            bf16x8 vf[NDT];
#pragma unroll
            for (int dt = 0; dt < NDT; ++dt) vf[dt] = *(const LAS bf16x8*)(slot + (2 * NKS + dt) * 1024);
#pragma unroll
            for (int qt = 0; qt < QT; ++qt) {
                S.adjust(i, qt, scC[qt]);
                float tm = fmaxf(fmaxf(fmaxf(scC[qt][0][0], scC[qt][0][1]), fmaxf(scC[qt][0][2], scC[qt][0][3])), fmaxf(fmaxf(scC[qt][1][0], scC[qt][1][1]), fmaxf(scC[qt][1][2], scC[qt][1][3])));
                tm = xrow16_max(tm);
                if (first || __builtin_amdgcn_ballot_w64(tm > ATT_DEFER) != 0ull) {
                    const float d = first ? tm : fmaxf(tm, 0.f), alpha = first ? 0.f : fexp2(-d); mrun[qt] += d; osum[qt] = osum[qt] * alpha;
#pragma unroll
                    for (int dt = 0; dt < NDT; ++dt) o[qt][dt] = o[qt][dt] * alpha;
#pragma unroll
                    for (int s = 0; s < 2; ++s) { scC[qt][s] = scC[qt][s] - d; if (nxt_ok) scN[qt][s] = scN[qt][s] - d; } }
                u32x4 pk; pk.x = pkbf(fexp2(scC[qt][0][0]), fexp2(scC[qt][0][1])); pk.y = pkbf(fexp2(scC[qt][0][2]), fexp2(scC[qt][0][3]));
                pk.z = pkbf(fexp2(scC[qt][1][0]), fexp2(scC[qt][1][1])); pk.w = pkbf(fexp2(scC[qt][1][2]), fexp2(scC[qt][1][3]));
                const bf16x8 pf = __builtin_bit_cast(bf16x8, pk);
#pragma unroll
                for (int dt = 0; dt < NDT; ++dt) o[qt][dt] = __builtin_amdgcn_mfma_f32_16x16x32_bf16(vf[dt], pf, o[qt][dt], 0, 0, 0);
                osum[qt] = __builtin_amdgcn_mfma_f32_16x16x32_bf16(ones, pf, osum[qt], 0, 0, 0);
            }
            first = false;
        }
        cur_ok = nxt_ok;
        __builtin_amdgcn_sched_barrier(0);
        }
    }
    asm volatile("s_waitcnt lgkmcnt(0)" ::: "memory");
#undef ATT_SPROD
#pragma unroll
    for (int qt = 0; qt < QT; ++qt) lsum[qt] = osum[qt][0] * 0.25f;
}
template <int NKS, int NDT, int QT, class Src>
__device__ __forceinline__ void attn_ring_np(LAS unsigned char* ring, const Src& S, const bf16x8 (&qf)[QT][NKS], f32x4 (&o)[QT][NDT], float (&lsum)[QT], int wave, int lane) {
    constexpr int NF = 2 * NKS + NDT, NF8 = (NF + 7) / 8, SLOTB = NF8 * 8 * 1024;
    static_assert(RING_D == 4, "the tile loop is unrolled by the ring depth so that every slot offset is a compile-time constant (else hipcc drains vmcnt ahead of the ds_reads)");
    float mrun[QT]; f32x4 osum[QT];
#pragma unroll
    for (int qt = 0; qt < QT; ++qt) { mrun[qt] = 0.f; osum[qt] = (f32x4){0.f, 0.f, 0.f, 0.f};
#pragma unroll
        for (int dt = 0; dt < NDT; ++dt) o[qt][dt] = (f32x4){0.f, 0.f, 0.f, 0.f}; }
    bool first = true;
    const bf16x8 ones = __builtin_bit_cast(bf16x8, (u32x4){0x3F803F80u, 0x3F803F80u, 0x3F803F80u, 0x3F803F80u});
    const int nt = S.ntiles();
    RingPlan<NF8> P;
#pragma unroll
    for (int k = 0; k < NF8; ++k) { const int f = wave + 8 * k; S.plan(f < NF ? f : f - 8, P.bA[k], P.bB[k], P.voff[k], P.pitch[k], P.isv[k]); }
    asm volatile("s_waitcnt vmcnt(0) lgkmcnt(0)" ::: "memory"); __builtin_amdgcn_s_barrier(); asm volatile("" ::: "memory");
#pragma unroll
    for (int t = 0; t < RING_D - 1; ++t) ring_issue<NKS, NDT, Src>(ring + t * SLOTB, S, P, t, wave);
#pragma unroll 1
    for (int i0 = 0; i0 < nt; i0 += RING_D) {
#pragma unroll
        for (int ph = 0; ph < RING_D; ++ph) { const int i = i0 + ph;
        if (i + RING_D - 1 <= nt) wait_vm<(RING_D - 2) * NF8>(); else wait_vm<0>();
        __builtin_amdgcn_s_barrier(); asm volatile("" ::: "memory");
        if (i + RING_D - 1 < nt) ring_issue<NKS, NDT, Src>(ring + ((ph + RING_D - 1) & (RING_D - 1)) * SLOTB, S, P, i + RING_D - 1, wave);
        if (S.active(i)) {
            const LAS unsigned char* slot = ring + ph * SLOTB + lane * 16;
            f32x4 sc[QT][2];
            { bf16x8 kf[2][NKS];
#pragma unroll
              for (int s = 0; s < 2; ++s)
#pragma unroll
                for (int ks = 0; ks < NKS; ++ks) kf[s][ks] = *(const LAS bf16x8*)(slot + (s * NKS + ks) * 1024);
#pragma unroll
              for (int qt = 0; qt < QT; ++qt)
#pragma unroll
                for (int s = 0; s < 2; ++s) { const float nm = -mrun[qt]; f32x4 a = (f32x4){nm, nm, nm, nm};
#pragma unroll
                    for (int ks = 0; ks < NKS; ++ks) a = __builtin_amdgcn_mfma_f32_16x16x32_bf16(kf[s][ks], qf[qt][ks], a, 0, 0, 0);
                    sc[qt][s] = a; } }
            __builtin_amdgcn_sched_barrier(0);
            bf16x8 vf[NDT];
#pragma unroll
            for (int dt = 0; dt < NDT; ++dt) vf[dt] = *(const LAS bf16x8*)(slot + (2 * NKS + dt) * 1024);
#pragma unroll
            for (int qt = 0; qt < QT; ++qt) {
                S.adjust(i, qt, sc[qt]);
                float tm = fmaxf(fmaxf(fmaxf(sc[qt][0][0], sc[qt][0][1]), fmaxf(sc[qt][0][2], sc[qt][0][3])), fmaxf(fmaxf(sc[qt][1][0], sc[qt][1][1]), fmaxf(sc[qt][1][2], sc[qt][1][3])));
                tm = xrow16_max(tm);
                if (first || __builtin_amdgcn_ballot_w64(tm > ATT_DEFER) != 0ull) {
                    const float d = first ? tm : fmaxf(tm, 0.f), alpha = first ? 0.f : fexp2(-d); mrun[qt] += d; osum[qt] = osum[qt] * alpha;
#pragma unroll
                    for (int dt = 0; dt < NDT; ++dt) o[qt][dt] = o[qt][dt] * alpha;
#pragma unroll
                    for (int s = 0; s < 2; ++s) sc[qt][s] = sc[qt][s] - d; }
                u32x4 pk; pk.x = pkbf(fexp2(sc[qt][0][0]), fexp2(sc[qt][0][1])); pk.y = pkbf(fexp2(sc[qt][0][2]), fexp2(sc[qt][0][3]));
                pk.z = pkbf(fexp2(sc[qt][1][0]), fexp2(sc[qt][1][1])); pk.w = pkbf(fexp2(sc[qt][1][2]), fexp2(sc[qt][1][3]));
                const bf16x8 pf = __builtin_bit_cast(bf16x8, pk);
#pragma unroll
                for (int dt = 0; dt < NDT; ++dt) o[qt][dt] = __builtin_amdgcn_mfma_f32_16x16x32_bf16(vf[dt], pf, o[qt][dt], 0, 0, 0);
                osum[qt] = __builtin_amdgcn_mfma_f32_16x16x32_bf16(ones, pf, osum[qt], 0, 0, 0);
            }
            first = false;
        }
        asm volatile("s_waitcnt lgkmcnt(0)" ::: "memory");
        __builtin_amdgcn_sched_barrier(0);
        }
    }
#pragma unroll
    for (int qt = 0; qt < QT; ++qt) lsum[qt] = osum[qt][0] * 0.25f;
}
template <int NKS, int NDT, bool MLA>
struct RingSeg {
    const bf16 *kA, *kB, *rA, *rB, *vA, *vB;
    unsigned oK0, oK1, oR0, oR1, oV;
    int nA, nt, ldk, vts;
    __device__ __forceinline__ void lanes(int fr, int fq) { const int kap0 = 8 * (fr >> 2) + (fr & 3), kap1 = kap0 + 4;
        oK0 = (unsigned)(kap0 * ldk + 8 * fq) * 2u; oK1 = (unsigned)(kap1 * ldk + 8 * fq) * 2u; oR0 = (unsigned)(kap0 * 64 + 8 * fq) * 2u; oR1 = (unsigned)(kap1 * 64 + 8 * fq) * 2u; oV = (unsigned)(fr * 256 + 8 * fq) * 2u; }
    __device__ __forceinline__ int ntiles() const { return nt; }
    __device__ __forceinline__ bool active(int) const { return true; }
    __device__ __forceinline__ void adjust(int, int, f32x4 (&)[2]) const {}
    __device__ __forceinline__ void tile(int t, bool& segB, unsigned& key0) const { segB = t >= nA; key0 = 32u * (unsigned)(segB ? t - nA : t); }
    __device__ __forceinline__ unsigned voffset(unsigned key0) const { return ((key0 >> 8) * (unsigned)vts + (key0 & 255u)) * 2u; }
    __device__ __forceinline__ void plan(int f, const char*& bA, const char*& bB, unsigned& voff, unsigned& pitch, bool& isv) const {
        if (f < 2 * NKS) { const int s = f >= NKS ? 1 : 0, ks = f - s * NKS; isv = false;
            if (MLA && ks >= 4) { voff = s ? oR1 : oR0; pitch = 128u; bA = (const char*)(rA + 32 * (ks - 4)); bB = (const char*)(rB + 32 * (ks - 4)); }
            else { voff = s ? oK1 : oK0; pitch = (unsigned)ldk * 2u; bA = (const char*)(kA + 32 * ks); bB = (const char*)(kB + 32 * ks); } }
        else { isv = true; voff = oV; pitch = 0u; bA = (const char*)(vA + (f - 2 * NKS) * 16 * 256); bB = (const char*)(vB + (f - 2 * NKS) * 16 * 256); }
    }
};
struct RingNa {
    const bf16 *kloc, *kctx, *vloc, *vctx; const LAS float* biasl;
    unsigned oK0, oK1, oV;
    int R0, r, rstart, cs, qcol, cstq, fq;
    __device__ __forceinline__ int ntiles() const { return 28; }
    __device__ __forceinline__ bool active(int i) const { const int kr = R0 + i; return i >= 12 || (kr >= rstart && kr < rstart + 8); }
    __device__ __forceinline__ void tile(int t, bool& segB, unsigned& key0) const { segB = t >= 12; key0 = segB ? 32u * (unsigned)(t - 12) : (unsigned)(64 * (R0 + t) + cs); }
    __device__ __forceinline__ unsigned voffset(unsigned key0) const { return ((key0 >> 8) * (1024u * 256u) + (key0 & 255u)) * 2u; }
    __device__ __forceinline__ void plan(int f, const char*& bA, const char*& bB, unsigned& voff, unsigned& pitch, bool& isv) const {
        if (f < 4) { const int s = f >> 1, ks = f & 1; isv = false; voff = s ? oK1 : oK0; pitch = 2048u; bA = (const char*)(kloc + 32 * ks); bB = (const char*)(kctx + 32 * ks); }
        else { isv = true; voff = oV; pitch = 0u; bA = (const char*)(vloc + (f - 4) * 16 * 256); bB = (const char*)(vctx + (f - 4) * 16 * 256); }
    }
    __device__ __forceinline__ void adjust(int i, int, f32x4 (&sc)[2]) const {
        if (i < 12) { const int relr = R0 + i - r + 7; float bv[8];
#pragma unroll
            for (int k = 0; k < 8; ++k) { const int ck = cs + 8 * fq + k; int relc = ck - qcol + 15; relc = relc < 0 ? 0 : (relc > 30 ? 30 : relc); bv[k] = biasl[relr * 31 + relc]; }
            asm volatile("" : "+v"(bv[0]), "+v"(bv[1]), "+v"(bv[2]), "+v"(bv[3]), "+v"(bv[4]), "+v"(bv[5]), "+v"(bv[6]), "+v"(bv[7]));
#pragma unroll
            for (int s = 0; s < 2; ++s)
#pragma unroll
                for (int g = 0; g < 4; ++g) { const int ck = cs + 8 * fq + 4 * s + g; const bool ok = ck >= cstq && ck < cstq + 16;
                    sc[s][g] = ok ? sc[s][g] + bv[4 * s + g] * LOG2E : -1e30f; } }
    }
};
constexpr int RING_BIAS_OFF = 100 * 1024;
__device__ __forceinline__ void na_group(Frame& F, int j, int grp) {
    const int rh = grp & 1, qi = (grp >> 1) & 3, h = (grp >> 3) & 15, b = grp >> 7, lane = F.lane, fr = lane & 15, fq = lane >> 4;
    const int r = 8 * rh + F.wave, srow = MP + b * 1024, c0 = 16 * qi, qcol = c0 + fr;
    LAS float* bl = (LAS float*)(F.lds + RING_BIAS_OFF);
    asm volatile("s_waitcnt lgkmcnt(0)" ::: "memory"); __builtin_amdgcn_s_barrier();
    for (int e = F.tid; e < 15 * 31; e += NWAVES * 64) bl[e] = F.a->in[25][(size_t)(j * 16 + h) * 15 * 31 + e];
    RingNa S; S.R0 = rh ? 4 : 0; S.r = r; S.rstart = r - 4 < 0 ? 0 : (r - 4 > 8 ? 8 : r - 4); S.cs = qi == 0 ? 0 : (qi == 1 ? 8 : (qi == 2 ? 24 : 32)); S.qcol = qcol;
    S.cstq = qcol - 8 < 0 ? 0 : (qcol - 8 > 48 ? 48 : qcol - 8); S.fq = fq; S.biasl = bl;
    { const int kap0 = 8 * (fr >> 2) + (fr & 3); S.oK0 = (unsigned)(kap0 * 1024 + 8 * fq) * 2u; S.oK1 = (unsigned)((kap0 + 4) * 1024 + 8 * fq) * 2u; S.oV = (unsigned)(fr * 256 + 8 * fq) * 2u; }
    S.kloc = (const bf16*)(F.ws + WS_KB) + (size_t)srow * 1024 + h * 64;
    S.kctx = (const bf16*)(F.ws + WS_KCNA) + (size_t)(b * 2 + j) * 512 * 1024 + h * 64;
    S.vloc = (const bf16*)(F.ws + WS_VT) + ((size_t)(srow >> 8) * 1024 + h * 64) * 256;
    S.vctx = (const bf16*)(F.ws + WS_VTCNA) + ((size_t)((b * 2 + j) * 2) * 1024 + h * 64) * 256;
    const size_t qrow = (size_t)srow + 64 * r + qcol;
    bf16x8 qf[1][2]; const bf16* qp = (const bf16*)(F.ws + WS_QB) + qrow * 1024 + h * 64 + 8 * fq; qf[0][0] = ld16(qp); qf[0][1] = ld16(qp + 32);
    f32x4 o[1][4]; float ls[1];
    attn_ring<2, 4, 1, RingNa>(F.lds, S, qf, o, ls, F.wave, lane);
    attn_store<4>(o[0], ls[0], (bf16*)(F.ws + WS_YCAT) + qrow * 2048 + 1024 + h * 64, fq);
}
template <int QT>
__device__ __forceinline__ void dense64_group(Frame& F, const bf16* Q, int ldq, size_t qrow0, int wq, int qstep, int qcol0, int qcstep, bf16* Y, int ycol0, int ycstep,
                                              const bf16* KA, const bf16* VA, int nA, const bf16* KB_, const bf16* VB_, int nB, int ldk, int vts) {
    const int lane = F.lane, fr = lane & 15, fq = lane >> 4;
    RingSeg<2, 4, false> S; S.nA = nA; S.nt = nA + nB; S.ldk = ldk; S.vts = vts; S.lanes(fr, fq);
    S.kA = KA; S.kB = KB_; S.rA = nullptr; S.rB = nullptr; S.vA = VA; S.vB = VB_;
    const size_t qr = qrow0 + (size_t)wq * F.wave;
    bf16x8 qf[QT][2];
#pragma unroll
    for (int qt = 0; qt < QT; ++qt) { const bf16* qp = Q + (qr + (size_t)qstep * qt + fr) * ldq + qcol0 + qcstep * qt + 8 * fq; qf[qt][0] = ld16(qp); qf[qt][1] = ld16(qp + 32); }
    f32x4 o[QT][4]; float ls[QT];
    if constexpr (QT >= 4) attn_ring_np<2, 4, QT, RingSeg<2, 4, false>>(F.lds, S, qf, o, ls, F.wave, lane);
    else attn_ring<2, 4, QT, RingSeg<2, 4, false>>(F.lds, S, qf, o, ls, F.wave, lane);
#pragma unroll
    for (int qt = 0; qt < QT; ++qt) attn_store<4>(o[qt], ls[qt], Y + (qr + (size_t)qstep * qt + fr) * 2048 + ycol0 + ycstep * qt, fq);
}
__device__ __forceinline__ void mla_group(Frame& F, int j, int h, size_t qrow0, size_t krowA, int nA, size_t krowB, int nB) {
    const int lane = F.lane, fr = lane & 15, fq = lane >> 4;
    const bf16* KN = (const bf16*)(F.ws + WS_KN); const bf16* KR = (const bf16*)(F.ws + WS_KRALL) + (size_t)j * MKV * 64; const bf16* VDT = (const bf16*)(F.ws + WS_VDT);
    RingSeg<6, 8, true> S; S.nA = nA; S.nt = nA + nB; S.ldk = 1024; S.vts = 1024 * 256; S.lanes(fr, fq);
    S.kA = KN + krowA * 1024 + h * 128; S.kB = KN + krowB * 1024 + h * 128;
    S.rA = KR + krowA * 64; S.rB = KR + krowB * 64;
    S.vA = VDT + ((size_t)(krowA >> 8) * 1024 + h * 128) * 256; S.vB = VDT + ((size_t)(krowB >> 8) * 1024 + h * 128) * 256;
    const size_t qr = qrow0 + 16 * F.wave;
    bf16x8 qf[1][6];
    { const bf16* qp = (const bf16*)(F.ws + WS_QD) + (qr + fr) * 1536 + h * 192 + 8 * fq;
#pragma unroll
      for (int ks = 0; ks < 6; ++ks) qf[0][ks] = ld16(qp + 32 * ks); }
    f32x4 o[1][8]; float ls[1];
    attn_ring<6, 8, 1, RingSeg<6, 8, true>>(F.lds, S, qf, o, ls, F.wave, lane);
    attn_store<8>(o[0], ls[0], (bf16*)(F.ws + WS_YCAT) + (qr + fr) * 2048 + 1024 + h * 128, fq);
}

__device__ __forceinline__ void cd_ctx_convert(Frame& F, int j) {
    LAS float* scr = (LAS float*)(F.lds + F.wave * SCR_PER_WAVE);
    const int gw = (int)blockIdx.x * NWAVES + F.wave, NGW = F.G * NWAVES, lane = F.lane; unsigned char* ws = F.ws;
    for (int it = gw; it < 8 * 32; it += NGW) { const int b = it >> 5, q = it & 31, kb = q >> 2, nb = q & 3, k0 = 64 * kb, n0 = 64 * nb, mat = b * 2 + j;
        tr_item(F.a->in[7] + (size_t)mat * 512 * 256 + (size_t)k0 * 256 + n0, 256, (bf16*)(ws + WS_VTCG) + ((size_t)(mat * 2 + (k0 >> 8)) * 256 + n0) * 256 + (k0 & 255), 256, scr, lane); }
    const int gt = gw * 64 + lane, ngt = NGW * 64;
    for (int i = gt; i < 8 * 512 * 256 / 4; i += ngt) { const int e = i * 4, b = e / (512 * 256), rem = e % (512 * 256); const size_t o = (size_t)(b * 2 + j) * 512 * 256 + rem;
        const f32x4 v = *(const f32x4*)(F.a->in[6] + o); u32x2 w; w.x = pkbf(v.x, v.y); w.y = pkbf(v.z, v.w); *(u32x2*)((bf16*)(ws + WS_KCG) + o) = w; }
    for (int i = gt; i < 8 * 512 * 512 / 4; i += ngt) { const int e = i * 4, b = e / (512 * 512), rem = e % (512 * 512);
        const f32x4 v = *(const f32x4*)(F.a->in[8] + (size_t)(b * 2 + j) * 512 * 512 + rem); u32x2 w; w.x = pkbf(v.x, v.y); w.y = pkbf(v.z, v.w);
        *(u32x2*)((bf16*)(ws + WS_CKVALL) + ((size_t)j * MKV + MT + b * 512) * 512 + rem) = w; }
    for (int i = gt; i < 8 * 512 * 64 / 4; i += ngt) { const int e = i * 4, b = e / (512 * 64), rem = e % (512 * 64);
        const f32x4 v = *(const f32x4*)(F.a->in[9] + (size_t)(b * 2 + j) * 512 * 64 + rem); u32x2 w; w.x = pkbf(v.x, v.y); w.y = pkbf(v.z, v.w);
        *(u32x2*)((bf16*)(ws + WS_KRALL) + ((size_t)j * MKV + MT + b * 512) * 64 + rem) = w; }
}
__device__ __forceinline__ void cd_post_row(Frame& F, int j, int m) {
    const int lane = F.lane, l16 = lane & 15, hg = lane >> 4;
    const bool smp = m >= MP; const int t = smp ? ((m - MP) & 1023) : (m & 255), b = smp ? ((m - MP) >> 10) : (m >> 8);
    const bf16* raw = (const bf16*)(F.ws + WS_RAW) + (size_t)m * 2816; const float* rope = (const float*)(F.ws + WS_ROPE);
    const int d0 = 4 * l16;
    const int pos = d0 >= 32 ? (t & 63) : (t >> 6); const bool isx2 = (d0 & 31) >= 16; const int fi = d0 & 15;
    const f32x4 rc = *(const f32x4*)(rope + pos * 16 + fi), rs = *(const f32x4*)(rope + 1024 + pos * 16 + fi);
#pragma unroll
    for (int g = 0; g < 5; ++g) { const int col = (g < 4 ? (4 * g + hg) * 64 : 1024 + hg * 64) + d0;
        const u32x2 rw = *(const u32x2*)(raw + col); f32x4 v = (f32x4){bflo(rw.x), bfhi(rw.x), bflo(rw.y), bfhi(rw.y)};
        float ss = (v.x * v.x + v.y * v.y) + (v.z * v.z + v.w * v.w); ss += __shfl_xor(ss, 1); ss += __shfl_xor(ss, 2); ss += __shfl_xor(ss, 4); ss += __shfl_xor(ss, 8);
        const float rstd = 1.0f / sqrtf(ss * (1.0f / 64.0f) + EPS);
        const f32x4 gn = *(const f32x4*)((g < 4 ? F.a->in[28] : F.a->in[29]) + j * 64 + d0);
        v = v * rstd * gn;
        if (g == 4 && !smp) *(f32x4*)(F.out + O_GK + ((size_t)(b * 2 + j) * 256 + t) * 256 + hg * 64 + d0) = v;
        f32x4 pr; pr.x = __shfl_xor(v.x, 4); pr.y = __shfl_xor(v.y, 4); pr.z = __shfl_xor(v.z, 4); pr.w = __shfl_xor(v.w, 4);
        if (smp) v = isx2 ? v * rc + pr * rs : v * rc - pr * rs;
        if (g < 4) { v = v * QS64; u32x2 w; w.x = pkbf(v.x, v.y); w.y = pkbf(v.z, v.w); *(u32x2*)((bf16*)(F.ws + WS_QG) + (size_t)m * 1024 + (4 * g + hg) * 64 + d0) = w; }
        else { u32x2 w; w.x = pkbf(v.x, v.y); w.y = pkbf(v.z, v.w); *(u32x2*)((bf16*)(F.ws + WS_KG) + (size_t)m * 256 + hg * 64 + d0) = w; } }
    { const u32x2 rw = *(const u32x2*)(raw + 1280 + 4 * lane); const f32x4 v = (f32x4){bflo(rw.x), bfhi(rw.x), bflo(rw.y), bfhi(rw.y)};
      if (!smp) *(f32x4*)(F.out + O_GV + ((size_t)(b * 2 + j) * 256 + t) * 256 + 4 * lane) = v;
      bf16* p = (bf16*)(F.ws + WS_VGT) + ((size_t)(m >> 8) * 256 + 4 * lane) * 256 + (m & 255);
      p[0] = (bf16)(rw.x & 0xffffu); p[256] = (bf16)(rw.x >> 16); p[512] = (bf16)(rw.y & 0xffffu); p[768] = (bf16)(rw.y >> 16); }
#pragma unroll
    for (int which = 0; which < 2; ++which) { const u32x4 rw = *(const u32x4*)(raw + (which ? 2048 : 1536) + 8 * lane);
        float v[8] = {bflo(rw.x), bfhi(rw.x), bflo(rw.y), bfhi(rw.y), bflo(rw.z), bfhi(rw.z), bflo(rw.w), bfhi(rw.w)};
        float ss = 0.f;
#pragma unroll
        for (int e = 0; e < 8; ++e) ss += v[e] * v[e];
        const float rstd = 1.0f / sqrtf(wave_sum(ss) * (1.0f / 512.0f) + EPS);
        const float* gp = (which ? F.a->in[31] : F.a->in[30]) + j * 512 + 8 * lane; const f32x4 g0 = *(const f32x4*)gp, g1 = *(const f32x4*)(gp + 4);
        v[0] *= rstd * g0.x; v[1] *= rstd * g0.y; v[2] *= rstd * g0.z; v[3] *= rstd * g0.w; v[4] *= rstd * g1.x; v[5] *= rstd * g1.y; v[6] *= rstd * g1.z; v[7] *= rstd * g1.w;
        u32x4 w; w.x = pkbf(v[0], v[1]); w.y = pkbf(v[2], v[3]); w.z = pkbf(v[4], v[5]); w.w = pkbf(v[6], v[7]);
        if (which == 0) *(u32x4*)((bf16*)(F.ws + WS_QA) + (size_t)m * 512 + 8 * lane) = w;
        else { *(u32x4*)((bf16*)(F.ws + WS_CKVALL) + ((size_t)j * MKV + m) * 512 + 8 * lane) = w;
            if (!smp) { float* o = F.out + O_CKV + ((size_t)(b * 2 + j) * 256 + t) * 512 + 8 * lane; *(f32x4*)o = (f32x4){v[0], v[1], v[2], v[3]}; *(f32x4*)(o + 4) = (f32x4){v[4], v[5], v[6], v[7]}; } } }
    { const u32x2 rw = *(const u32x2*)(raw + 2560 + d0); f32x4 v = (f32x4){bflo(rw.x), bfhi(rw.x), bflo(rw.y), bfhi(rw.y)};
      if (!smp && lane < 16) *(f32x4*)(F.out + O_KR + ((size_t)(b * 2 + j) * 256 + t) * 64 + d0) = v;
      f32x4 pr; pr.x = __shfl_xor(v.x, 4); pr.y = __shfl_xor(v.y, 4); pr.z = __shfl_xor(v.z, 4); pr.w = __shfl_xor(v.w, 4);
      if (smp) v = isx2 ? v * rc + pr * rs : v * rc - pr * rs;
      if (lane < 16) { u32x2 w; w.x = pkbf(v.x, v.y); w.y = pkbf(v.z, v.w); *(u32x2*)((bf16*)(F.ws + WS_KRALL) + ((size_t)j * MKV + m) * 64 + d0) = w; } }
}

__global__ void __launch_bounds__(NWAVES * 64, 2) trunk_fwd(Args args) {
    extern __shared__ __attribute__((aligned(16))) unsigned char lds[];
    Frame F;
    F.lds = (LAS unsigned char*)lds; F.MISC = (volatile LAS unsigned*)(F.lds + MISC_OFF);
    F.tid = threadIdx.x; F.lane = F.tid & 63; F.wave = __builtin_amdgcn_readfirstlane(F.tid >> 6);
    F.G = gridDim.x; { const int bx = blockIdx.x; F.vcu = (F.G % 8 == 0) ? (bx % 8) * (F.G / 8) + bx / 8 : bx; }
    F.a = &args; F.out = args.out; F.ws = args.ws; F.ctl = (unsigned*)(args.ws + WS_CTL);
#define REFRESH() do { unsigned t_ = threadIdx.x; asm volatile("" : "+v"(t_)); F.tid = (int)t_; F.lane = (int)(t_ & 63u); F.wave = __builtin_amdgcn_readfirstlane((int)(t_ >> 6)); \
        unsigned long long w_ = (unsigned long long)args.ws, o_ = (unsigned long long)args.out; asm volatile("" : "+s"(w_), "+s"(o_)); \
        F.ws = (unsigned char*)(__attribute__((address_space(1))) unsigned char*)w_; F.out = (float*)(__attribute__((address_space(1))) float*)o_; ws = F.ws;        \
        gwb = (int)blockIdx.x * NWAVES + F.wave; } while (0)
    for (int u = F.tid; u < (LDS_BYTES - MISC_OFF) / 4; u += NWAVES * 64) ((LAS unsigned*)(F.lds + MISC_OFF))[u] = 0u;
    __syncthreads();
#if !MK_PER_PHASE
    XcdBarrier bar = xcd_barrier_post(F.ctl + CW_BAR, F.MISC + 8);
    if (F.tid == 0) { const unsigned x = xb_xcc_id(); F.MISC[16] = xb_add(F.ctl + CW_RANK + 64 * (x & 7u), 1u); F.MISC[17] = x; }
#endif
    int cvirt = (int)blockIdx.x, vcu2 = F.vcu;
    const int lo = args.ph_lo, hi = args.ph_hi; int ph = 0;
    int gwb = blockIdx.x * NWAVES + F.wave; const int NGW = F.G * NWAVES;
    unsigned char* ws = F.ws;
#define IN() (ph >= lo && ph < hi)
#if MK_PER_PHASE
#define SEAM() do { ++ph; } while (0)
#else
#define SEAM() do { if (ph >= lo && ph + 1 < hi) xcd_barrier(bar); ++ph; } while (0)
#endif
    if (EN_P0 && IN()) for (int rp = 0; rp < REPS(0); ++rp) { REFRESH(); p0_prologue(F); __syncthreads(); }
    SEAM();
#if !MK_PER_PHASE
    if (lo == 0) {
        if (F.tid == 0) { bool ok = (F.G % 8) == 0; for (unsigned jx = 0; jx < 16; ++jx) { const unsigned c_ = xb_ld(F.ctl + CW_BAR + XB_XCNT(jx)); ok = ok && (c_ == (jx < 8 ? (unsigned)F.G / 8u : 0u)); } F.MISC[18] = ok ? 1u : 0u; }
        __syncthreads();
        if (F.MISC[18]) { const int rk = __builtin_amdgcn_readfirstlane((int)F.MISC[16]), xx = __builtin_amdgcn_readfirstlane((int)F.MISC[17]); cvirt = rk * 8 + xx; vcu2 = xx * (F.G / 8) + rk; }
    }
#endif
#pragma unroll 1
    for (int it = 0; it < 12; ++it) {
        const int L = it / 3, sub = it - 3 * L, j = L >> 1; const bool even = (L & 1) == 0;
#define MODL ((const float*)(ws + WS_MOD) + (size_t)L * 9 * NMODC)
        if (EN_ADALN && IN()) for (int rp = 0; rp < REPS(1); ++rp) { REFRESH(); adaln_phase(F, F.a->in[14] + (size_t)(L * 3 + sub) * D, MODL, 3 * sub, 3 * sub + 1); }
        SEAM();
        if (sub != 1) {
            if (EN_G1 && IN()) for (int rp = 0; rp < REPS(2); ++rp) { REFRESH(); const int f = sub >> 1;
                pg8::Gemm g{(const bf16*)(ws + WS_H), (const bf16*)(ws + WS_W1) + (size_t)(L * 2 + f) * 11264 * 2048, MT, 11264, 2048}; pg8::HalfOrder S; S.init(MT, 11264, F.G, cvirt); S.wgm = 6;
                EpiSwiGLU E{(bf16*)(ws + WS_ACT)};
                pg8::gemm_phase<EpiSwiGLU, pg8::HalfOrder, true, true>(F.lds, g, S, E); }
            SEAM();
        } else if (even) {
            if (EN_GAB && IN()) for (int rp = 0; rp < REPS(3); ++rp) { REFRESH(); pg8::Gemm g{(const bf16*)(ws + WS_H), (const bf16*)(ws + WS_WABI) + (size_t)j * 5120 * 2048, MT, 5120, 2048}; pg8::StaticOrder S; S.init(MT, 5120, F.G, cvirt);
                EpiAB E{(bf16*)(ws + WS_XAGA), (bf16*)(ws + WS_QB), (bf16*)(ws + WS_KB), (bf16*)(ws + WS_VT), F.out + O_NAK, F.out + O_NAV, j};
                pg8::gemm_phase<EpiAB, pg8::StaticOrder, true, true>(F.lds, g, S, E); }
            SEAM();
            if (EN_L1 && IN()) for (int rp = 0; rp < REPS(4); ++rp) { REFRESH(); LAS float* scr = (LAS float*)(F.lds + F.wave * SCR_PER_WAVE);
                for (int item = gwb; item < 192 * 16; item += NGW) lru_l1_item(F, j, item, scr); }
            SEAM();
            if (IN()) for (int rp = 0; rp < REPS(5); ++rp) { REFRESH();
                const bool lfirst = ((cvirt >> 3) & 1) != 0;
                if (lfirst) { if (EN_L3) for (int item = gwb; item < 192 * 32; item += NGW) lru_l3_item(F, j, item); }
                if (EN_NA) for (int grp = vcu2; grp < 8 * 16 * 4 * 2; grp += F.G) na_group(F, j, grp);
                if (EN_DP) for (int grp = vcu2; grp < 16 * 16; grp += F.G) { const int h = grp & 15, b = grp >> 4;
                    const bf16* K = (const bf16*)(ws + WS_KB) + (size_t)b * 256 * 1024 + h * 64; const bf16* V = (const bf16*)(ws + WS_VT) + ((size_t)b * 1024 + h * 64) * 256;
                    dense64_group<2>(F, (const bf16*)(ws + WS_QB), 1024, (size_t)b * 256, 32, 16, h * 64, 0, (bf16*)(ws + WS_YCAT), 1024 + h * 64, 0, K, V, 8, K, V, 0, 1024, 1024 * 256); }
                asm volatile("s_waitcnt vmcnt(0) lgkmcnt(0)" ::: "memory"); __syncthreads();
                if (!lfirst) { if (EN_L3) for (int item = gwb; item < 192 * 32; item += NGW) lru_l3_item(F, j, item); }
            }
            SEAM();
        } else {
            if (EN_GCD && IN()) for (int rp = 0; rp < REPS(6); ++rp) { REFRESH(); pg8::Gemm g{(const bf16*)(ws + WS_H), (const bf16*)(ws + WS_WCDI) + (size_t)j * 2816 * 2048, MT, 2816, 2048}; pg8::HalfOrder S; S.init(MT, 2816, F.G, cvirt);
                EpiPlain E{(bf16*)(ws + WS_RAW), 2816};
                pg8::gemm_phase<EpiPlain, pg8::HalfOrder, true, true>(F.lds, g, S, E); }
            SEAM();
            if (EN_POST && IN()) for (int rp = 0; rp < REPS(7); ++rp) { REFRESH(); cd_ctx_convert(F, j);
                for (int blk = (int)blockIdx.x; blk < MT / 64; blk += F.G) for (int i = 0; i < 8; ++i) cd_post_row(F, j, blk * 64 + F.wave * 8 + i); }
            SEAM();
            if (IN()) for (int rp = 0; rp < REPS(8); ++rp) { REFRESH();
                if (EN_GQD) { pg8::Gemm g{(const bf16*)(ws + WS_QA), (const bf16*)(ws + WS_WUQ) + (size_t)j * 1536 * 512, MT, 1536, 512}; pg8::HalfOrder S; S.init(MT, 1536, F.G, cvirt);
                  EpiQD E{(bf16*)(ws + WS_QD), (const float*)(ws + WS_ROPE)};
                  pg8::gemm_phase<EpiQD, pg8::HalfOrder, true, true>(F.lds, g, S, E); }
                if (EN_GKNV) { pg8::Gemm g{(const bf16*)(ws + WS_CKVALL) + (size_t)j * MKV * 512, (const bf16*)(ws + WS_WUKV) + (size_t)j * 2048 * 512, MKV, 2048, 512}; pg8::StaticOrder S; S.init(MKV, 2048, F.G, (int)(F.G - 1 - cvirt));
                  EpiKNV E{(bf16*)(ws + WS_KN), (bf16*)(ws + WS_VDT)};
                  pg8::gemm_phase<EpiKNV, pg8::StaticOrder, true, true>(F.lds, g, S, E); }
            }
            SEAM();
            if (IN()) for (int rp = 0; rp < REPS(9); ++rp) { REFRESH();
                const bf16* QG = (const bf16*)(ws + WS_QG); const bf16* KG = (const bf16*)(ws + WS_KG); const bf16* VGT = (const bf16*)(ws + WS_VGT); bf16* Y = (bf16*)(ws + WS_YCAT);
                if (EN_GQA) for (int grp = vcu2; grp < 8 * 4 * 8; grp += F.G) { const int tg = grp & 7, kvh = (grp >> 3) & 3, b = grp >> 5; const size_t srow = (size_t)MP + b * 1024;
                    dense64_group<4>(F, QG, 1024, srow + 128 * tg, 16, 0, kvh * 256, 64, Y, kvh * 256, 64,
                                     KG + srow * 256 + kvh * 64, VGT + ((srow >> 8) * 256 + kvh * 64) * 256, 32,
                                     (const bf16*)(ws + WS_KCG) + (size_t)(b * 2 + j) * 512 * 256 + kvh * 64, (const bf16*)(ws + WS_VTCG) + ((size_t)((b * 2 + j) * 2) * 256 + kvh * 64) * 256, 16, 256, 256 * 256); }
                if (EN_MLA) for (int grp = vcu2; grp < 8 * 8 * 8; grp += F.G) { const int qg = grp & 7, h = (grp >> 3) & 7, b = grp >> 6; const size_t srow = (size_t)MP + b * 1024;
                    mla_group(F, j, h, srow + 128 * qg, srow, 32, (size_t)MT + b * 512, 16); }
                if (EN_GQA) for (int grp = vcu2; grp < 16 * 4 * 2 * 2; grp += F.G) { const int hp = grp & 1, tg = (grp >> 1) & 1, kvh = (grp >> 2) & 3, b = grp >> 4; const size_t prow = (size_t)b * 256;
                    const bf16* K = KG + prow * 256 + kvh * 64; const bf16* V = VGT + ((size_t)b * 256 + kvh * 64) * 256;
                    dense64_group<2>(F, QG, 1024, prow + 128 * tg, 16, 0, kvh * 256 + hp * 128, 64, Y, kvh * 256 + hp * 128, 64, K, V, 8, K, V, 0, 256, 256 * 256); }
                if (EN_MLA) for (int grp = vcu2; grp < 16 * 8 * 2; grp += F.G) { const int qg = grp & 1, h = (grp >> 1) & 7, b = grp >> 4; const size_t prow = (size_t)b * 256;
                    mla_group(F, j, h, prow + 128 * qg, prow, 8, prow, 0); }
                asm volatile("s_waitcnt vmcnt(0) lgkmcnt(0)" ::: "memory"); __syncthreads();
            }
            SEAM();
        }
        if (EN_RES && IN() && (EN_MIXRES || sub != 1)) { REFRESH(); const bool ffn = sub != 1; const int f = sub >> 1;
            const bf16* A = ffn ? (const bf16*)(ws + WS_ACT) : (const bf16*)(ws + WS_YCAT);
            const bf16* Bt = ffn ? (const bf16*)(ws + WS_W2) + (size_t)(L * 2 + f) * 2048 * 5632 : (even ? (const bf16*)(ws + WS_WABO) : (const bf16*)(ws + WS_WCDO)) + (size_t)j * 2048 * 2048;
            pg8::Gemm g{A, Bt, MT, 2048, ffn ? DFF : 2048};
#if RES_TM == 192
            pg8::StaticOrder S; S.init_tm(MT, 2048, F.G, cvirt, 192);
            EpiResid192 E{(bf16*)(ws + WS_X), MODL + (3 * sub + 2) * 2048, ffn ? 0.5f : 1.0f};
            pg8::gemm_phase<EpiResid192, pg8::StaticOrder, true, true, 192>(F.lds, g, S, E); }
#else
            pg8::HalfOrder S; S.init(MT, 2048, F.G, cvirt);
            EpiResid E{(bf16*)(ws + WS_X), MODL + (3 * sub + 2) * 2048, ffn ? 0.5f : 1.0f};
            pg8::gemm_phase<EpiResid, pg8::HalfOrder, true, true>(F.lds, g, S, E); }
#endif
        SEAM();
    }
    if (EN_FINAL && IN()) for (int rp = 0; rp < REPS(10); ++rp) { REFRESH(); final_phase(F); }
#undef IN
#undef SEAM
}

extern "C" void kernel_launch(void* const* d_in, const int* in_sizes, int n_in, void* d_out, int out_size, void* d_ws, size_t ws_size, hipStream_t stream) {
    static int grid = 0;
    if (grid == 0) {
        if (n_in != 37 || (size_t)out_size != O_END || ws_size < WS_END) { fprintf(stderr, "kernel_launch: unexpected problem shape (n_in %d, out %d, ws %zu); nothing launched\n", n_in, out_size, ws_size); grid = -1; return; }
        int dev = 0, cus = 0;
        if (hipGetDevice(&dev) != hipSuccess || hipDeviceGetAttribute(&cus, hipDeviceAttributeMultiprocessorCount, dev) != hipSuccess) { grid = -1; return; }
        if (hipFuncSetAttribute((const void*)trunk_fwd, hipFuncAttributeMaxDynamicSharedMemorySize, LDS_BYTES) != hipSuccess) { fprintf(stderr, "kernel_launch: hipFuncSetAttribute failed\n"); grid = -1; return; }
        int per_cu = 0;
        if (hipOccupancyMaxActiveBlocksPerMultiprocessor(&per_cu, (const void*)trunk_fwd, NWAVES * 64, LDS_BYTES) != hipSuccess || per_cu < 1) { fprintf(stderr, "kernel_launch: occupancy query says %d blocks per CU\n", per_cu); }
        (void)hipGetLastError();
        grid = cus;
    }
    if (grid < 0) return;
    (void)hipMemsetAsync((char*)d_ws + WS_CTL, 0, CTL_ZERO_BYTES, stream);
    Args a{};
    for (int i = 0; i < 37; ++i) a.in[i] = (const float*)d_in[i];
    a.out = (float*)d_out; a.ws = (unsigned char*)d_ws;
#if MK_PER_PHASE
    for (int p = 0; p < N_PHASES; ++p) { a.ph_lo = p; a.ph_hi = p + 1; hipLaunchKernelGGL(trunk_fwd, dim3(grid), dim3(NWAVES * 64), LDS_BYTES, stream, a); }
#else
    a.ph_lo = 0; a.ph_hi = N_PHASES;
    hipLaunchKernelGGL(trunk_fwd, dim3(grid), dim3(NWAVES * 64), LDS_BYTES, stream, a);
#endif
}
```

```cpp
#include <hip/hip_runtime.h>
#include <cstdio>
#include <cstdint>
namespace pg8 {
#define PG8_LAS __attribute__((address_space(3)))
typedef unsigned short bf16_t;
typedef short bf16x8 __attribute__((ext_vector_type(8)));
typedef float f32x4 __attribute__((ext_vector_type(4)));
typedef unsigned u32x4 __attribute__((ext_vector_type(4)));
constexpr int BM = 256, BK = 64, HALF = 128, HTB = HALF * BK * 2  , STAGE_BYTES = 8 * HTB, NXCD = 8, WGM = 4;

__host__ __device__ __forceinline__ int lds_byte(int r, int c) { const int st = (r >> 4) * 2 + (c >> 5), rr = r & 15, cc = c & 31, ob = rr * 64 + cc * 2; return st * 1024 + (ob ^ (((ob >> 9) & 1) << 5)); }
__host__ __device__ __forceinline__ void stage_rc(int b, int& R, int& C) { const int st = b / 1024, sb = b % 1024, swz = sb ^ (((sb >> 9) & 1) << 5); R = (st >> 1) * 16 + swz / 64; C = (st & 1) * 32 + (swz % 64) / 2; }
__host__ __device__ __forceinline__ int perm32(int rho) { const int n = rho >> 4, i = rho & 15; return 8 * (i >> 2) + 4 * n + (i & 3); }

struct Unit { int pm, pn, mh; };
struct Gemm { const bf16_t* A; const bf16_t* Bt; int M, N, K; };

struct StaticOrder {
    int nM, nN, nwg, G, c, wgm;
    __host__ __device__ void init(int M, int N, int G_, int c_) { nM = M / BM; nN = N / BM; nwg = nM * nN; G = G_; c = c_; wgm = WGM; }
    __host__ __device__ void init_tm(int M, int N, int G_, int c_, int tm) { nM = M / tm; nN = N / BM; nwg = nM * nN; G = G_; c = c_; wgm = WGM; }
    __host__ __device__ bool next(int i, Unit& u) const {
        const long L = (long)i * G + c; if (L >= nwg) return false;
        int wgid = (int)L; { const int q = nwg / NXCD, r = nwg % NXCD, xcd = wgid % NXCD, off = wgid / NXCD; wgid = (xcd < r ? xcd * (q + 1) : r * (q + 1) + (xcd - r) * q) + off; }
        const int nig = wgm * nN, gid = wgid / nig, fm = gid * wgm, gsz = (nM - fm) < wgm ? (nM - fm) : wgm;
        u.pm = fm + ((wgid % nig) % gsz); u.pn = (wgid % nig) / gsz; u.mh = -1; return true;
    }
    __device__ __forceinline__ void a_ready(const Unit&) const {}
    __device__ __forceinline__ void done(const Unit&) const {}
};
struct HalfOrder : StaticOrder {
    __host__ __device__ bool next(int i, Unit& u) const {
        const int R = nwg / G, rem = nwg % G;
        if (i < R) { StaticOrder t = *this; return t.StaticOrder::next(i, u); }
        if (i > R || rem == 0) return false;
        if (2 * rem > G) { StaticOrder t = *this; return t.StaticOrder::next(R, u); }
        int cc = c >> 1, hh = c & 1;
        if ((rem & 7) == 0 && (G & 7) == 0) { const int xx = c & 7, rk = c >> 3; if (rk >= 2 * (rem >> 3)) return false; cc = 8 * (rk >> 1) + xx; hh = rk & 1; }
        else if (c >= 2 * rem) return false;
        StaticOrder t = *this; t.c = cc;
        if (!t.StaticOrder::next(R, u)) return false;
        u.mh = hh; return true;
    }
};
__device__ __forceinline__ unsigned cvt_pk_bf16(float lo, float hi) { unsigned r; asm volatile("v_cvt_pk_bf16_f32 %0, %1, %2" : "=v"(r) : "v"(lo), "v"(hi)); return r; }
typedef float f32x2 __attribute__((ext_vector_type(2)));
template <class Epi, class Sched, bool ALIGN_EPI = false, bool SP2 = false, int TM = 256>
__device__ __forceinline__ void gemm_phase(PG8_LAS unsigned char* lds, const Gemm g, const Sched& S, const Epi& E) {
    static_assert(SP2, "half-M units are implemented in the SP2 loop only");
    static_assert(TM == 256 || TM == 192, "row tile");
    constexpr int HI_PIECES = TM == 256 ? 2 : 1, HI_M = TM == 256 ? 4 : 2;
    int tid_l = threadIdx.x; asm volatile("" : "+v"(tid_l));
    const int tid = tid_l, wid = __builtin_amdgcn_readfirstlane(tid >> 6), lane = tid & 63, wr = wid >> 2, wc = wid & 3, fr = lane & 15, fq = lane >> 4;
    const int K = g.K, nt = K / BK;
    unsigned voffA[2], voffB[2];
#pragma unroll
    for (int i = 0; i < 2; ++i) { int R, C; stage_rc(tid * 16 + i * 8192, R, C); const int Rb = Epi::PERM ? ((R & ~31) + perm32(R & 31)) : R;
        voffA[i] = (unsigned)(R * K + C) * 2u; voffB[i] = (unsigned)(Rb * K + C) * 2u; }
    const size_t kstep = (size_t)(BK * 2);
    const size_t hstep = (size_t)HALF * K * 2;
    const size_t tstep = 2 * hstep;
    const size_t tstepA = TM == 256 ? tstep : (size_t)192 * K * 2;
    const unsigned ldsw = (unsigned)wid * 1024u;
    const int aoff = lds_byte(wr * 64 + fr, fq * 8), boff = lds_byte(wc * 32 + fr, fq * 8), aoff_hi = TM == 256 ? aoff : lds_byte(wr * 32 + fr, fq * 8);
#define PG8_SA(b, h) (((b) * 2 + (h)) * HTB)
#define PG8_SB(b, h) ((4 + (b) * 2 + (h)) * HTB)
#define PG8_STAGE(bufoff, gbase, voff) do { _Pragma("unroll") for (int _i = 0; _i < 2; ++_i) \
        __builtin_amdgcn_global_load_lds((const unsigned*)((const char*)(gbase) + (voff)[_i]), (PG8_LAS unsigned*)(lds + (bufoff) + ldsw + _i * 8192), 16, 0, 0); } while (0)
#define PG8_STAGE_HI(bufoff, gbase, voff) do { _Pragma("unroll") for (int _i = 0; _i < HI_PIECES; ++_i) \
        __builtin_amdgcn_global_load_lds((const unsigned*)((const char*)(gbase) + (voff)[_i]), (PG8_LAS unsigned*)(lds + (bufoff) + ldsw + _i * 8192), 16, 0, 0); } while (0)
#define PG8_LDA_HI(dst, b) do { _Pragma("unroll") for (int m = 0; m < HI_M; ++m) _Pragma("unroll") for (int k = 0; k < 2; ++k) dst[m][k] = *(const PG8_LAS bf16x8*)(lds + PG8_SA(b, 1) + aoff_hi + m * 2048 + k * 1024); } while (0)
#define PG8_MMA_HI(bj, At, Bt) do { __builtin_amdgcn_s_setprio(1); _Pragma("unroll") for (int m = 0; m < HI_M; ++m) _Pragma("unroll") for (int n = 0; n < 2; ++n) _Pragma("unroll") for (int k = 0; k < 2; ++k) \
        acc[1][bj][m][n] = __builtin_amdgcn_mfma_f32_16x16x32_bf16(Bt[n][k], At[m][k], acc[1][bj][m][n], 0, 0, 0); __builtin_amdgcn_s_setprio(0); } while (0)
#define PG8_WAIT_LOOP do { if constexpr (TM == 256) asm volatile("s_waitcnt vmcnt(8)" ::: "memory"); else asm volatile("s_waitcnt vmcnt(7)" ::: "memory"); } while (0)
#define PG8_LDA(dst, b, h) do { _Pragma("unroll") for (int m = 0; m < 4; ++m) _Pragma("unroll") for (int k = 0; k < 2; ++k) dst[m][k] = *(const PG8_LAS bf16x8*)(lds + PG8_SA(b, h) + aoff + m * 2048 + k * 1024); } while (0)
#define PG8_LDB(dst, b, h) do { _Pragma("unroll") for (int n = 0; n < 2; ++n) _Pragma("unroll") for (int k = 0; k < 2; ++k) dst[n][k] = *(const PG8_LAS bf16x8*)(lds + PG8_SB(b, h) + boff + n * 2048 + k * 1024); } while (0)
#define PG8_MMA(ai, bj, At, Bt) do { __builtin_amdgcn_s_setprio(1); _Pragma("unroll") for (int m = 0; m < 4; ++m) _Pragma("unroll") for (int n = 0; n < 2; ++n) _Pragma("unroll") for (int k = 0; k < 2; ++k) \
        acc[ai][bj][m][n] = __builtin_amdgcn_mfma_f32_16x16x32_bf16(Bt[n][k], At[m][k], acc[ai][bj][m][n], 0, 0, 0); __builtin_amdgcn_s_setprio(0); } while (0)
#define PG8_WAIT_V(n) asm volatile("s_waitcnt vmcnt(" #n ")" ::: "memory")
#define PG8_WAIT_L(n) asm volatile("s_waitcnt lgkmcnt(" #n ")" ::: "memory")
#define PG8_BAR __builtin_amdgcn_s_barrier()
#define PG8_SCHED __builtin_amdgcn_sched_barrier(0)
    Unit cur, nxt; int ui = 0;
    if (!S.next(0, cur)) return;
    f32x4 acc[2][2][4][2];
#pragma unroll
    for (int a = 0; a < 2; ++a)
#pragma unroll
        for (int b = 0; b < 2; ++b)
#pragma unroll
            for (int m = 0; m < 4; ++m)
#pragma unroll
                for (int n = 0; n < 2; ++n) acc[a][b][m][n] = (f32x4){0.f, 0.f, 0.f, 0.f};
    bf16x8 At[4][2], B0[2][2], B1[2][2];
    bool c_half = cur.mh >= 0; size_t c_ahi = c_half ? 0 : hstep;
    const char* cA = (const char*)g.A + (size_t)cur.pm * tstepA + (cur.mh > 0 ? hstep : 0); const char* cB = (const char*)g.Bt + (size_t)cur.pn * tstep;
    S.a_ready(cur);
    if constexpr (SP2) {
        PG8_STAGE(PG8_SB(0, 0), cB, voffB); PG8_STAGE(PG8_SB(0, 1), cB + hstep, voffB); PG8_STAGE(PG8_SA(0, 0), cA, voffA); PG8_STAGE_HI(PG8_SA(0, 1), cA + c_ahi, voffA);
        if (wr == 1) PG8_BAR;
        if constexpr (TM == 256) PG8_WAIT_V(2); else PG8_WAIT_V(1);
        PG8_BAR;
        PG8_STAGE(PG8_SB(1, 0), cB + kstep, voffB); PG8_STAGE(PG8_SA(1, 0), cA + kstep, voffA); PG8_STAGE(PG8_SB(1, 1), cB + hstep + kstep, voffB);
        PG8_WAIT_V(6); PG8_BAR;
    } else {
        PG8_STAGE(PG8_SB(0, 0), cB, voffB); PG8_STAGE(PG8_SA(0, 0), cA, voffA); PG8_STAGE(PG8_SB(0, 1), cB + hstep, voffB); PG8_STAGE(PG8_SA(0, 1), cA + hstep, voffA);
        if (wr == 1) PG8_BAR;
        PG8_WAIT_V(4); PG8_BAR;
        PG8_STAGE(PG8_SB(1, 0), cB + kstep, voffB); PG8_STAGE(PG8_SA(1, 0), cA + kstep, voffA); PG8_STAGE(PG8_SB(1, 1), cB + hstep + kstep, voffB);
        PG8_WAIT_V(6); PG8_BAR;
    }
    for (;;) {
        const bool has_next = S.next(ui + 1, nxt);
        const char* nA = has_next ? (const char*)g.A + (size_t)nxt.pm * tstepA + (nxt.mh > 0 ? hstep : 0) : cA; const char* nB = has_next ? (const char*)g.Bt + (size_t)nxt.pn * tstep : cB;
        const bool n_half = has_next ? (nxt.mh >= 0) : c_half; const size_t n_ahi = n_half ? 0 : hstep;
        for (int t = 0; t < nt; t += 2) {
            const bool last = (t == nt - 2);
            const char* a1 = cA + (size_t)(t + 1) * kstep;
            const char* a2 = last ? nA : cA + (size_t)(t + 2) * kstep; const char* b2 = last ? nB : cB + (size_t)(t + 2) * kstep;
            const char* a3 = a2 + kstep; const char* b3 = b2 + kstep;
            if (last && has_next) S.a_ready(nxt);
            if constexpr (SP2) {
            PG8_LDA(At, 0, 0); PG8_LDB(B0, 0, 0); PG8_LDB(B1, 0, 1); PG8_STAGE_HI(PG8_SA(1, 1), a1 + c_ahi, voffA);
            PG8_WAIT_LOOP; PG8_WAIT_L(0); PG8_BAR; PG8_MMA(0, 0, At, B0); PG8_MMA(0, 1, At, B1); PG8_BAR; PG8_SCHED;
            if (!c_half) PG8_LDA_HI(At, 0); PG8_STAGE(PG8_SB(0, 0), b2, voffB); PG8_STAGE(PG8_SB(0, 1), b2 + hstep, voffB); PG8_STAGE(PG8_SA(0, 0), a2, voffA);
            PG8_WAIT_LOOP; PG8_WAIT_L(0); PG8_BAR; if (!c_half) { PG8_MMA_HI(0, At, B0); PG8_MMA_HI(1, At, B1); } PG8_BAR; PG8_SCHED;
            PG8_LDA(At, 1, 0); PG8_LDB(B0, 1, 0); PG8_LDB(B1, 1, 1); PG8_STAGE_HI(PG8_SA(0, 1), a2 + (last ? n_ahi : c_ahi), voffA);
            PG8_WAIT_LOOP; PG8_WAIT_L(0); PG8_BAR; PG8_MMA(0, 0, At, B0); PG8_MMA(0, 1, At, B1); PG8_BAR; PG8_SCHED;
            if (!c_half) PG8_LDA_HI(At, 1); PG8_STAGE(PG8_SB(1, 0), b3, voffB); PG8_STAGE(PG8_SB(1, 1), b3 + hstep, voffB); PG8_STAGE(PG8_SA(1, 0), a3, voffA);
            PG8_WAIT_LOOP; PG8_WAIT_L(0); PG8_BAR; if (!c_half) { PG8_MMA_HI(0, At, B0); PG8_MMA_HI(1, At, B1); } PG8_BAR; PG8_SCHED;
            } else {
            PG8_LDB(B0, 0, 0); PG8_SCHED; PG8_LDA(At, 0, 0); PG8_STAGE(PG8_SA(1, 1), a1 + hstep, voffA);
            PG8_WAIT_L(8); PG8_BAR; PG8_WAIT_L(0); PG8_MMA(0, 0, At, B0); PG8_BAR; PG8_SCHED;
            PG8_LDB(B1, 0, 1); PG8_STAGE(PG8_SB(0, 0), b2, voffB);
            PG8_BAR; PG8_WAIT_L(0); PG8_MMA(0, 1, At, B1); PG8_BAR;
            PG8_LDA(At, 0, 1); PG8_STAGE(PG8_SA(0, 0), a2, voffA);
            PG8_BAR; PG8_WAIT_L(0); PG8_MMA(1, 0, At, B0); PG8_BAR; PG8_SCHED;
            PG8_STAGE(PG8_SB(0, 1), b2 + hstep, voffB);
            PG8_WAIT_V(6); PG8_BAR; PG8_MMA(1, 1, At, B1); PG8_BAR;
            PG8_LDB(B0, 1, 0); PG8_SCHED; PG8_LDA(At, 1, 0); PG8_STAGE(PG8_SA(0, 1), a2 + hstep, voffA);
            PG8_WAIT_L(8); PG8_BAR; PG8_WAIT_L(0); PG8_MMA(0, 0, At, B0); PG8_BAR; PG8_SCHED;
            PG8_LDB(B1, 1, 1); PG8_STAGE(PG8_SB(1, 0), b3, voffB);
            PG8_BAR; PG8_WAIT_L(0); PG8_MMA(0, 1, At, B1); PG8_BAR;
            PG8_LDA(At, 1, 1); PG8_STAGE(PG8_SA(1, 0), a3, voffA);
            PG8_BAR; PG8_WAIT_L(0); PG8_MMA(1, 0, At, B0); PG8_BAR; PG8_SCHED;
            PG8_STAGE(PG8_SB(1, 1), b3 + hstep, voffB);
            PG8_WAIT_V(6); PG8_BAR; PG8_MMA(1, 1, At, B1); PG8_BAR;
            }
        }
        if constexpr (ALIGN_EPI) { if (wr == 0) PG8_BAR; }
        if constexpr (!Epi::AFTER_DRAIN) { E(acc, cur, wr, wc, fr, fq); S.done(cur); }
        if (!has_next) break;
#pragma unroll
        for (int a = 0; a < 2; ++a)
#pragma unroll
            for (int b = 0; b < 2; ++b)
#pragma unroll
                for (int m = 0; m < 4; ++m)
#pragma unroll
                    for (int n = 0; n < 2; ++n) acc[a][b][m][n] = (f32x4){0.f, 0.f, 0.f, 0.f};
        cur = nxt; cA = nA; cB = nB; c_half = n_half; c_ahi = n_ahi; ++ui;
        if constexpr (ALIGN_EPI) { if (wr == 1) PG8_BAR; }
    }
    PG8_WAIT_V(0);
    if constexpr (!ALIGN_EPI) { if (wr == 0) PG8_BAR; }
    PG8_BAR;
    if constexpr (Epi::AFTER_DRAIN) { E.fused(acc, cur, wr, wc, fr, fq, lds, wid, lane); S.done(cur); }
#undef PG8_SA
#undef PG8_SB
#undef PG8_STAGE
#undef PG8_LDA
#undef PG8_STAGE_HI
#undef PG8_LDA_HI
#undef PG8_MMA_HI
#undef PG8_WAIT_LOOP
#undef PG8_LDB
#undef PG8_MMA
#undef PG8_WAIT_V
#undef PG8_WAIT_L
#undef PG8_BAR
#undef PG8_SCHED
}
}

#define GAS __attribute__((address_space(1)))
#define LAS __attribute__((address_space(3)))
typedef unsigned short bf16;
typedef short bf16x8 __attribute__((ext_vector_type(8)));
typedef float f32x4 __attribute__((ext_vector_type(4)));
typedef unsigned u32x4 __attribute__((ext_vector_type(4)));
typedef unsigned u32x2 __attribute__((ext_vector_type(2)));
#define LDS_WAIT() asm volatile("s_waitcnt lgkmcnt(0)" ::: "memory")
#define VM_WAIT() asm volatile("s_waitcnt vmcnt(0)" ::: "memory")

#ifndef EN_P0
#define EN_P0 1
#endif
#ifndef EN_ADALN
#define EN_ADALN 1
#endif
#ifndef EN_G1
#define EN_G1 1
#endif
#ifndef EN_GAB
#define EN_GAB 1
#endif
#ifndef EN_L1
#define EN_L1 1
#endif
#ifndef EN_NA
#define EN_NA 1
#endif
#ifndef EN_DP
#define EN_DP 1
#endif
#ifndef EN_L3
#define EN_L3 1
#endif
#ifndef EN_GCD
#define EN_GCD 1
#endif
#ifndef EN_POST
#define EN_POST 1
#endif
#ifndef EN_GQD
#define EN_GQD 1
#endif
#ifndef EN_GKNV
#define EN_GKNV 1
#endif
#ifndef EN_GQA
#define EN_GQA 1
#endif
#ifndef EN_MLA
#define EN_MLA 1
#endif
#ifndef EN_RES
#define EN_RES 1
#endif
#ifndef EN_MIXRES
#define EN_MIXRES 1
#endif
#ifndef EN_FINAL
#define EN_FINAL 1
#endif
#ifndef DUP_MASK
#define DUP_MASK 0
#endif
#define REPS(k) (((DUP_MASK >> (k)) & 1) + 1)
#ifndef ATT_DEFER
#define ATT_DEFER 6.0f
#endif
#ifndef RES_TM
#define RES_TM 192
#endif
#ifndef MK_PER_PHASE
#define MK_PER_PHASE 0
#endif

constexpr int D = 2048, DFF = 5632, MP = 4096, MS = 8192, MT = 12288, MKV = 16384;
constexpr int NMODC = 9 * 2048;
constexpr float EPS = 1e-6f;
constexpr float LOG2E = 1.4426950408889634f;
constexpr float QS64 = 0.125f * LOG2E;
constexpr float QS192 = 0.07216878364870322f * LOG2E;
constexpr int NWAVES = 8;
constexpr int N_PHASES = 48;

constexpr size_t O_YP = 0, O_YS = O_YP + (size_t)MP * D, O_SF = O_YS + (size_t)MS * D, O_SB = O_SF + 16 * 2 * 1024, O_NAK = O_SB + 16 * 2 * 1024,
                 O_NAV = O_NAK + (size_t)16 * 2 * 256 * 1024, O_GK = O_NAV + (size_t)16 * 2 * 256 * 1024, O_GV = O_GK + (size_t)16 * 2 * 256 * 256,
                 O_CKV = O_GV + (size_t)16 * 2 * 256 * 256, O_KR = O_CKV + (size_t)16 * 2 * 256 * 512, O_END = O_KR + (size_t)16 * 2 * 256 * 64;

constexpr size_t MiB = 1u << 20;
constexpr size_t WS_CTL = 0, WS_MOD = 1 * MiB, CTL_ZERO_BYTES = 64 * 1024;
constexpr size_t WS_ROPE = 4 * MiB;
constexpr size_t WS_LRUW = 5 * MiB;
constexpr size_t WS_W1 = 8 * MiB;
constexpr size_t WS_W2 = WS_W1 + 352 * MiB;
constexpr size_t WS_WABI = WS_W2 + 176 * MiB;
constexpr size_t WS_WABO = WS_WABI + 40 * MiB;
constexpr size_t WS_WCDI = WS_WABO + 16 * MiB;
constexpr size_t WS_WCDO = WS_WCDI + 22 * MiB;
constexpr size_t WS_WUQ = WS_WCDO + 16 * MiB;
constexpr size_t WS_WUKV = WS_WUQ + 3 * MiB;
constexpr size_t WS_KCNA = WS_WUKV + 4 * MiB;
constexpr size_t WS_VTCNA = WS_KCNA + 16 * MiB;
constexpr size_t WS_KCG = WS_VTCNA + 16 * MiB;
constexpr size_t WS_VTCG = WS_KCG + 4 * MiB;
constexpr size_t WS_CKVALL = WS_VTCG + 4 * MiB;
constexpr size_t WS_KRALL = WS_CKVALL + 32 * MiB;
constexpr size_t WS_X = WS_KRALL + 4 * MiB;
constexpr size_t WS_H = WS_X + 96 * MiB;
constexpr size_t WS_ACT = WS_H + 48 * MiB;
constexpr size_t WS_YCAT = WS_ACT + 132 * MiB;
constexpr size_t WS_XAGA = WS_YCAT + 48 * MiB;
constexpr size_t WS_QB = WS_XAGA + 48 * MiB;
constexpr size_t WS_KB = WS_QB + 24 * MiB;
constexpr size_t WS_VT = WS_KB + 24 * MiB;
constexpr size_t WS_LRU = WS_VT + 24 * MiB;
constexpr size_t WS_AGG = WS_LRU + 96 * MiB;
constexpr size_t WS_RAW = WS_AGG + 4 * MiB;
constexpr size_t WS_QG = WS_RAW + 66 * MiB;
constexpr size_t WS_KG = WS_QG + 24 * MiB;
constexpr size_t WS_VGT = WS_KG + 6 * MiB;
constexpr size_t WS_QA = WS_VGT + 6 * MiB;
constexpr size_t WS_QD = WS_QA + 12 * MiB;
constexpr size_t WS_KN = WS_QD + 36 * MiB;
constexpr size_t WS_VDT = WS_KN + 32 * MiB;
constexpr size_t WS_END = WS_VDT + 32 * MiB;
constexpr int CW_RANK = 9216;
constexpr int CW_BAR = 4096;

constexpr int RING_BYTES = 131072;
constexpr int SCR_PER_WAVE = 16640;
constexpr int MISC_OFF = 135168;
constexpr int LDS_BYTES = 147456;
static_assert(NWAVES * SCR_PER_WAVE <= MISC_OFF && MISC_OFF + 256 <= LDS_BYTES, "LDS map");

typedef float f32x2_t __attribute__((ext_vector_type(2))); typedef __bf16 bf16x2_t __attribute__((ext_vector_type(2)));
__device__ __forceinline__ unsigned pkbf(float lo, float hi) { f32x2_t v = {lo, hi}; bf16x2_t b = __builtin_convertvector(v, bf16x2_t); return __builtin_bit_cast(unsigned, b); }
__device__ __forceinline__ float bflo(unsigned w) { return __uint_as_float(w << 16); }
__device__ __forceinline__ float bfhi(unsigned w) { return __uint_as_float(w & 0xffff0000u); }
__device__ __forceinline__ float fexp2(float x) { return __builtin_amdgcn_exp2f(x); }
__device__ __forceinline__ float frcp(float x) { return __builtin_amdgcn_rcpf(x); }
__device__ __forceinline__ float sigmoidf_(float x) { return frcp(1.0f + fexp2(-x * LOG2E)); }
__device__ __forceinline__ float wave_sum(float v) {
#pragma unroll
    for (int o = 1; o < 64; o <<= 1) v += __shfl_xor(v, o);
    return v;
}
__device__ __forceinline__ int cond_of_row(int m) { return m < MP ? 0 : 1 + ((m - MP) >> 10); }
__device__ __forceinline__ bf16x8 ld16(const bf16* p) { return *(const bf16x8*)p; }

#define XB_TMO      128
#define XB_XCNT(j)  (256  + 64 * (j))
#define XB_XSUB(j)  (1280 + 64 * (j))
#define XB_XGEN(j)  (2304 + 64 * (j))
#define XB_TOP      3328
#define XB_TOPGEN   3392
#define XCD_BAR_WORDS 3456
#define XB_SPIN_CAP (1u << 18)

__device__ __forceinline__ unsigned xb_ld(unsigned* p)              { return __hip_atomic_load(p, __ATOMIC_RELAXED, __HIP_MEMORY_SCOPE_AGENT); }
__device__ __forceinline__ unsigned xb_add(unsigned* p, unsigned v) { return __hip_atomic_fetch_add(p, v, __ATOMIC_RELAXED, __HIP_MEMORY_SCOPE_AGENT); }
__device__ __forceinline__ unsigned xb_xcc_id() { return (unsigned)__builtin_amdgcn_s_getreg((3 << 11) | 20) & 0xFu; }
#define XB_SPIN(cond, bar) do { unsigned _sp = 0; while (cond) { __builtin_amdgcn_s_sleep(1); \
    if ((++_sp & 255u) == 0u) { if (xb_ld(&(bar)[XB_TMO])) break; if (_sp > XB_SPIN_CAP) { atomicAdd(&(bar)[XB_TMO], 1u); break; } } } } while (0)

struct XcdBarrier {
    unsigned* bar; unsigned x;
    volatile LAS unsigned* st;
};

__device__ __forceinline__ XcdBarrier xcd_barrier_post(unsigned* bar, volatile LAS unsigned* st) {
    XcdBarrier b; b.bar = bar; b.x = xb_xcc_id(); b.st = st;
    if (threadIdx.x == 0) (void)xb_add(&bar[XB_XCNT(b.x)], 1u);
    return b;
}
__device__ __forceinline__ void xcd_barrier_complete(unsigned* bar, unsigned x, unsigned& nloc, unsigned& nx) {
    const unsigned G = gridDim.x * gridDim.y * gridDim.z;
    unsigned sum, cnt, mine, sp = 0u;
    for (;;) {
        sum = 0u; cnt = 0u; mine = 0u;
#pragma unroll
        for (unsigned j = 0; j < 16; ++j) { const unsigned c = xb_ld(&bar[XB_XCNT(j)]); sum += c; cnt += (c > 0u) ? 1u : 0u; mine = (j == x) ? c : mine; }
        if (sum == G) break;
        __builtin_amdgcn_s_sleep(1);
        if ((++sp & 255u) == 0u) { if (xb_ld(&bar[XB_TMO])) break; if (sp > XB_SPIN_CAP) { atomicAdd(&bar[XB_TMO], 1u); break; } }
    }
    nloc = mine > 0u ? mine : 1u; nx = cnt > 0u ? cnt : 1u;
}

__device__ __forceinline__ void xcd_barrier(const XcdBarrier& b) {
    asm volatile("s_waitcnt vmcnt(0)" ::: "memory");
    __syncthreads();
    if (threadIdx.x == 0) {
        unsigned* bar = b.bar;
        __builtin_amdgcn_s_waitcnt(0);
        unsigned nloc = b.st[0], nx = b.st[1];
        if (nloc == 0u) { xcd_barrier_complete(bar, b.x, nloc, nx); b.st[0] = nloc; b.st[1] = nx; }
        const unsigned old = xb_add(&bar[XB_XSUB(b.x)], 1u);
        const unsigned gen = old / nloc;
        if (old + 1u == (gen + 1u) * nloc) {
            __builtin_amdgcn_fence(__ATOMIC_RELEASE, "agent");
            asm volatile("s_waitcnt vmcnt(0)" ::: "memory");
            const unsigned og = xb_add(&bar[XB_TOP], 1u);
            const unsigned tg = og / nx;
            if (og + 1u == (tg + 1u) * nx) xb_add(&bar[XB_TOPGEN], 1u);
            else XB_SPIN(xb_ld(&bar[XB_TOPGEN]) == tg, bar);
            __builtin_amdgcn_fence(__ATOMIC_ACQUIRE, "agent");
            xb_add(&bar[XB_XGEN(b.x)], 1u);
            asm volatile("s_waitcnt vmcnt(0)" ::: "memory");
        } else {
            XB_SPIN(xb_ld(&bar[XB_XGEN(b.x)]) == gen, bar);
            __builtin_amdgcn_fence(__ATOMIC_ACQUIRE, "agent");
            asm volatile("s_waitcnt vmcnt(0)" ::: "memory");
        }
    }
    __syncthreads();
}

struct Args { const float* in[37]; float* out; unsigned char* ws; int ph_lo, ph_hi; };
struct Frame {
    LAS unsigned char* lds; volatile LAS unsigned* MISC; unsigned* ctl;
    int tid, lane, wave, vcu, G;
    float* out; unsigned char* ws; const Args* a;
};

__device__ __forceinline__ void tr_item(const float* src, size_t ldsrc, bf16* dst, size_t ldd, LAS float* scr, int lane) {
    float tv[64];
#pragma unroll
    for (int i = 0; i < 64; ++i) tv[i] = __builtin_nontemporal_load(src + (size_t)i * ldsrc + lane);
#pragma unroll
    for (int i = 0; i < 64; ++i) scr[i * 65 + lane] = tv[i];
    LDS_WAIT();
    const int c = lane & 7;
#pragma unroll
    for (int jn = 0; jn < 8; ++jn) { const int n = (lane >> 3) + 8 * jn; const LAS float* s = scr + (8 * c) * 65 + n;
        u32x4 o; o.x = pkbf(s[0 * 65], s[1 * 65]); o.y = pkbf(s[2 * 65], s[3 * 65]); o.z = pkbf(s[4 * 65], s[5 * 65]); o.w = pkbf(s[6 * 65], s[7 * 65]);
        *(u32x4*)(dst + (size_t)n * ldd + 8 * c) = o; }
    LDS_WAIT();
}
__device__ __forceinline__ void cvt_copy(const float* src, bf16* dst, size_t n4, int gt, int ngt) {
    for (size_t i = gt; i < n4; i += ngt) { const f32x4 v = ((const f32x4*)src)[i]; u32x2 o; o.x = pkbf(v.x, v.y); o.y = pkbf(v.z, v.w); ((u32x2*)dst)[i] = o; }
}

__device__ __forceinline__ void p0_prologue(Frame& F) {
    LAS float* scr = (LAS float*)(F.lds + F.wave * SCR_PER_WAVE);
    const int gw = F.vcu * NWAVES + F.wave, NGW = F.G * NWAVES, lane = F.lane;
    unsigned char* ws = F.ws;
    constexpr int I_W1 = 8 * 32 * 176, I_W2 = 8 * 88 * 32, I_ABI = 2 * 32 * 80, I_ABO = 2 * 32 * 32, I_CDI = 2 * 32 * 41, I_CDO = 2 * 32 * 32, I_UQ = 2 * 8 * 24, I_UK = 2 * 8 * 16, I_UV = I_UK,
                  I_LRU = 128, I_VNA = 16 * 8 * 16;
    constexpr int NITEMS = I_W1 + I_W2 + I_ABI + I_ABO + I_CDI + I_CDO + I_UQ + I_UK + I_UV + I_LRU + I_VNA;
    for (int it = gw; it < NITEMS; it += NGW) {
        int r = it;
        if (r < I_W1) { const int mat = r / (32 * 176), q = r % (32 * 176), kb = q / 176, nb = q % 176; const int k0 = 64 * kb, n0 = 64 * nb;
            const int drow = n0 < DFF ? 256 * (n0 >> 7) + (n0 & 127) : 256 * ((n0 - DFF) >> 7) + 128 + ((n0 - DFF) & 127);
            tr_item(F.a->in[15] + (size_t)mat * 2048 * 11264 + (size_t)k0 * 11264 + n0, 11264, (bf16*)(ws + WS_W1) + (size_t)mat * 11264 * 2048 + (size_t)drow * 2048 + k0, 2048, scr, lane); continue; } r -= I_W1;
        if (r < I_W2) { const int mat = r / (88 * 32), q = r % (88 * 32), kb = q / 32, nb = q % 32; const int k0 = 64 * kb, n0 = 64 * nb;
            tr_item(F.a->in[16] + (size_t)mat * 5632 * 2048 + (size_t)k0 * 2048 + n0, 2048, (bf16*)(ws + WS_W2) + (size_t)mat * 2048 * 5632 + (size_t)n0 * 5632 + k0, 5632, scr, lane); continue; } r -= I_W2;
        if (r < I_ABI) { const int mat = r / (32 * 80), q = r % (32 * 80), kb = q / 80, nb = q % 80; const int k0 = 64 * kb, n0 = 64 * nb;
            tr_item(F.a->in[17] + (size_t)mat * 2048 * 5120 + (size_t)k0 * 5120 + n0, 5120, (bf16*)(ws + WS_WABI) + (size_t)mat * 5120 * 2048 + (size_t)n0 * 2048 + k0, 2048, scr, lane); continue; } r -= I_ABI;
        if (r < I_ABO) { const int mat = r / 1024, q = r % 1024, kb = q / 32, nb = q % 32; const int k0 = 64 * kb, n0 = 64 * nb;
            tr_item(F.a->in[26] + (size_t)mat * 2048 * 2048 + (size_t)k0 * 2048 + n0, 2048, (bf16*)(ws + WS_WABO) + (size_t)mat * 2048 * 2048 + (size_t)n0 * 2048 + k0, 2048, scr, lane); continue; } r -= I_ABO;
        if (r < I_CDI) { const int mat = r / (32 * 41), q = r % (32 * 41), kb = q / 41, nb = q % 41; const int k0 = 64 * kb, n0 = 64 * nb;
            tr_item(F.a->in[27] + (size_t)mat * 2048 * 2624 + (size_t)k0 * 2624 + n0, 2624, (bf16*)(ws + WS_WCDI) + (size_t)mat * 2816 * 2048 + (size_t)n0 * 2048 + k0, 2048, scr, lane); continue; } r -= I_CDI;
        if (r < I_CDO) { const int mat = r / 1024, q = r % 1024, kb = q / 32, nb = q % 32; const int k0 = 64 * kb, n0 = 64 * nb;
            tr_item(F.a->in[35] + (size_t)mat * 2048 * 2048 + (size_t)k0 * 2048 + n0, 2048, (bf16*)(ws + WS_WCDO) + (size_t)mat * 2048 * 2048 + (size_t)n0 * 2048 + k0, 2048, scr, lane); continue; } r -= I_CDO;
        if (r < I_UQ) { const int mat = r / (8 * 24), q = r % (8 * 24), kb = q / 24, nb = q % 24; const int k0 = 64 * kb, n0 = 64 * nb;
            tr_item(F.a->in[32] + (size_t)mat * 512 * 1536 + (size_t)k0 * 1536 + n0, 1536, (bf16*)(ws + WS_WUQ) + (size_t)mat * 1536 * 512 + (size_t)n0 * 512 + k0, 512, scr, lane); continue; } r -= I_UQ;
        if (r < I_UK) { const int mat = r / 128, q = r % 128, kb = q / 16, nb = q % 16; const int k0 = 64 * kb, n0 = 64 * nb;
            tr_item(F.a->in[33] + (size_t)mat * 512 * 1024 + (size_t)k0 * 1024 + n0, 1024, (bf16*)(ws + WS_WUKV) + (size_t)mat * 2048 * 512 + (size_t)n0 * 512 + k0, 512, scr, lane); continue; } r -= I_UK;
        if (r < I_UV) { const int mat = r / 128, q = r % 128, kb = q / 16, nb = q % 16; const int k0 = 64 * kb, n0 = 64 * nb;
            tr_item(F.a->in[34] + (size_t)mat * 512 * 1024 + (size_t)k0 * 1024 + n0, 1024, (bf16*)(ws + WS_WUKV) + (size_t)mat * 2048 * 512 + (size_t)(1024 + n0) * 512 + k0, 512, scr, lane); continue; } r -= I_UV;
        if (r < I_LRU) { const int ax = r & 1, blk = r >> 1;
            tr_item((ax ? F.a->in[22] : F.a->in[20]) + (size_t)blk * 4096, 64, (bf16*)(ws + WS_LRUW) + ((size_t)((blk >> 4) * 2 + ax) * 16 + (blk & 15)) * 4096, 64, scr, lane); continue; } r -= I_LRU;
        { const int mat = r / 128, q = r % 128, kb = q / 16, nb = q % 16; const int k0 = 64 * kb, n0 = 64 * nb;
            tr_item(F.a->in[5] + (size_t)mat * 512 * 1024 + (size_t)k0 * 1024 + n0, 1024, (bf16*)(ws + WS_VTCNA) + ((size_t)(mat * 2 + (k0 >> 8)) * 1024 + n0) * 256 + (k0 & 255), 256, scr, lane); }
    }
    const int gt = gw * 64 + lane, ngt = NGW * 64;
    { u32x2* X = (u32x2*)(ws + WS_X); const size_t np4 = (size_t)MP * D / 4, nt4 = (size_t)MT * D / 4;
      for (size_t i = gt; i < nt4; i += ngt) { const f32x4 v = i < np4 ? ((const f32x4*)F.a->in[0])[i] : ((const f32x4*)F.a->in[1])[i - np4]; u32x2 w; w.x = pkbf(v.x, v.y); w.y = pkbf(v.z, v.w); X[i] = w; } }
    cvt_copy(F.a->in[4], (bf16*)(ws + WS_KCNA), (size_t)8 * 2 * 512 * 1024 / 4, gt, ngt);
    for (size_t i = gt; i < (size_t)2 * 192 * 2048 / 8; i += ngt) { const size_t e = i * 8, mat = e / (192 * 2048), rem = e % (192 * 2048);
        *(u32x4*)((bf16*)(ws + WS_WCDI) + (mat * 2816 + 2624) * 2048 + rem) = (u32x4){0u, 0u, 0u, 0u}; }
    if (gt < 1024) { const int pos = gt >> 4, i = gt & 15; const float inv = exp2f(-(float)i * (13.287712379549449f / 16.0f)); const float ang = (float)pos * inv;
        ((float*)(ws + WS_ROPE))[gt] = cosf(ang); ((float*)(ws + WS_ROPE))[1024 + gt] = sinf(ang); }
    __syncthreads();
    LAS float* red = (LAS float*)F.lds;
    typedef float f32x2v __attribute__((ext_vector_type(2)));
    for (int u = F.vcu; u < 4 * 144; u += F.G) {
        const int L = u / 144, cc = u % 144;
        f32x2v acc[9];
#pragma unroll
        for (int c = 0; c < 9; ++c) acc[c] = (f32x2v){0.f, 0.f};
#pragma unroll 1
        for (int kq = 0; kq < 4; ++kq) {
            const int kbase = kq * 512 + F.wave * 64;
            float s[9];
#pragma unroll
            for (int c = 0; c < 9; ++c) { const float v = c == 0 ? F.a->in[11][kbase + lane] : F.a->in[10][(c - 1) * 2048 + kbase + lane]; s[c] = v * sigmoidf_(v); }
            const f32x2v* wp = (const f32x2v*)(F.a->in[12] + ((size_t)L * 2048 + kbase) * NMODC + cc * 128) + lane;
#pragma unroll 32
            for (int i = 0; i < 64; ++i) { const f32x2v w = __builtin_nontemporal_load(wp + (size_t)i * (NMODC / 2));
#pragma unroll
                for (int c = 0; c < 9; ++c) { const float sc = __builtin_bit_cast(float, __builtin_amdgcn_readlane(__builtin_bit_cast(int, s[c]), i)); acc[c] += w * sc; } }
        }
#pragma unroll
        for (int c = 0; c < 9; ++c) *(LAS f32x2v*)(red + (F.wave * 9 + c) * 128 + 2 * lane) = acc[c];
        __syncthreads();
        for (int o = F.tid; o < 9 * 128; o += NWAVES * 64) { float v = 0.f;
#pragma unroll
            for (int w = 0; w < 8; ++w) v += red[w * 9 * 128 + o];
            const int c = o >> 7, col = cc * 128 + (o & 127);
            ((float*)(ws + WS_MOD))[((size_t)L * 9 + c) * NMODC + col] = v + F.a->in[13][(size_t)L * NMODC + col]; }
        __syncthreads();
    }
}

__device__ __forceinline__ void unpk8(const u32x4& w, f32x4& a, f32x4& b) {
    a.x = bflo(w.x); a.y = bfhi(w.x); a.z = bflo(w.y); a.w = bfhi(w.y); b.x = bflo(w.z); b.y = bfhi(w.z); b.z = bflo(w.w); b.w = bfhi(w.w); }
__device__ __forceinline__ void adaln_phase(Frame& F, const float* gain, const float* modL, int jsh, int jsc) {
    const int gw = F.vcu * NWAVES + F.wave, NGW = F.G * NWAVES, lane = F.lane;
    const int per = (MT + NGW - 1) / NGW, r0 = gw * per, r1 = (r0 + per) < MT ? (r0 + per) : MT;
    const bf16* X = (const bf16*)(F.ws + WS_X); bf16* H = (bf16*)(F.ws + WS_H);
    int cur = -1; f32x4 gs[4][2], sh[4][2];
    for (int mb = r0; mb < r1; mb += 3) {
        u32x4 w[3][4];
#pragma unroll
        for (int i = 0; i < 3; ++i) { const int m = (mb + i) < r1 ? (mb + i) : (r1 - 1); const u32x4* xr = (const u32x4*)(X + (size_t)m * D) + lane;
#pragma unroll
            for (int j = 0; j < 4; ++j) w[i][j] = xr[64 * j]; }
#pragma unroll
        for (int i = 0; i < 3; ++i) { const int m = mb + i; if (m < r1) {
            const int cond = cond_of_row(m);
            if (cond != cur) { cur = cond;
#pragma unroll
                for (int j = 0; j < 4; ++j)
#pragma unroll
                    for (int h = 0; h < 2; ++h) { const int col = 8 * lane + 512 * j + 4 * h; const f32x4 g = *(const f32x4*)(gain + col), sc = *(const f32x4*)(modL + (size_t)cond * NMODC + jsc * 2048 + col);
                        gs[j][h] = g * (sc + 1.0f); sh[j][h] = *(const f32x4*)(modL + (size_t)cond * NMODC + jsh * 2048 + col); } }
            f32x4 v[4][2]; float ss = 0.f;
#pragma unroll
            for (int j = 0; j < 4; ++j) { unpk8(w[i][j], v[j][0], v[j][1]);
#pragma unroll
                for (int h = 0; h < 2; ++h) ss += (v[j][h].x * v[j][h].x + v[j][h].y * v[j][h].y) + (v[j][h].z * v[j][h].z + v[j][h].w * v[j][h].w); }
            const float rstd = 1.0f / sqrtf(wave_sum(ss) * (1.0f / D) + EPS);
            u32x4* o = (u32x4*)(H + (size_t)m * D) + lane;
#pragma unroll
            for (int j = 0; j < 4; ++j) { const f32x4 y0 = v[j][0] * rstd * gs[j][0] + sh[j][0], y1 = v[j][1] * rstd * gs[j][1] + sh[j][1];
                u32x4 q; q.x = pkbf(y0.x, y0.y); q.y = pkbf(y0.z, y0.w); q.z = pkbf(y1.x, y1.y); q.w = pkbf(y1.z, y1.w); o[64 * j] = q; } } }
    }
}
__device__ __forceinline__ void final_phase(Frame& F) {
    const int gw = F.vcu * NWAVES + F.wave, NGW = F.G * NWAVES, lane = F.lane;
    const bf16* X = (const bf16*)(F.ws + WS_X); const float* gain = F.a->in[36];
    f32x4 g[4][2];
#pragma unroll
    for (int j = 0; j < 4; ++j)
#pragma unroll
        for (int h = 0; h < 2; ++h) g[j][h] = *(const f32x4*)(gain + 8 * lane + 512 * j + 4 * h);
    for (int m = gw; m < MT; m += NGW) {
        const u32x4* xr = (const u32x4*)(X + (size_t)m * D) + lane; u32x4 w[4]; f32x4 v[4][2]; float ss = 0.f;
#pragma unroll
        for (int j = 0; j < 4; ++j) w[j] = xr[64 * j];
#pragma unroll
        for (int j = 0; j < 4; ++j) { unpk8(w[j], v[j][0], v[j][1]);
#pragma unroll
            for (int h = 0; h < 2; ++h) ss += (v[j][h].x * v[j][h].x + v[j][h].y * v[j][h].y) + (v[j][h].z * v[j][h].z + v[j][h].w * v[j][h].w); }
        const float rstd = 1.0f / sqrtf(wave_sum(ss) * (1.0f / D) + EPS);
        f32x4* o = (f32x4*)(F.out + O_YP + (size_t)m * D) + 2 * lane;
#pragma unroll
        for (int j = 0; j < 4; ++j) { o[128 * j] = v[j][0] * rstd * g[j][0]; o[128 * j + 1] = v[j][1] * rstd * g[j][1]; }
    }
}

typedef pg8::Unit Unit;
struct EpiSwiGLU {
    static constexpr bool PERM = true, AFTER_DRAIN = false;
    bf16* O;
    __device__ __forceinline__ void operator()(const f32x4 (&acc)[2][2][4][2], const Unit& u, int wr, int wc, int fr, int fq) const {
        const int row0 = u.pm * 256 + (u.mh > 0 ? 128 : 0) + wr * 64 + fr, col0 = u.pn * 128 + wc * 32 + 8 * fq; const int nai = u.mh < 0 ? 2 : 1;
#pragma unroll
        for (int ai = 0; ai < 2; ++ai) if (ai < nai)
#pragma unroll
            for (int m = 0; m < 4; ++m) { bf16* rowp = O + (size_t)(row0 + ai * 128 + m * 16) * DFF + col0;
                float r[8];
#pragma unroll
                for (int n = 0; n < 2; ++n)
#pragma unroll
                    for (int i = 0; i < 4; ++i) { const float g = acc[ai][0][m][n][i], uu = acc[ai][1][m][n][i]; r[4 * n + i] = g * sigmoidf_(g) * uu; }
                u32x4 w; w.x = pkbf(r[0], r[1]); w.y = pkbf(r[2], r[3]); w.z = pkbf(r[4], r[5]); w.w = pkbf(r[6], r[7]);
                *(u32x4*)rowp = w; }
    }
};
struct EpiResid {
    static constexpr bool PERM = true, AFTER_DRAIN = false;
    bf16* X; const float* gate; float s;
    __device__ __forceinline__ void operator()(const f32x4 (&acc)[2][2][4][2], const Unit& u, int wr, int wc, int fr, int fq) const {
        const int row0 = u.pm * 256 + (u.mh > 0 ? 128 : 0) + wr * 64 + fr, col0 = u.pn * 256 + wc * 32 + 8 * fq; const int nai = u.mh < 0 ? 2 : 1;
        const float* gp = gate + (size_t)cond_of_row(u.pm * 256) * NMODC + col0;
        f32x4 gv[2][2];
#pragma unroll
        for (int bj = 0; bj < 2; ++bj)
#pragma unroll
            for (int h = 0; h < 2; ++h) gv[bj][h] = *(const f32x4*)(gp + bj * 128 + 4 * h) * s;
#pragma unroll
        for (int ai = 0; ai < 2; ++ai) if (ai < nai) {
            u32x4 w[4][2];
#pragma unroll
            for (int m = 0; m < 4; ++m)
#pragma unroll
                for (int bj = 0; bj < 2; ++bj) w[m][bj] = *(const u32x4*)(X + (size_t)(row0 + ai * 128 + m * 16) * D + col0 + bj * 128);
#pragma unroll
            for (int m = 0; m < 4; ++m)
#pragma unroll
                for (int bj = 0; bj < 2; ++bj) { f32x4 x0, x1; unpk8(w[m][bj], x0, x1);
                    x0 = x0 + gv[bj][0] * acc[ai][bj][m][0]; x1 = x1 + gv[bj][1] * acc[ai][bj][m][1];
                    u32x4 q; q.x = pkbf(x0.x, x0.y); q.y = pkbf(x0.z, x0.w); q.z = pkbf(x1.x, x1.y); q.w = pkbf(x1.z, x1.w);
                    *(u32x4*)(X + (size_t)(row0 + ai * 128 + m * 16) * D + col0 + bj * 128) = q; } }
    }
};
struct EpiResid192 {
    static constexpr bool PERM = true, AFTER_DRAIN = false;
    bf16* X; const float* gate; float s;
    __device__ __forceinline__ void operator()(const f32x4 (&acc)[2][2][4][2], const Unit& u, int wr, int wc, int fr, int fq) const {
        const int col0 = u.pn * 256 + wc * 32 + 8 * fq;
#pragma unroll
        for (int ai = 0; ai < 2; ++ai) {
            const int rbase = u.pm * 192 + (ai ? 128 + wr * 32 : wr * 64), nm = ai ? 2 : 4;
            const float* gp = gate + (size_t)cond_of_row(rbase) * NMODC + col0;
            f32x4 gv[2][2];
#pragma unroll
            for (int bj = 0; bj < 2; ++bj)
#pragma unroll
                for (int h = 0; h < 2; ++h) gv[bj][h] = *(const f32x4*)(gp + bj * 128 + 4 * h) * s;
            u32x4 w[4][2];
#pragma unroll
            for (int m = 0; m < 4; ++m) if (m < nm)
#pragma unroll
                for (int bj = 0; bj < 2; ++bj) w[m][bj] = *(const u32x4*)(X + (size_t)(rbase + fr + m * 16) * D + col0 + bj * 128);
#pragma unroll
            for (int m = 0; m < 4; ++m) if (m < nm)
#pragma unroll
                for (int bj = 0; bj < 2; ++bj) { f32x4 x0, x1; unpk8(w[m][bj], x0, x1);
                    x0 = x0 + gv[bj][0] * acc[ai][bj][m][0]; x1 = x1 + gv[bj][1] * acc[ai][bj][m][1];
                    u32x4 q; q.x = pkbf(x0.x, x0.y); q.y = pkbf(x0.z, x0.w); q.z = pkbf(x1.x, x1.y); q.w = pkbf(x1.z, x1.w);
                    *(u32x4*)(X + (size_t)(rbase + fr + m * 16) * D + col0 + bj * 128) = q; } }
    }
};
struct EpiPlain {
    static constexpr bool PERM = true, AFTER_DRAIN = false;
    bf16* O; int ldc;
    __device__ __forceinline__ void operator()(const f32x4 (&acc)[2][2][4][2], const Unit& u, int wr, int wc, int fr, int fq) const {
        const int row0 = u.pm * 256 + (u.mh > 0 ? 128 : 0) + wr * 64 + fr, col0 = u.pn * 256 + wc * 32 + 8 * fq; const int nai = u.mh < 0 ? 2 : 1;
#pragma unroll
        for (int ai = 0; ai < 2; ++ai) if (ai < nai)
#pragma unroll
            for (int m = 0; m < 4; ++m) { bf16* rowp = O + (size_t)(row0 + ai * 128 + m * 16) * ldc + col0;
#pragma unroll
                for (int bj = 0; bj < 2; ++bj) { const f32x4 v0 = acc[ai][bj][m][0], v1 = acc[ai][bj][m][1];
                    u32x4 w; w.x = pkbf(v0[0], v0[1]); w.y = pkbf(v0[2], v0[3]); w.z = pkbf(v1[0], v1[1]); w.w = pkbf(v1[2], v1[3]);
                    *(u32x4*)(rowp + bj * 128) = w; } }
    }
};
__device__ __forceinline__ void vt_store8(bf16* VT, int C, int pm, int c, int r, const f32x4& v0, const f32x4& v1) {
    bf16* p = VT + ((size_t)pm * C + c) * 256 + r;
    const unsigned w0 = pkbf(v0[0], v0[1]), w1 = pkbf(v0[2], v0[3]), w2 = pkbf(v1[0], v1[1]), w3 = pkbf(v1[2], v1[3]);
    p[0 * 256] = (bf16)(w0 & 0xffffu); p[1 * 256] = (bf16)(w0 >> 16); p[2 * 256] = (bf16)(w1 & 0xffffu); p[3 * 256] = (bf16)(w1 >> 16);
    p[4 * 256] = (bf16)(w2 & 0xffffu); p[5 * 256] = (bf16)(w2 >> 16); p[6 * 256] = (bf16)(w3 & 0xffffu); p[7 * 256] = (bf16)(w3 >> 16);
}
struct EpiAB {
    static constexpr bool PERM = true, AFTER_DRAIN = false;
    bf16 *XAGA, *QB, *KB, *VT; float* ock; float* ocv; int j;
    __device__ __forceinline__ void operator()(const f32x4 (&acc)[2][2][4][2], const Unit& u, int wr, int wc, int fr, int fq) const {
        const int rt0 = wr * 64 + fr, ct0 = wc * 32 + 8 * fq;
        const int pn = u.pn, pm = u.pm;
        if (pn < 16) {
            char* dst; int ldc; float sc = 1.0f;
            if (pn < 8) { dst = (char*)(XAGA + pn * 256); ldc = 2048; } else if (pn < 12) { dst = (char*)(QB + (pn - 8) * 256); ldc = 1024; sc = QS64; } else { dst = (char*)(KB + (pn - 12) * 256); ldc = 1024; }
            dst += (size_t)pm * 256 * ldc * 2;
            const unsigned vo = (unsigned)(rt0 * ldc + ct0) * 2u;
            const bool cache = pn >= 12 && pm < 16;
            char* oc = (char*)(ock + ((size_t)(pm * 2 + j) * 256) * 1024 + (pn - 12) * 256);
            const unsigned vc = (unsigned)(rt0 * 1024 + ct0) * 4u;
#pragma unroll
            for (int ai = 0; ai < 2; ++ai)
#pragma unroll
                for (int m = 0; m < 4; ++m) { const int ro = ai * 128 + m * 16;
#pragma unroll
                    for (int bj = 0; bj < 2; ++bj) { const f32x4 v0 = acc[ai][bj][m][0] * sc, v1 = acc[ai][bj][m][1] * sc;
                        u32x4 w; w.x = pkbf(v0[0], v0[1]); w.y = pkbf(v0[2], v0[3]); w.z = pkbf(v1[0], v1[1]); w.w = pkbf(v1[2], v1[3]);
                        *(u32x4*)(dst + (size_t)(ro * ldc + bj * 128) * 2 + vo) = w;
                        if (cache) { char* o = oc + (size_t)(ro * 1024 + bj * 128) * 4; *(f32x4*)(o + vc) = v0; *(f32x4*)(o + vc + 16) = v1; } }
                    asm volatile("" ::: "memory"); }
        } else {
            const int c0 = (pn - 16) * 256;
            char* vt = (char*)(VT + ((size_t)pm * 1024 + c0) * 256);
            const unsigned vv = (unsigned)(ct0 * 256 + rt0) * 2u;
            char* oc = (char*)(ocv + ((size_t)(pm * 2 + j) * 256) * 1024 + c0);
            const unsigned vc = (unsigned)(rt0 * 1024 + ct0) * 4u;
#pragma unroll
            for (int ai = 0; ai < 2; ++ai)
#pragma unroll
                for (int m = 0; m < 4; ++m) { const int ro = ai * 128 + m * 16;
#pragma unroll
                    for (int bj = 0; bj < 2; ++bj) { const f32x4 v0 = acc[ai][bj][m][0], v1 = acc[ai][bj][m][1];
                        const unsigned w0 = pkbf(v0[0], v0[1]), w1 = pkbf(v0[2], v0[3]), w2 = pkbf(v1[0], v1[1]), w3 = pkbf(v1[2], v1[3]);
                        char* p = vt + (size_t)(bj * 128 * 256 + ro) * 2;
                        *(bf16*)(p + vv + 0 * 512) = (bf16)(w0 & 0xffffu); *(bf16*)(p + vv + 1 * 512) = (bf16)(w0 >> 16); *(bf16*)(p + vv + 2 * 512) = (bf16)(w1 & 0xffffu); *(bf16*)(p + vv + 3 * 512) = (bf16)(w1 >> 16);
                        *(bf16*)(p + vv + 4 * 512) = (bf16)(w2 & 0xffffu); *(bf16*)(p + vv + 5 * 512) = (bf16)(w2 >> 16); *(bf16*)(p + vv + 6 * 512) = (bf16)(w3 & 0xffffu); *(bf16*)(p + vv + 7 * 512) = (bf16)(w3 >> 16);
                        if (pm < 16) { char* o = oc + (size_t)(ro * 1024 + bj * 128) * 4; *(f32x4*)(o + vc) = v0; *(f32x4*)(o + vc + 16) = v1; } }
                    asm volatile("" ::: "memory"); }
        }
    }
};
struct EpiQD {
    static constexpr bool PERM = false, AFTER_DRAIN = false;
    bf16* QD; const float* rope;
    __device__ __forceinline__ void operator()(const f32x4 (&acc)[2][2][4][2], const Unit& u, int wr, int wc, int fr, int fq) const {
        const bool smp = u.pm >= 16; const int nai = u.mh < 0 ? 2 : 1, mho = u.mh > 0 ? 128 : 0;
#pragma unroll
        for (int ai = 0; ai < 2; ++ai) if (ai < nai)
#pragma unroll
            for (int m = 0; m < 4; ++m) { const int row = u.pm * 256 + mho + ai * 128 + wr * 64 + m * 16 + fr; const int t = (row - MP) & 1023;
#pragma unroll
                for (int bj = 0; bj < 2; ++bj) { const int cg = u.pn * 256 + bj * 128 + wc * 32; const int eg = cg % 192;
                    f32x4 x1 = acc[ai][bj][m][0], x2 = acc[ai][bj][m][1];
                    if (smp && eg >= 128) { const int pos = (eg == 160) ? (t & 63) : (t >> 6);
                        const f32x4 cs = *(const f32x4*)(rope + pos * 16 + 4 * fq), sn = *(const f32x4*)(rope + 1024 + pos * 16 + 4 * fq);
                        const f32x4 o1 = x1 * cs - x2 * sn, o2 = x2 * cs + x1 * sn; x1 = o1; x2 = o2; }
                    x1 = x1 * QS192; x2 = x2 * QS192;
                    bf16* p = QD + (size_t)row * 1536 + cg + 4 * fq;
                    u32x2 w1; w1.x = pkbf(x1[0], x1[1]); w1.y = pkbf(x1[2], x1[3]); *(u32x2*)p = w1;
                    u32x2 w2; w2.x = pkbf(x2[0], x2[1]); w2.y = pkbf(x2[2], x2[3]); *(u32x2*)(p + 16) = w2; } }
    }
};
struct EpiKNV {
    static constexpr bool PERM = true, AFTER_DRAIN = false;
    bf16 *KN, *VDT;
    __device__ __forceinline__ void operator()(const f32x4 (&acc)[2][2][4][2], const Unit& u, int wr, int wc, int fr, int fq) const {
        const int rt0 = wr * 64 + fr, ct0 = wc * 32 + 8 * fq;
        if (u.pn < 4) { char* dst = (char*)(KN + (size_t)u.pm * 256 * 1024 + u.pn * 256); const unsigned vo = (unsigned)(rt0 * 1024 + ct0) * 2u;
#pragma unroll
            for (int ai = 0; ai < 2; ++ai)
#pragma unroll
                for (int m = 0; m < 4; ++m) { const int ro = ai * 128 + m * 16;
#pragma unroll
                    for (int bj = 0; bj < 2; ++bj) { const f32x4 v0 = acc[ai][bj][m][0], v1 = acc[ai][bj][m][1];
                        u32x4 w; w.x = pkbf(v0[0], v0[1]); w.y = pkbf(v0[2], v0[3]); w.z = pkbf(v1[0], v1[1]); w.w = pkbf(v1[2], v1[3]);
                        *(u32x4*)(dst + (size_t)(ro * 1024 + bj * 128) * 2 + vo) = w; }
                    asm volatile("" ::: "memory"); }
        } else { char* vt = (char*)(VDT + ((size_t)u.pm * 1024 + (u.pn - 4) * 256) * 256); const unsigned vv = (unsigned)(ct0 * 256 + rt0) * 2u;
#pragma unroll
            for (int ai = 0; ai < 2; ++ai)
#pragma unroll
                for (int m = 0; m < 4; ++m) { const int ro = ai * 128 + m * 16;
#pragma unroll
                    for (int bj = 0; bj < 2; ++bj) { const f32x4 v0 = acc[ai][bj][m][0], v1 = acc[ai][bj][m][1];
                        const unsigned w0 = pkbf(v0[0], v0[1]), w1 = pkbf(v0[2], v0[3]), w2 = pkbf(v1[0], v1[1]), w3 = pkbf(v1[2], v1[3]);
                        char* p = vt + (size_t)(bj * 128 * 256 + ro) * 2;
                        *(bf16*)(p + vv + 0 * 512) = (bf16)(w0 & 0xffffu); *(bf16*)(p + vv + 1 * 512) = (bf16)(w0 >> 16); *(bf16*)(p + vv + 2 * 512) = (bf16)(w1 & 0xffffu); *(bf16*)(p + vv + 3 * 512) = (bf16)(w1 >> 16);
                        *(bf16*)(p + vv + 4 * 512) = (bf16)(w2 & 0xffffu); *(bf16*)(p + vv + 5 * 512) = (bf16)(w2 >> 16); *(bf16*)(p + vv + 6 * 512) = (bf16)(w3 & 0xffffu); *(bf16*)(p + vv + 7 * 512) = (bf16)(w3 >> 16); }
                    asm volatile("" ::: "memory"); }
        }
    }
};

__device__ __forceinline__ void prow16(float x, float& lo, float& hi) { auto s_ = __builtin_amdgcn_permlane16_swap(__float_as_uint(x), __float_as_uint(x), false, false); lo = __uint_as_float(s_[0]); hi = __uint_as_float(s_[1]); }
__device__ __forceinline__ void prow32(float x, float& lo, float& hi) { auto s_ = __builtin_amdgcn_permlane32_swap(__float_as_uint(x), __float_as_uint(x), false, false); lo = __uint_as_float(s_[0]); hi = __uint_as_float(s_[1]); }
__device__ __forceinline__ float rows_up16(float x, int fq) { float a, b, c, d, e, f; prow16(x, a, b); prow32(x, c, d); prow16(c, e, f); return fq == 2 ? f : a; }
__device__ __forceinline__ float rows_up32(float x) { float c, d; prow32(x, c, d); return c; }
__device__ __forceinline__ float rows_last(float x) { float c, d, e, f; prow32(x, c, d); prow16(d, e, f); return f; }
__device__ __forceinline__ float rows_dn16(float x, int fq) { float a, b, c, d, e, f; prow16(x, a, b); prow32(x, c, d); prow16(d, e, f); return fq == 1 ? e : b; }
__device__ __forceinline__ float rows_dn32(float x) { float c, d; prow32(x, c, d); return d; }
__device__ __forceinline__ float rows_first(float x) { float c, d, e, f; prow32(x, c, d); prow16(c, e, f); return e; }
__device__ __forceinline__ void lru_scan_store(const float (&a)[4][4], const float (&u)[4][4], bool rev, int fr, int fq, bf16* Ao, bf16* Ho, float& TAo, float& TUo) {
    float cA = 1.f, cU = 0.f;
#pragma unroll
    for (int mi = 0; mi < 4; ++mi) { const int mt = rev ? 3 - mi : mi;
        float ia[4], iu[4]; float A, U;
        if (!rev) { A = a[mt][0]; U = u[mt][0]; ia[0] = A; iu[0] = U;
#pragma unroll
            for (int r = 1; r < 4; ++r) { U = a[mt][r] * U + u[mt][r]; A *= a[mt][r]; ia[r] = A; iu[r] = U; } }
        else { A = a[mt][3]; U = u[mt][3]; ia[3] = A; iu[3] = U;
#pragma unroll
            for (int r = 2; r >= 0; --r) { U = a[mt][r] * U + u[mt][r]; A *= a[mt][r]; ia[r] = A; iu[r] = U; } }
        float PA = A, PU = U, qa, qu, EA, EU, TA, TU;
        if (!rev) {
            qa = rows_up16(PA, fq); qu = rows_up16(PU, fq); if (fq >= 1) { PU = PA * qu + PU; PA = qa * PA; }
            qa = rows_up32(PA); qu = rows_up32(PU); if (fq >= 2) { PU = PA * qu + PU; PA = qa * PA; }
            EA = rows_up16(PA, fq); EU = rows_up16(PU, fq); if (fq == 0) { EA = 1.f; EU = 0.f; }
            TA = rows_last(PA); TU = rows_last(PU);
        } else {
            qa = rows_dn16(PA, fq); qu = rows_dn16(PU, fq); if (fq <= 2) { PU = PA * qu + PU; PA = qa * PA; }
            qa = rows_dn32(PA); qu = rows_dn32(PU); if (fq <= 1) { PU = PA * qu + PU; PA = qa * PA; }
            EA = rows_dn16(PA, fq); EU = rows_dn16(PU, fq); if (fq == 3) { EA = 1.f; EU = 0.f; }
            TA = rows_first(PA); TU = rows_first(PU);
        }
        const float preA = cA * EA, preU = EA * cU + EU;
#pragma unroll
        for (int r = 0; r < 4; ++r) { const float Ac = preA * ia[r], Hc = ia[r] * preU + iu[r]; const size_t off = (size_t)(16 * mt + 4 * fq + r) * 1024;
            Ao[off] = (bf16)(pkbf(Ac, 0.f) & 0xffffu); Ho[off] = (bf16)(pkbf(Hc, 0.f) & 0xffffu); }
        cU = TA * cU + TU; cA = cA * TA;
    }
    TAo = cA; TUo = cU;
}
__device__ __forceinline__ void lru_l1_item(Frame& F, int j, int item, LAS float* scr) {
    const int tt = item >> 4, n = item & 15, lane = F.lane, fr = lane & 15, fq = lane >> 4;
    const int m0 = tt * 64;
    const int s0 = m0 < MP ? (m0 & ~255) : MP + ((m0 - MP) & ~1023);
    const int Lq = m0 < MP ? 256 : 1024, t0 = m0 - s0;
    const bf16* XA = (const bf16*)(F.ws + WS_XAGA);
    const float* convw = F.a->in[18] + (size_t)j * 4 * 1024; const float* convb = F.a->in[19] + (size_t)j * 1024;
    bf16x8 af[4][2];
#pragma unroll
    for (int ks = 0; ks < 2; ++ks) { const int ch0 = 64 * n + 32 * ks + 8 * fq;
        float w[4][8], cb[8];
#pragma unroll
        for (int jj = 0; jj < 4; ++jj) { const f32x4 a = *(const f32x4*)(convw + jj * 1024 + ch0), b = *(const f32x4*)(convw + jj * 1024 + ch0 + 4);
            w[jj][0] = a.x; w[jj][1] = a.y; w[jj][2] = a.z; w[jj][3] = a.w; w[jj][4] = b.x; w[jj][5] = b.y; w[jj][6] = b.z; w[jj][7] = b.w; }
        { const f32x4 a = *(const f32x4*)(convb + ch0), b = *(const f32x4*)(convb + ch0 + 4); cb[0] = a.x; cb[1] = a.y; cb[2] = a.z; cb[3] = a.w; cb[4] = b.x; cb[5] = b.y; cb[6] = b.z; cb[7] = b.w; }
        u32x4 xin[4][4];
#pragma unroll
        for (int mt = 0; mt < 4; ++mt)
#pragma unroll
            for (int jj = 0; jj < 4; ++jj) { int tq = t0 + 16 * mt + fr + jj - 2; tq = tq < 0 ? 0 : (tq > Lq - 1 ? Lq - 1 : tq); xin[mt][jj] = *(const u32x4*)(XA + (size_t)(s0 + tq) * 2048 + ch0); }
#pragma unroll
        for (int mt = 0; mt < 4; ++mt) { const int t = t0 + 16 * mt + fr;
            float acc[8];
#pragma unroll
            for (int e = 0; e < 8; ++e) acc[e] = cb[e];
#pragma unroll
            for (int jj = 0; jj < 4; ++jj) { const int tq = t + jj - 2; const bool in = tq >= 0 && tq < Lq;
                u32x4 xv = xin[mt][jj]; xv.x = in ? xv.x : 0u; xv.y = in ? xv.y : 0u; xv.z = in ? xv.z : 0u; xv.w = in ? xv.w : 0u;
                acc[0] += bflo(xv.x) * w[jj][0]; acc[1] += bfhi(xv.x) * w[jj][1]; acc[2] += bflo(xv.y) * w[jj][2]; acc[3] += bfhi(xv.y) * w[jj][3];
                acc[4] += bflo(xv.z) * w[jj][4]; acc[5] += bfhi(xv.z) * w[jj][5]; acc[6] += bflo(xv.w) * w[jj][6]; acc[7] += bfhi(xv.w) * w[jj][7]; }
            LAS float* sp = scr + (16 * mt + fr) * 65 + 32 * ks + 8 * fq;
#pragma unroll
            for (int e = 0; e < 8; ++e) sp[e] = acc[e];
            u32x4 pk; pk.x = pkbf(acc[0], acc[1]); pk.y = pkbf(acc[2], acc[3]); pk.z = pkbf(acc[4], acc[5]); pk.w = pkbf(acc[6], acc[7]);
            af[mt][ks] = __builtin_bit_cast(bf16x8, pk); } }
    LDS_WAIT();
#pragma unroll 1
    for (int dir = 0; dir < 2; ++dir) {
        const bf16* waT = (const bf16*)(F.ws + WS_LRUW) + ((size_t)((j * 2 + dir) * 2 + 0) * 16 + n) * 4096;
        const bf16* wxT = waT + (size_t)16 * 4096;
        bf16* Ao = (bf16*)(F.ws + WS_LRU) + (size_t)(dir * 2 + 0) * MT * 1024; bf16* Ho = (bf16*)(F.ws + WS_LRU) + (size_t)(dir * 2 + 1) * MT * 1024;
#pragma unroll 1
        for (int nt = 0; nt < 4; ++nt) {
            const int ch = 64 * n + 16 * nt + fr;
            bf16x8 ba[2], bx[2];
#pragma unroll
            for (int ks = 0; ks < 2; ++ks) { ba[ks] = ld16(waT + (16 * nt + fr) * 64 + 32 * ks + 8 * fq); bx[ks] = ld16(wxT + (16 * nt + fr) * 64 + 32 * ks + 8 * fq); }
            const float bav = F.a->in[21][(size_t)(j * 2 + dir) * 1024 + ch], bxv = F.a->in[23][(size_t)(j * 2 + dir) * 1024 + ch], lam = F.a->in[24][(size_t)(j * 2 + dir) * 1024 + ch];
            const float clam = -8.0f * log1pf(expf(-lam));
            float a[4][4], u[4][4];
#pragma unroll
            for (int mt = 0; mt < 4; ++mt) { f32x4 ra = (f32x4){0.f, 0.f, 0.f, 0.f}, ga = (f32x4){0.f, 0.f, 0.f, 0.f};
#pragma unroll
                for (int ks = 0; ks < 2; ++ks) { ra = __builtin_amdgcn_mfma_f32_16x16x32_bf16(af[mt][ks], ba[ks], ra, 0, 0, 0); ga = __builtin_amdgcn_mfma_f32_16x16x32_bf16(af[mt][ks], bx[ks], ga, 0, 0, 0); }
#pragma unroll
                for (int r = 0; r < 4; ++r) { const float rg = sigmoidf_(ra[r] + bav), gi = sigmoidf_(ga[r] + bxv); const float la = clam * rg;
                    const float av = fexp2(la * LOG2E), x2 = 2.0f * la;
                    const float m2s = -x2 * (1.0f + x2 * (0.5f + x2 * (0.16666667f + x2 * (0.041666668f + x2 * (0.0083333338f + x2 * 0.0013888889f)))));
                    const float m2 = x2 > -0.5f ? m2s : 1.0f - av * av;
                    const float mult = __builtin_amdgcn_sqrtf(m2); const float xcv = scr[(16 * mt + 4 * fq + r) * 65 + 16 * nt + fr];
                    a[mt][r] = av; u[mt][r] = mult * gi * xcv; } }
            float TA, TU;
            lru_scan_store(a, u, dir == 1, fr, fq, Ao + (size_t)m0 * 1024 + ch, Ho + (size_t)m0 * 1024 + ch, TA, TU);
            if (fq == 0) { float* ag = (float*)(F.ws + WS_AGG) + ((size_t)(tt * 2 + dir) * 2) * 1024 + ch; ag[0] = TA; ag[1024] = TU; }
        }
    }
    LDS_WAIT();
}
__device__ __forceinline__ float gelu_tanh(float x) { const float z = 0.7978845608028654f * (x + 0.044715f * x * x * x); const float e = fexp2(2.0f * LOG2E * z); const float th = 1.0f - 2.0f * frcp(e + 1.0f); return 0.5f * x * (1.0f + th); }
__device__ __forceinline__ void lru_l3_item(Frame& F, int j, int item) {
    const int tt = item >> 5, rs = (item >> 2) & 7, q = item & 3, lane = F.lane, c0 = 256 * q + 4 * lane;
    const int m0 = tt * 64; const bool smp = m0 >= MP;
    const int s0 = smp ? MP + ((m0 - MP) & ~1023) : (m0 & ~255);
    const int first = s0 >> 6, last = first + (smp ? 16 : 4) - 1;
    const float* AG = (const float*)(F.ws + WS_AGG);
    const bf16* AF = (const bf16*)(F.ws + WS_LRU); const bf16* HF = AF + (size_t)MT * 1024; const bf16* AB = HF + (size_t)MT * 1024; const bf16* HB = AB + (size_t)MT * 1024;
    const bf16* GA = (const bf16*)(F.ws + WS_XAGA) + 1024; bf16* Y = (bf16*)(F.ws + WS_YCAT);
    u32x2 af[8], hf[8], ab[8], hb[8], ga[8];
#pragma unroll
    for (int r = 0; r < 8; ++r) { const size_t m = (size_t)m0 + 8 * rs + r, o = m * 1024 + c0;
        af[r] = *(const u32x2*)(AF + o); hf[r] = *(const u32x2*)(HF + o); ab[r] = *(const u32x2*)(AB + o); hb[r] = *(const u32x2*)(HB + o); ga[r] = *(const u32x2*)(GA + m * 2048 + c0); }
    f32x4 cf = (f32x4){0.f, 0.f, 0.f, 0.f}, cb = cf;
    if (smp) { const int b = (m0 - MP) >> 10; cf = *(const f32x4*)(F.a->in[2] + ((size_t)b * 2 + j) * 1024 + c0); cb = *(const f32x4*)(F.a->in[3] + ((size_t)b * 2 + j) * 1024 + c0); }
    for (int p = first; p < tt; ++p) { const f32x4 A = *(const f32x4*)(AG + ((size_t)(p * 2 + 0) * 2 + 0) * 1024 + c0), U = *(const f32x4*)(AG + ((size_t)(p * 2 + 0) * 2 + 1) * 1024 + c0); cf = A * cf + U; }
    for (int p = last; p > tt; --p) { const f32x4 A = *(const f32x4*)(AG + ((size_t)(p * 2 + 1) * 2 + 0) * 1024 + c0), U = *(const f32x4*)(AG + ((size_t)(p * 2 + 1) * 2 + 1) * 1024 + c0); cb = A * cb + U; }
#pragma unroll
    for (int r = 0; r < 8; ++r) { const size_t m = (size_t)m0 + 8 * rs + r;
        f32x4 vf, vb, g;
        vf.x = bflo(af[r].x) * cf.x + bflo(hf[r].x); vf.y = bfhi(af[r].x) * cf.y + bfhi(hf[r].x); vf.z = bflo(af[r].y) * cf.z + bflo(hf[r].y); vf.w = bfhi(af[r].y) * cf.w + bfhi(hf[r].y);
        vb.x = bflo(ab[r].x) * cb.x + bflo(hb[r].x); vb.y = bfhi(ab[r].x) * cb.y + bfhi(hb[r].x); vb.z = bflo(ab[r].y) * cb.z + bflo(hb[r].y); vb.w = bfhi(ab[r].y) * cb.w + bfhi(hb[r].y);
        g.x = gelu_tanh(bflo(ga[r].x)); g.y = gelu_tanh(bfhi(ga[r].x)); g.z = gelu_tanh(bflo(ga[r].y)); g.w = gelu_tanh(bfhi(ga[r].y));
        const f32x4 y = (vf + vb) * g;
        u32x2 w; w.x = pkbf(y.x, y.y); w.y = pkbf(y.z, y.w);
        *(u32x2*)(Y + m * 2048 + c0) = w;
        if (!smp) { const int t = (int)(m - s0), b = s0 >> 8;
            if (t == 255) *(f32x4*)(F.out + O_SF + ((size_t)b * 2 + j) * 1024 + c0) = vf;
            if (t == 0) *(f32x4*)(F.out + O_SB + ((size_t)b * 2 + j) * 1024 + c0) = vb; }
    }
}

__device__ __forceinline__ float xrow16_max(float x) {
    auto s = __builtin_amdgcn_permlane16_swap(__float_as_uint(x), __float_as_uint(x), false, false); x = fmaxf(__uint_as_float(s[0]), __uint_as_float(s[1]));
    auto t = __builtin_amdgcn_permlane32_swap(__float_as_uint(x), __float_as_uint(x), false, false); return fmaxf(__uint_as_float(t[0]), __uint_as_float(t[1]));
}
__device__ __forceinline__ float xrow16_sum(float x) {
    auto s = __builtin_amdgcn_permlane16_swap(__float_as_uint(x), __float_as_uint(x), false, false); x = __uint_as_float(s[0]) + __uint_as_float(s[1]);
    auto t = __builtin_amdgcn_permlane32_swap(__float_as_uint(x), __float_as_uint(x), false, false); return __uint_as_float(t[0]) + __uint_as_float(t[1]);
}
template <int NKS, int NDT, int QT, class Src>
__device__ __forceinline__ void attn_core(const Src& S, const bf16x8 (&qf)[QT][NKS], f32x4 (&o)[QT][NDT], float (&lsum)[QT]) {
    float mrun[QT];
#pragma unroll
    for (int qt = 0; qt < QT; ++qt) { mrun[qt] = -1e30f; lsum[qt] = 0.f;
#pragma unroll
        for (int dt = 0; dt < NDT; ++dt) o[qt][dt] = (f32x4){0.f, 0.f, 0.f, 0.f}; }
    bf16x8 kf[2][NKS], vf[NDT];
    const int nt = S.ntiles();
    S.loadk(0, kf); S.loadv(0, vf);
#pragma unroll 1
    for (int i = 0; i < nt; ++i) {
        f32x4 sc[QT][2];
#pragma unroll
        for (int qt = 0; qt < QT; ++qt)
#pragma unroll
            for (int s = 0; s < 2; ++s) { f32x4 a = (f32x4){0.f, 0.f, 0.f, 0.f};
#pragma unroll
                for (int ks = 0; ks < NKS; ++ks) a = __builtin_amdgcn_mfma_f32_16x16x32_bf16(kf[s][ks], qf[qt][ks], a, 0, 0, 0);
                sc[qt][s] = a; }
        if (i + 1 < nt) S.loadk(i + 1, kf);
#pragma unroll
        for (int qt = 0; qt < QT; ++qt) {
            S.adjust(i, qt, sc[qt]);
            float tm = fmaxf(fmaxf(fmaxf(sc[qt][0][0], sc[qt][0][1]), fmaxf(sc[qt][0][2], sc[qt][0][3])), fmaxf(fmaxf(sc[qt][1][0], sc[qt][1][1]), fmaxf(sc[qt][1][2], sc[qt][1][3])));
            tm = xrow16_max(tm);
            const float mn = fmaxf(mrun[qt], tm), alpha = fexp2(mrun[qt] - mn); mrun[qt] = mn;
            float p[8]; float ps = 0.f;
#pragma unroll
            for (int s = 0; s < 2; ++s)
#pragma unroll
                for (int r = 0; r < 4; ++r) { p[4 * s + r] = fexp2(sc[qt][s][r] - mn); ps += p[4 * s + r]; }
            lsum[qt] = lsum[qt] * alpha + ps;
#pragma unroll
            for (int dt = 0; dt < NDT; ++dt) o[qt][dt] = o[qt][dt] * alpha;
            u32x4 pk; pk.x = pkbf(p[0], p[1]); pk.y = pkbf(p[2], p[3]); pk.z = pkbf(p[4], p[5]); pk.w = pkbf(p[6], p[7]);
            const bf16x8 pf = __builtin_bit_cast(bf16x8, pk);
#pragma unroll
            for (int dt = 0; dt < NDT; ++dt) o[qt][dt] = __builtin_amdgcn_mfma_f32_16x16x32_bf16(vf[dt], pf, o[qt][dt], 0, 0, 0);
        }
        if (i + 1 < nt) S.loadv(i + 1, vf);
    }
}
template <int NDT>
__device__ __forceinline__ void attn_store(const f32x4 (&o)[NDT], float lsum, bf16* yrow  , int fq) {
    const float l = xrow16_sum(lsum);
    const float inv = 1.0f / l;
#pragma unroll
    for (int dt = 0; dt < NDT; ++dt) { const f32x4 v = o[dt] * inv; u32x2 w; w.x = pkbf(v[0], v[1]); w.y = pkbf(v[2], v[3]); *(u32x2*)(yrow + 16 * dt + 4 * fq) = w; }
}
template <int NKS, int NDT, bool MLA>
struct SegSrc {
    const bf16 *kA, *kB, *rA, *rB, *vA, *vB;
    int nA, nt, ldk, vts, kap0, kap1;
    __device__ __forceinline__ int ntiles() const { return nt; }
    __device__ __forceinline__ void loadk(int i, bf16x8 (&kf)[2][NKS]) const {
        const bool sb = i >= nA; const int key0 = 32 * (sb ? i - nA : i); const bf16* kb = sb ? kB : kA;
        const bf16* p0 = kb + (size_t)(key0 + kap0) * ldk; const bf16* p1 = kb + (size_t)(key0 + kap1) * ldk;
#pragma unroll
        for (int ks = 0; ks < (MLA ? 4 : NKS); ++ks) { kf[0][ks] = ld16(p0 + 32 * ks); kf[1][ks] = ld16(p1 + 32 * ks); }
        if (MLA) { const bf16* rb = sb ? rB : rA; const bf16* r0 = rb + (size_t)(key0 + kap0) * 64; const bf16* r1 = rb + (size_t)(key0 + kap1) * 64;
#pragma unroll
            for (int ks = 4; ks < NKS; ++ks) { kf[0][ks] = ld16(r0 + 32 * (ks - 4)); kf[1][ks] = ld16(r1 + 32 * (ks - 4)); } }
    }
    __device__ __forceinline__ void loadv(int i, bf16x8 (&vf)[NDT]) const {
        const bool sb = i >= nA; const int key0 = 32 * (sb ? i - nA : i); const bf16* p = (sb ? vB : vA) + (size_t)(key0 >> 8) * vts + (key0 & 255);
#pragma unroll
        for (int dt = 0; dt < NDT; ++dt) vf[dt] = ld16(p + dt * 16 * 256);
    }
    __device__ __forceinline__ void adjust(int, int, f32x4 (&)[2]) const {}
};
struct NaSrc {
    const bf16 *kloc, *kctx, *vloc, *vctx; const float* bias;
    int r, rstart, cs, qcol, cstq, kap0, kap1, fq;
    __device__ __forceinline__ int ntiles() const { return 24; }
    __device__ __forceinline__ void loadk(int i, bf16x8 (&kf)[2][2]) const {
        const bf16* kb; int key0;
        if (i < 8) { kb = kloc; key0 = 64 * (rstart + i) + cs; } else { kb = kctx; key0 = 32 * (i - 8); }
        const bf16* p0 = kb + (size_t)(key0 + kap0) * 1024; const bf16* p1 = kb + (size_t)(key0 + kap1) * 1024;
        kf[0][0] = ld16(p0); kf[0][1] = ld16(p0 + 32); kf[1][0] = ld16(p1); kf[1][1] = ld16(p1 + 32);
    }
    __device__ __forceinline__ void loadv(int i, bf16x8 (&vf)[4]) const {
        const bf16* vb; int key0;
        if (i < 8) { vb = vloc; key0 = 64 * (rstart + i) + cs; } else { vb = vctx; key0 = 32 * (i - 8); }
        const bf16* p = vb + (size_t)(key0 >> 8) * (1024 * 256) + (key0 & 255);
#pragma unroll
        for (int dt = 0; dt < 4; ++dt) vf[dt] = ld16(p + dt * 16 * 256);
    }
    __device__ __forceinline__ void adjust(int i, int, f32x4 (&sc)[2]) const {
        if (i < 8) { const int relr = rstart + i - r + 7;
#pragma unroll
            for (int s = 0; s < 2; ++s)
#pragma unroll
                for (int g = 0; g < 4; ++g) { const int ck = cs + 8 * fq + 4 * s + g; const bool ok = ck >= cstq && ck < cstq + 16; int relc = ck - qcol + 15; relc = relc < 0 ? 0 : (relc > 30 ? 30 : relc);
                    const float bv = bias[relr * 31 + relc]; sc[s][g] = ok ? sc[s][g] + bv * LOG2E : -1e30f; } }
    }
};

__device__ __forceinline__ void na_item(Frame& F, int j, int item) {
    const int qi = item & 3, r = (item >> 2) & 15, h = (item >> 6) & 15, b = item >> 10, lane = F.lane, fr = lane & 15, fq = lane >> 4;
    const int srow = MP + b * 1024, c0 = 16 * qi, qcol = c0 + fr;
    const int cs = qi == 0 ? 0 : (qi == 1 ? 8 : (qi == 2 ? 24 : 32));
    const int rs = r - 4 < 0 ? 0 : (r - 4 > 8 ? 8 : r - 4);
    NaSrc S; S.r = r; S.rstart = rs; S.cs = cs; S.qcol = qcol; S.cstq = qcol - 8 < 0 ? 0 : (qcol - 8 > 48 ? 48 : qcol - 8); S.fq = fq;
    S.kap0 = 8 * (fr >> 2) + (fr & 3); S.kap1 = S.kap0 + 4;
    S.kloc = (const bf16*)(F.ws + WS_KB) + (size_t)srow * 1024 + h * 64 + 8 * fq;
    S.kctx = (const bf16*)(F.ws + WS_KCNA) + (size_t)(b * 2 + j) * 512 * 1024 + h * 64 + 8 * fq;
    S.vloc = (const bf16*)(F.ws + WS_VT) + ((size_t)(srow >> 8) * 1024 + h * 64 + fr) * 256 + 8 * fq;
    S.vctx = (const bf16*)(F.ws + WS_VTCNA) + ((size_t)((b * 2 + j) * 2) * 1024 + h * 64 + fr) * 256 + 8 * fq;
    S.bias = F.a->in[25] + (size_t)(j * 16 + h) * 15 * 31;
    const size_t qrow = (size_t)srow + 64 * r + qcol;
    bf16x8 qf[1][2]; const bf16* qp = (const bf16*)(F.ws + WS_QB) + qrow * 1024 + h * 64 + 8 * fq; qf[0][0] = ld16(qp); qf[0][1] = ld16(qp + 32);
    f32x4 o[1][4]; float ls[1];
    attn_core<2, 4, 1, NaSrc>(S, qf, o, ls);
    attn_store<4>(o[0], ls[0], (bf16*)(F.ws + WS_YCAT) + qrow * 2048 + 1024 + h * 64, fq);
}
template <int QT>
__device__ __forceinline__ void dense64_item(Frame& F, const bf16* Q, int ldq, size_t qrow0, int qstep, int qcol0, int qcstep, bf16* Y, int ycol0, int ycstep,
                                             const bf16* KA, const bf16* VA, int nA, const bf16* KB_, const bf16* VB_, int nB, int ldk, int vts) {
    const int lane = F.lane, fr = lane & 15, fq = lane >> 4;
    SegSrc<2, 4, false> S; S.kap0 = 8 * (fr >> 2) + (fr & 3); S.kap1 = S.kap0 + 4; S.nA = nA; S.nt = nA + nB; S.ldk = ldk; S.vts = vts;
    S.kA = KA + 8 * fq; S.kB = KB_ + 8 * fq; S.rA = nullptr; S.rB = nullptr; S.vA = VA + (size_t)fr * 256 + 8 * fq; S.vB = VB_ + (size_t)fr * 256 + 8 * fq;
    bf16x8 qf[QT][2];
#pragma unroll
    for (int qt = 0; qt < QT; ++qt) { const bf16* qp = Q + (qrow0 + (size_t)qstep * qt + fr) * ldq + qcol0 + qcstep * qt + 8 * fq; qf[qt][0] = ld16(qp); qf[qt][1] = ld16(qp + 32); }
    f32x4 o[QT][4]; float ls[QT];
    attn_core<2, 4, QT, SegSrc<2, 4, false>>(S, qf, o, ls);
#pragma unroll
    for (int qt = 0; qt < QT; ++qt) attn_store<4>(o[qt], ls[qt], Y + (qrow0 + (size_t)qstep * qt + fr) * 2048 + ycol0 + ycstep * qt, fq);
}
__device__ __forceinline__ void mla_item(Frame& F, int j, int h, size_t qrow0, size_t krowA, int nA, size_t krowB, int nB) {
    const int lane = F.lane, fr = lane & 15, fq = lane >> 4;
    const bf16* KN = (const bf16*)(F.ws + WS_KN); const bf16* KR = (const bf16*)(F.ws + WS_KRALL) + (size_t)j * MKV * 64; const bf16* VDT = (const bf16*)(F.ws + WS_VDT);
    SegSrc<6, 8, true> S; S.kap0 = 8 * (fr >> 2) + (fr & 3); S.kap1 = S.kap0 + 4; S.nA = nA; S.nt = nA + nB; S.ldk = 1024; S.vts = 1024 * 256;
    S.kA = KN + krowA * 1024 + h * 128 + 8 * fq; S.kB = KN + krowB * 1024 + h * 128 + 8 * fq;
    S.rA = KR + krowA * 64 + 8 * fq; S.rB = KR + krowB * 64 + 8 * fq;
    S.vA = VDT + ((size_t)(krowA >> 8) * 1024 + h * 128 + fr) * 256 + 8 * fq; S.vB = VDT + ((size_t)(krowB >> 8) * 1024 + h * 128 + fr) * 256 + 8 * fq;
    bf16x8 qf[1][6];
    { const bf16* qp = (const bf16*)(F.ws + WS_QD) + (qrow0 + fr) * 1536 + h * 192 + 8 * fq;
#pragma unroll
      for (int ks = 0; ks < 6; ++ks) qf[0][ks] = ld16(qp + 32 * ks); }
    f32x4 o[1][8]; float ls[1];
    attn_core<6, 8, 1, SegSrc<6, 8, true>>(S, qf, o, ls);
    attn_store<8>(o[0], ls[0], (bf16*)(F.ws + WS_YCAT) + (qrow0 + fr) * 2048 + 1024 + h * 128, fq);
}

constexpr int RING_D = 4;
template <int N> __device__ __forceinline__ void wait_vm() { asm volatile("s_waitcnt vmcnt(%0)" :: "n"(N) : "memory"); }
template <int NF8> struct RingPlan { const char* bA[NF8]; const char* bB[NF8]; unsigned voff[NF8]; unsigned pitch[NF8]; bool isv[NF8]; };
template <int NKS, int NDT, class Src>
__device__ __forceinline__ void ring_issue(LAS unsigned char* slot, const Src& S, const RingPlan<(2 * NKS + NDT + 7) / 8>& P, int t, int wave) {
    constexpr int NF = 2 * NKS + NDT, NF8 = (NF + 7) / 8;
    bool segB; unsigned key0; S.tile(t, segB, key0);
    const unsigned offv = S.voffset(key0);
#pragma unroll
    for (int k = 0; k < NF8; ++k) { const int f = wave + 8 * k;
        const char* ub = (segB ? P.bB[k] : P.bA[k]) + (P.isv[k] ? (size_t)offv : (size_t)key0 * P.pitch[k]);
        __builtin_amdgcn_global_load_lds((const unsigned*)(ub + P.voff[k]), (LAS unsigned*)(slot + f * 1024), 16, 0, 0); }
}
template <int NKS, int NDT, int QT, class Src>
__device__ __forceinline__ void attn_ring(LAS unsigned char* ring, const Src& S, const bf16x8 (&qf)[QT][NKS], f32x4 (&o)[QT][NDT], float (&lsum)[QT], int wave, int lane) {
    constexpr int NF = 2 * NKS + NDT, NF8 = (NF + 7) / 8, SLOTB = NF8 * 8 * 1024;
    static_assert(RING_D == 4, "the tile loop is unrolled by the ring depth so that every slot offset is a compile-time constant (else hipcc drains vmcnt ahead of the ds_reads)");
    float mrun[QT]; f32x4 osum[QT];
#pragma unroll
    for (int qt = 0; qt < QT; ++qt) { mrun[qt] = 0.f; osum[qt] = (f32x4){0.f, 0.f, 0.f, 0.f};
#pragma unroll
        for (int dt = 0; dt < NDT; ++dt) o[qt][dt] = (f32x4){0.f, 0.f, 0.f, 0.f}; }
    bool first = true;
    const bf16x8 ones = __builtin_bit_cast(bf16x8, (u32x4){0x3F803F80u, 0x3F803F80u, 0x3F803F80u, 0x3F803F80u});
    const int nt = S.ntiles();
    RingPlan<NF8> P;
#pragma unroll
    for (int k = 0; k < NF8; ++k) { const int f = wave + 8 * k; S.plan(f < NF ? f : f - 8, P.bA[k], P.bB[k], P.voff[k], P.pitch[k], P.isv[k]); }
    asm volatile("s_waitcnt vmcnt(0) lgkmcnt(0)" ::: "memory"); __builtin_amdgcn_s_barrier(); asm volatile("" ::: "memory");
#pragma unroll
    for (int t = 0; t < RING_D - 1; ++t) ring_issue<NKS, NDT, Src>(ring + t * SLOTB, S, P, t, wave);
    f32x4 scE[QT][2], scO[QT][2];
#define ATT_SPROD(dst, slotidx) do { const LAS unsigned char* sl_ = ring + (slotidx) * SLOTB + lane * 16; bf16x8 kf[2][NKS]; \
        _Pragma("unroll") for (int s = 0; s < 2; ++s) _Pragma("unroll") for (int ks = 0; ks < NKS; ++ks) kf[s][ks] = *(const LAS bf16x8*)(sl_ + (s * NKS + ks) * 1024); \
        _Pragma("unroll") for (int qt = 0; qt < QT; ++qt) _Pragma("unroll") for (int s = 0; s < 2; ++s) { const float nm = -mrun[qt]; f32x4 a = (f32x4){nm, nm, nm, nm}; \
            _Pragma("unroll") for (int ks = 0; ks < NKS; ++ks) a = __builtin_amdgcn_mfma_f32_16x16x32_bf16(kf[s][ks], qf[qt][ks], a, 0, 0, 0); dst[qt][s] = a; } } while (0)
    wait_vm<(RING_D - 2) * NF8>(); __builtin_amdgcn_s_barrier(); asm volatile("" ::: "memory");
    bool cur_ok = S.active(0);
    if (cur_ok) ATT_SPROD(scE, 0);
#pragma unroll 1
    for (int i0 = 0; i0 < nt; i0 += RING_D) {
#pragma unroll
        for (int ph = 0; ph < RING_D; ++ph) { const int i = i0 + ph;
        f32x4 (&scC)[QT][2] = (ph & 1) ? scO : scE; f32x4 (&scN)[QT][2] = (ph & 1) ? scE : scO;
        if (i + 1 < nt) { if (i + 2 < nt) wait_vm<NF8>(); else wait_vm<0>(); }
        asm volatile("s_waitcnt lgkmcnt(0)" ::: "memory");
        __builtin_amdgcn_s_barrier(); asm volatile("" ::: "memory");
        if (i + RING_D - 1 < nt) ring_issue<NKS, NDT, Src>(ring + ((ph + RING_D - 1) & (RING_D - 1)) * SLOTB, S, P, i + RING_D - 1, wave);
        const bool nxt_ok = (i + 1 < nt) && S.active(i + 1);
        if (nxt_ok) ATT_SPROD(scN, (ph + 1) & (RING_D - 1));
        if (cur_ok) {
            const LAS unsigned char* slot = ring + ph * SLOTB + lane * 16;
            bf16x8 vf[NDT];
#pragma unroll
            for (int dt = 0; dt < NDT; ++dt) vf[dt] = *(const LAS bf16x8*)(slot + (2 * NKS + dt) * 1024);
#pragma unroll
            for (int qt = 0; qt < QT; ++qt) {
                S.adjust(i, qt, scC[qt]);
                float tm = fmaxf(fmaxf(fmaxf(scC[qt][0][0], scC[qt][0][1]), fmaxf(scC[qt][0][2], scC[qt][0][3])), fmaxf(fmaxf(scC[qt][1][0], scC[qt][1][1]), fmaxf(scC[qt][1][2], scC[qt][1][3])));
                tm = xrow16_max(tm);
                if (first || __builtin_amdgcn_ballot_w64(tm > ATT_DEFER) != 0ull) {
                    const float d = first ? tm : fmaxf(tm, 0.f), alpha = first ? 0.f : fexp2(-d); mrun[qt] += d; osum[qt] = osum[qt] * alpha;
#pragma unroll
                    for (int dt = 0; dt < NDT; ++dt) o[qt][dt] = o[qt][dt] * alpha;
#pragma unroll
                    for (int s = 0; s < 2; ++s) { scC[qt][s] = scC[qt][s] - d; if (nxt_ok) scN[qt][s] = scN[qt][s] - d; } }
                u32x4 pk; pk.x = pkbf(fexp2(scC[qt][0][0]), fexp2(scC[qt][0][1])); pk.y = pkbf(fexp2(scC[qt][0][2]), fexp2(scC[qt][0][3]));
                pk.z = pkbf(fexp2(scC[qt][1][0]), fexp2(scC[qt][1][1])); pk.w = pkbf(fexp2(scC[qt][1][2]), fexp2(scC[qt][1][3]));
                const bf16x8 pf = __builtin_bit_cast(bf16x8, pk);
#pragma unroll
                for (int dt = 0; dt < NDT; ++dt) o[qt][dt] = __builtin_amdgcn_mfma_f32_16x16x32_bf16(vf[dt], pf, o[qt][dt], 0, 0, 0);
                osum[qt] = __builtin_amdgcn_mfma_f32_16x16x32_bf16(ones, pf, osum[qt], 0, 0, 0);
            }
            first = false;
        }
        cur_ok = nxt_ok;
        __builtin_amdgcn_sched_barrier(0);
        }
    }
    asm volatile("s_waitcnt lgkmcnt(0)" ::: "memory");
#undef ATT_SPROD
#pragma unroll
    for (int qt = 0; qt < QT; ++qt) lsum[qt] = osum[qt][0] * 0.25f;
}
template <int NKS, int NDT, int QT, class Src>
__device__ __forceinline__ void attn_ring_np(LAS unsigned char* ring, const Src& S, const bf16x8 (&qf)[QT][NKS], f32x4 (&o)[QT][NDT], float (&lsum)[QT], int wave, int lane) {
    constexpr int NF = 2 * NKS + NDT, NF8 = (NF + 7) / 8, SLOTB = NF8 * 8 * 1024;
    static_assert(RING_D == 4, "the tile loop is unrolled by the ring depth so that every slot offset is a compile-time constant (else hipcc drains vmcnt ahead of the ds_reads)");
    float mrun[QT]; f32x4 osum[QT];
#pragma unroll
    for (int qt = 0; qt < QT; ++qt) { mrun[qt] = 0.f; osum[qt] = (f32x4){0.f, 0.f, 0.f, 0.f};
#pragma unroll
        for (int dt = 0; dt < NDT; ++dt) o[qt][dt] = (f32x4){0.f, 0.f, 0.f, 0.f}; }
    bool first = true;
    const bf16x8 ones = __builtin_bit_cast(bf16x8, (u32x4){0x3F803F80u, 0x3F803F80u, 0x3F803F80u, 0x3F803F80u});
    const int nt = S.ntiles();
    RingPlan<NF8> P;
#pragma unroll
    for (int k = 0; k < NF8; ++k) { const int f = wave + 8 * k; S.plan(f < NF ? f : f - 8, P.bA[k], P.bB[k], P.voff[k], P.pitch[k], P.isv[k]); }
    asm volatile("s_waitcnt vmcnt(0) lgkmcnt(0)" ::: "memory"); __builtin_amdgcn_s_barrier(); asm volatile("" ::: "memory");
#pragma unroll
    for (int t = 0; t < RING_D - 1; ++t) ring_issue<NKS, NDT, Src>(ring + t * SLOTB, S, P, t, wave);
#pragma unroll 1
    for (int i0 = 0; i0 < nt; i0 += RING_D) {
#pragma unroll
        for (int ph = 0; ph < RING_D; ++ph) { const int i = i0 + ph;
        if (i + RING_D - 1 <= nt) wait_vm<(RING_D - 2) * NF8>(); else wait_vm<0>();
        __builtin_amdgcn_s_barrier(); asm volatile("" ::: "memory");
        if (i + RING_D - 1 < nt) ring_issue<NKS, NDT, Src>(ring + ((ph + RING_D - 1) & (RING_D - 1)) * SLOTB, S, P, i + RING_D - 1, wave);
        if (S.active(i)) {
            const LAS unsigned char* slot = ring + ph * SLOTB + lane * 16;
            f32x4 sc[QT][2];
            { bf16x8 kf[2][NKS];
#pragma unroll
              for (int s = 0; s < 2; ++s)
#pragma unroll
                for (int ks = 0; ks < NKS; ++ks) kf[s][ks] = *(const LAS bf16x8*)(slot + (s * NKS + ks) * 1024);
#pragma unroll
              for (int qt = 0; qt < QT; ++qt)
#pragma unroll
                for (int s = 0; s < 2; ++s) { const float nm = -mrun[qt]; f32x4 a = (f32x4){nm, nm, nm, nm};
#pragma unroll
                    for (int ks = 0; ks < NKS; ++ks) a = __builtin_amdgcn_mfma_f32_16x16x32_bf16(kf[s][ks], qf[qt][ks], a, 0, 0, 0);
                    sc[qt][s] = a; } }
            __builtin_amdgcn_sched_barrier(0);
            bf16x8 vf[NDT];
#pragma unroll
            for (int dt = 0; dt < NDT; ++dt) vf[dt] = *(const LAS bf16x8*)(slot + (2 * NKS + dt) * 1024);
#pragma unroll
            for (int qt = 0; qt < QT; ++qt) {
                S.adjust(i, qt, sc[qt]);
                float tm = fmaxf(fmaxf(fmaxf(sc[qt][0][0], sc[qt][0][1]), fmaxf(sc[qt][0][2], sc[qt][0][3])), fmaxf(fmaxf(sc[qt][1][0], sc[qt][1][1]), fmaxf(sc[qt][1][2], sc[qt][1][3])));
                tm = xrow16_max(tm);
                if (first || __builtin_amdgcn_ballot_w64(tm > ATT_DEFER) != 0ull) {
                    const float d = first ? tm : fmaxf(tm, 0.f), alpha = first ? 0.f : fexp2(-d); mrun[qt] += d; osum[qt] = osum[qt] * alpha;
#pragma unroll
                    for (int dt = 0; dt < NDT; ++dt) o[qt][dt] = o[qt][dt] * alpha;
#pragma unroll
                    for (int s = 0; s < 2; ++s) sc[qt][s] = sc[qt][s] - d; }
                u32x4 pk; pk.x = pkbf(fexp2(sc[qt][0][0]), fexp2(sc[qt][0][1])); pk.y = pkbf(fexp2(sc[qt][0][2]), fexp2(sc[qt][0][3]));
                pk.z = pkbf(fexp2(sc[qt][1][0]), fexp2(sc[qt][1][1])); pk.w = pkbf(fexp2(sc[qt][1][2]), fexp2(sc[qt][1][3]));
                const bf16x8 pf = __builtin_bit_cast(bf16x8, pk);
#pragma unroll
                for (int dt = 0; dt < NDT; ++dt) o[qt][dt] = __builtin_amdgcn_mfma_f32_16x16x32_bf16(vf[dt], pf, o[qt][dt], 0, 0, 0);
                osum[qt] = __builtin_amdgcn_mfma_f32_16x16x32_bf16(ones, pf, osum[qt], 0, 0, 0);
            }
            first = false;
        }
        asm volatile("s_waitcnt lgkmcnt(0)" ::: "memory");
        __builtin_amdgcn_sched_barrier(0);
        }
    }
#pragma unroll
    for (int qt = 0; qt < QT; ++qt) lsum[qt] = osum[qt][0] * 0.25f;
}
template <int NKS, int NDT, bool MLA>
struct RingSeg {
    const bf16 *kA, *kB, *rA, *rB, *vA, *vB;
    unsigned oK0, oK1, oR0, oR1, oV;
    int nA, nt, ldk, vts;
    __device__ __forceinline__ void lanes(int fr, int fq) { const int kap0 = 8 * (fr >> 2) + (fr & 3), kap1 = kap0 + 4;
        oK0 = (unsigned)(kap0 * ldk + 8 * fq) * 2u; oK1 = (unsigned)(kap1 * ldk + 8 * fq) * 2u; oR0 = (unsigned)(kap0 * 64 + 8 * fq) * 2u; oR1 = (unsigned)(kap1 * 64 + 8 * fq) * 2u; oV = (unsigned)(fr * 256 + 8 * fq) * 2u; }
    __device__ __forceinline__ int ntiles() const { return nt; }
    __device__ __forceinline__ bool active(int) const { return true; }
    __device__ __forceinline__ void adjust(int, int, f32x4 (&)[2]) const {}
    __device__ __forceinline__ void tile(int t, bool& segB, unsigned& key0) const { segB = t >= nA; key0 = 32u * (unsigned)(segB ? t - nA : t); }
    __device__ __forceinline__ unsigned voffset(unsigned key0) const { return ((key0 >> 8) * (unsigned)vts + (key0 & 255u)) * 2u; }
    __device__ __forceinline__ void plan(int f, const char*& bA, const char*& bB, unsigned& voff, unsigned& pitch, bool& isv) const {
        if (f < 2 * NKS) { const int s = f >= NKS ? 1 : 0, ks = f - s * NKS; isv = false;
            if (MLA && ks >= 4) { voff = s ? oR1 : oR0; pitch = 128u; bA = (const char*)(rA + 32 * (ks - 4)); bB = (const char*)(rB + 32 * (ks - 4)); }
            else { voff = s ? oK1 : oK0; pitch = (unsigned)ldk * 2u; bA = (const char*)(kA + 32 * ks); bB = (const char*)(kB + 32 * ks); } }
        else { isv = true; voff = oV; pitch = 0u; bA = (const char*)(vA + (f - 2 * NKS) * 16 * 256); bB = (const char*)(vB + (f - 2 * NKS) * 16 * 256); }
    }
};
struct RingNa {
    const bf16 *kloc, *kctx, *vloc, *vctx; const LAS float* biasl;
    unsigned oK0, oK1, oV;
    int R0, r, rstart, cs, qcol, cstq, fq;
    __device__ __forceinline__ int ntiles() const { return 28; }
    __device__ __forceinline__ bool active(int i) const { const int kr = R0 + i; return i >= 12 || (kr >= rstart && kr < rstart + 8); }
    __device__ __forceinline__ void tile(int t, bool& segB, unsigned& key0) const { segB = t >= 12; key0 = segB ? 32u * (unsigned)(t - 12) : (unsigned)(64 * (R0 + t) + cs); }
    __device__ __forceinline__ unsigned voffset(unsigned key0) const { return ((key0 >> 8) * (1024u * 256u) + (key0 & 255u)) * 2u; }
    __device__ __forceinline__ void plan(int f, const char*& bA, const char*& bB, unsigned& voff, unsigned& pitch, bool& isv) const {
        if (f < 4) { const int s = f >> 1, ks = f & 1; isv = false; voff = s ? oK1 : oK0; pitch = 2048u; bA = (const char*)(kloc + 32 * ks); bB = (const char*)(kctx + 32 * ks); }
        else { isv = true; voff = oV; pitch = 0u; bA = (const char*)(vloc + (f - 4) * 16 * 256); bB = (const char*)(vctx + (f - 4) * 16 * 256); }
    }
    __device__ __forceinline__ void adjust(int i, int, f32x4 (&sc)[2]) const {
        if (i < 12) { const int relr = R0 + i - r + 7; float bv[8];
#pragma unroll
            for (int k = 0; k < 8; ++k) { const int ck = cs + 8 * fq + k; int relc = ck - qcol + 15; relc = relc < 0 ? 0 : (relc > 30 ? 30 : relc); bv[k] = biasl[relr * 31 + relc]; }
            asm volatile("" : "+v"(bv[0]), "+v"(bv[1]), "+v"(bv[2]), "+v"(bv[3]), "+v"(bv[4]), "+v"(bv[5]), "+v"(bv[6]), "+v"(bv[7]));
#pragma unroll
            for (int s = 0; s < 2; ++s)
#pragma unroll
                for (int g = 0; g < 4; ++g) { const int ck = cs + 8 * fq + 4 * s + g; const bool ok = ck >= cstq && ck < cstq + 16;
                    sc[s][g] = ok ? sc[s][g] + bv[4 * s + g] * LOG2E : -1e30f; } }
    }
};
constexpr int RING_BIAS_OFF = 100 * 1024;
__device__ __forceinline__ void na_group(Frame& F, int j, int grp) {
    const int rh = grp & 1, qi = (grp >> 1) & 3, h = (grp >> 3) & 15, b = grp >> 7, lane = F.lane, fr = lane & 15, fq = lane >> 4;
    const int r = 8 * rh + F.wave, srow = MP + b * 1024, c0 = 16 * qi, qcol = c0 + fr;
    LAS float* bl = (LAS float*)(F.lds + RING_BIAS_OFF);
    asm volatile("s_waitcnt lgkmcnt(0)" ::: "memory"); __builtin_amdgcn_s_barrier();
    for (int e = F.tid; e < 15 * 31; e += NWAVES * 64) bl[e] = F.a->in[25][(size_t)(j * 16 + h) * 15 * 31 + e];
    RingNa S; S.R0 = rh ? 4 : 0; S.r = r; S.rstart = r - 4 < 0 ? 0 : (r - 4 > 8 ? 8 : r - 4); S.cs = qi == 0 ? 0 : (qi == 1 ? 8 : (qi == 2 ? 24 : 32)); S.qcol = qcol;
    S.cstq = qcol - 8 < 0 ? 0 : (qcol - 8 > 48 ? 48 : qcol - 8); S.fq = fq; S.biasl = bl;
    { const int kap0 = 8 * (fr >> 2) + (fr & 3); S.oK0 = (unsigned)(kap0 * 1024 + 8 * fq) * 2u; S.oK1 = (unsigned)((kap0 + 4) * 1024 + 8 * fq) * 2u; S.oV = (unsigned)(fr * 256 + 8 * fq) * 2u; }
    S.kloc = (const bf16*)(F.ws + WS_KB) + (size_t)srow * 1024 + h * 64;
    S.kctx = (const bf16*)(F.ws + WS_KCNA) + (size_t)(b * 2 + j) * 512 * 1024 + h * 64;
    S.vloc = (const bf16*)(F.ws + WS_VT) + ((size_t)(srow >> 8) * 1024 + h * 64) * 256;
    S.vctx = (const bf16*)(F.ws + WS_VTCNA) + ((size_t)((b * 2 + j) * 2) * 1024 + h * 64) * 256;
    const size_t qrow = (size_t)srow + 64 * r + qcol;
    bf16x8 qf[1][2]; const bf16* qp = (const bf16*)(F.ws + WS_QB) + qrow * 1024 + h * 64 + 8 * fq; qf[0][0] = ld16(qp); qf[0][1] = ld16(qp + 32);
    f32x4 o[1][4]; float ls[1];
    attn_ring<2, 4, 1, RingNa>(F.lds, S, qf, o, ls, F.wave, lane);
    attn_store<4>(o[0], ls[0], (bf16*)(F.ws + WS_YCAT) + qrow * 2048 + 1024 + h * 64, fq);
}
template <int QT>
__device__ __forceinline__ void dense64_group(Frame& F, const bf16* Q, int ldq, size_t qrow0, int wq, int qstep, int qcol0, int qcstep, bf16* Y, int ycol0, int ycstep,
                                              const bf16* KA, const bf16* VA, int nA, const bf16* KB_, const bf16* VB_, int nB, int ldk, int vts) {
    const int lane = F.lane, fr = lane & 15, fq = lane >> 4;
    RingSeg<2, 4, false> S; S.nA = nA; S.nt = nA + nB; S.ldk = ldk; S.vts = vts; S.lanes(fr, fq);
    S.kA = KA; S.kB = KB_; S.rA = nullptr; S.rB = nullptr; S.vA = VA; S.vB = VB_;
    const size_t qr = qrow0 + (size_t)wq * F.wave;
    bf16x8 qf[QT][2];
#pragma unroll
    for (int qt = 0; qt < QT; ++qt) { const bf16* qp = Q + (qr + (size_t)qstep * qt + fr) * ldq + qcol0 + qcstep * qt + 8 * fq; qf[qt][0] = ld16(qp); qf[qt][1] = ld16(qp + 32); }
    f32x4 o[QT][4]; float ls[QT];
    if constexpr (QT >= 4) attn_ring_np<2, 4, QT, RingSeg<2, 4, false>>(F.lds, S, qf, o, ls, F.wave, lane);
    else attn_ring<2, 4, QT, RingSeg<2, 4, false>>(F.lds, S, qf, o, ls, F.wave, lane);
#pragma unroll
    for (int qt = 0; qt < QT; ++qt) attn_store<4>(o[qt], ls[qt], Y + (qr + (size_t)qstep * qt + fr) * 2048 + ycol0 + ycstep * qt, fq);
}
__device__ __forceinline__ void mla_group(Frame& F, int j, int h, size_t qrow0, size_t krowA, int nA, size_t krowB, int nB) {
    const int lane = F.lane, fr = lane & 15, fq = lane >> 4;
    const bf16* KN = (const bf16*)(F.ws + WS_KN); const bf16* KR = (const bf16*)(F.ws + WS_KRALL) + (size_t)j * MKV * 64; const bf16* VDT = (const bf16*)(F.ws + WS_VDT);
    RingSeg<6, 8, true> S; S.nA = nA; S.nt = nA + nB; S.ldk = 1024; S.vts = 1024 * 256; S.lanes(fr, fq);
    S.kA = KN + krowA * 1024 + h * 128; S.kB = KN + krowB * 1024 + h * 128;
    S.rA = KR + krowA * 64; S.rB = KR + krowB * 64;
    S.vA = VDT + ((size_t)(krowA >> 8) * 1024 + h * 128) * 256; S.vB = VDT + ((size_t)(krowB >> 8) * 1024 + h * 128) * 256;
    const size_t qr = qrow0 + 16 * F.wave;
    bf16x8 qf[1][6];
    { const bf16* qp = (const bf16*)(F.ws + WS_QD) + (qr + fr) * 1536 + h * 192 + 8 * fq;
#pragma unroll
      for (int ks = 0; ks < 6; ++ks) qf[0][ks] = ld16(qp + 32 * ks); }
    f32x4 o[1][8]; float ls[1];
    attn_ring<6, 8, 1, RingSeg<6, 8, true>>(F.lds, S, qf, o, ls, F.wave, lane);
    attn_store<8>(o[0], ls[0], (bf16*)(F.ws + WS_YCAT) + (qr + fr) * 2048 + 1024 + h * 128, fq);
}

__device__ __forceinline__ void cd_ctx_convert(Frame& F, int j) {
    LAS float* scr = (LAS float*)(F.lds + F.wave * SCR_PER_WAVE);
    const int gw = (int)blockIdx.x * NWAVES + F.wave, NGW = F.G * NWAVES, lane = F.lane; unsigned char* ws = F.ws;
    for (int it = gw; it < 8 * 32; it += NGW) { const int b = it >> 5, q = it & 31, kb = q >> 2, nb = q & 3, k0 = 64 * kb, n0 = 64 * nb, mat = b * 2 + j;
        tr_item(F.a->in[7] + (size_t)mat * 512 * 256 + (size_t)k0 * 256 + n0, 256, (bf16*)(ws + WS_VTCG) + ((size_t)(mat * 2 + (k0 >> 8)) * 256 + n0) * 256 + (k0 & 255), 256, scr, lane); }
    const int gt = gw * 64 + lane, ngt = NGW * 64;
    for (int i = gt; i < 8 * 512 * 256 / 4; i += ngt) { const int e = i * 4, b = e / (512 * 256), rem = e % (512 * 256); const size_t o = (size_t)(b * 2 + j) * 512 * 256 + rem;
        const f32x4 v = *(const f32x4*)(F.a->in[6] + o); u32x2 w; w.x = pkbf(v.x, v.y); w.y = pkbf(v.z, v.w); *(u32x2*)((bf16*)(ws + WS_KCG) + o) = w; }
    for (int i = gt; i < 8 * 512 * 512 / 4; i += ngt) { const int e = i * 4, b = e / (512 * 512), rem = e % (512 * 512);
        const f32x4 v = *(const f32x4*)(F.a->in[8] + (size_t)(b * 2 + j) * 512 * 512 + rem); u32x2 w; w.x = pkbf(v.x, v.y); w.y = pkbf(v.z, v.w);
        *(u32x2*)((bf16*)(ws + WS_CKVALL) + ((size_t)j * MKV + MT + b * 512) * 512 + rem) = w; }
    for (int i = gt; i < 8 * 512 * 64 / 4; i += ngt) { const int e = i * 4, b = e / (512 * 64), rem = e % (512 * 64);
        const f32x4 v = *(const f32x4*)(F.a->in[9] + (size_t)(b * 2 + j) * 512 * 64 + rem); u32x2 w; w.x = pkbf(v.x, v.y); w.y = pkbf(v.z, v.w);
        *(u32x2*)((bf16*)(ws + WS_KRALL) + ((size_t)j * MKV + MT + b * 512) * 64 + rem) = w; }
}
__device__ __forceinline__ void cd_post_row(Frame& F, int j, int m) {
    const int lane = F.lane, l16 = lane & 15, hg = lane >> 4;
    const bool smp = m >= MP; const int t = smp ? ((m - MP) & 1023) : (m & 255), b = smp ? ((m - MP) >> 10) : (m >> 8);
    const bf16* raw = (const bf16*)(F.ws + WS_RAW) + (size_t)m * 2816; const float* rope = (const float*)(F.ws + WS_ROPE);
    const int d0 = 4 * l16;
    const int pos = d0 >= 32 ? (t & 63) : (t >> 6); const bool isx2 = (d0 & 31) >= 16; const int fi = d0 & 15;
    const f32x4 rc = *(const f32x4*)(rope + pos * 16 + fi), rs = *(const f32x4*)(rope + 1024 + pos * 16 + fi);
#pragma unroll
    for (int g = 0; g < 5; ++g) { const int col = (g < 4 ? (4 * g + hg) * 64 : 1024 + hg * 64) + d0;
        const u32x2 rw = *(const u32x2*)(raw + col); f32x4 v = (f32x4){bflo(rw.x), bfhi(rw.x), bflo(rw.y), bfhi(rw.y)};
        float ss = (v.x * v.x + v.y * v.y) + (v.z * v.z + v.w * v.w); ss += __shfl_xor(ss, 1); ss += __shfl_xor(ss, 2); ss += __shfl_xor(ss, 4); ss += __shfl_xor(ss, 8);
        const float rstd = 1.0f / sqrtf(ss * (1.0f / 64.0f) + EPS);
        const f32x4 gn = *(const f32x4*)((g < 4 ? F.a->in[28] : F.a->in[29]) + j * 64 + d0);
        v = v * rstd * gn;
        if (g == 4 && !smp) *(f32x4*)(F.out + O_GK + ((size_t)(b * 2 + j) * 256 + t) * 256 + hg * 64 + d0) = v;
        f32x4 pr; pr.x = __shfl_xor(v.x, 4); pr.y = __shfl_xor(v.y, 4); pr.z = __shfl_xor(v.z, 4); pr.w = __shfl_xor(v.w, 4);
        if (smp) v = isx2 ? v * rc + pr * rs : v * rc - pr * rs;
        if (g < 4) { v = v * QS64; u32x2 w; w.x = pkbf(v.x, v.y); w.y = pkbf(v.z, v.w); *(u32x2*)((bf16*)(F.ws + WS_QG) + (size_t)m * 1024 + (4 * g + hg) * 64 + d0) = w; }
        else { u32x2 w; w.x = pkbf(v.x, v.y); w.y = pkbf(v.z, v.w); *(u32x2*)((bf16*)(F.ws + WS_KG) + (size_t)m * 256 + hg * 64 + d0) = w; } }
    { const u32x2 rw = *(const u32x2*)(raw + 1280 + 4 * lane); const f32x4 v = (f32x4){bflo(rw.x), bfhi(rw.x), bflo(rw.y), bfhi(rw.y)};
      if (!smp) *(f32x4*)(F.out + O_GV + ((size_t)(b * 2 + j) * 256 + t) * 256 + 4 * lane) = v;
      bf16* p = (bf16*)(F.ws + WS_VGT) + ((size_t)(m >> 8) * 256 + 4 * lane) * 256 + (m & 255);
      p[0] = (bf16)(rw.x & 0xffffu); p[256] = (bf16)(rw.x >> 16); p[512] = (bf16)(rw.y & 0xffffu); p[768] = (bf16)(rw.y >> 16); }
#pragma unroll
    for (int which = 0; which < 2; ++which) { const u32x4 rw = *(const u32x4*)(raw + (which ? 2048 : 1536) + 8 * lane);
        float v[8] = {bflo(rw.x), bfhi(rw.x), bflo(rw.y), bfhi(rw.y), bflo(rw.z), bfhi(rw.z), bflo(rw.w), bfhi(rw.w)};
        float ss = 0.f;
#pragma unroll
        for (int e = 0; e < 8; ++e) ss += v[e] * v[e];
        const float rstd = 1.0f / sqrtf(wave_sum(ss) * (1.0f / 512.0f) + EPS);
        const float* gp = (which ? F.a->in[31] : F.a->in[30]) + j * 512 + 8 * lane; const f32x4 g0 = *(const f32x4*)gp, g1 = *(const f32x4*)(gp + 4);
        v[0] *= rstd * g0.x; v[1] *= rstd * g0.y; v[2] *= rstd * g0.z; v[3] *= rstd * g0.w; v[4] *= rstd * g1.x; v[5] *= rstd * g1.y; v[6] *= rstd * g1.z; v[7] *= rstd * g1.w;
        u32x4 w; w.x = pkbf(v[0], v[1]); w.y = pkbf(v[2], v[3]); w.z = pkbf(v[4], v[5]); w.w = pkbf(v[6], v[7]);
        if (which == 0) *(u32x4*)((bf16*)(F.ws + WS_QA) + (size_t)m * 512 + 8 * lane) = w;
        else { *(u32x4*)((bf16*)(F.ws + WS_CKVALL) + ((size_t)j * MKV + m) * 512 + 8 * lane) = w;
            if (!smp) { float* o = F.out + O_CKV + ((size_t)(b * 2 + j) * 256 + t) * 512 + 8 * lane; *(f32x4*)o = (f32x4){v[0], v[1], v[2], v[3]}; *(f32x4*)(o + 4) = (f32x4){v[4], v[5], v[6], v[7]}; } } }
    { const u32x2 rw = *(const u32x2*)(raw + 2560 + d0); f32x4 v = (f32x4){bflo(rw.x), bfhi(rw.x), bflo(rw.y), bfhi(rw.y)};
      if (!smp && lane < 16) *(f32x4*)(F.out + O_KR + ((size_t)(b * 2 + j) * 256 + t) * 64 + d0) = v;
      f32x4 pr; pr.x = __shfl_xor(v.x, 4); pr.y = __shfl_xor(v.y, 4); pr.z = __shfl_xor(v.z, 4); pr.w = __shfl_xor(v.w, 4);
      if (smp) v = isx2 ? v * rc + pr * rs : v * rc - pr * rs;
      if (lane < 16) { u32x2 w; w.x = pkbf(v.x, v.y); w.y = pkbf(v.z, v.w); *(u32x2*)((bf16*)(F.ws + WS_KRALL) + ((size_t)j * MKV + m) * 64 + d0) = w; } }
}

__global__ void __launch_bounds__(NWAVES * 64, 2) trunk_fwd(Args args) {
    extern __shared__ __attribute__((aligned(16))) unsigned char lds[];
    Frame F;
    F.lds = (LAS unsigned char*)lds; F.MISC = (volatile LAS unsigned*)(F.lds + MISC_OFF);
    F.tid = threadIdx.x; F.lane = F.tid & 63; F.wave = __builtin_amdgcn_readfirstlane(F.tid >> 6);
    F.G = gridDim.x; { const int bx = blockIdx.x; F.vcu = (F.G % 8 == 0) ? (bx % 8) * (F.G / 8) + bx / 8 : bx; }
    F.a = &args; F.out = args.out; F.ws = args.ws; F.ctl = (unsigned*)(args.ws + WS_CTL);
#define REFRESH() do { unsigned t_ = threadIdx.x; asm volatile("" : "+v"(t_)); F.tid = (int)t_; F.lane = (int)(t_ & 63u); F.wave = __builtin_amdgcn_readfirstlane((int)(t_ >> 6)); \
        unsigned long long w_ = (unsigned long long)args.ws, o_ = (unsigned long long)args.out; asm volatile("" : "+s"(w_), "+s"(o_)); \
        F.ws = (unsigned char*)(__attribute__((address_space(1))) unsigned char*)w_; F.out = (float*)(__attribute__((address_space(1))) float*)o_; ws = F.ws;        \
        gwb = (int)blockIdx.x * NWAVES + F.wave; } while (0)
    for (int u = F.tid; u < (LDS_BYTES - MISC_OFF) / 4; u += NWAVES * 64) ((LAS unsigned*)(F.lds + MISC_OFF))[u] = 0u;
    __syncthreads();
#if !MK_PER_PHASE
    XcdBarrier bar = xcd_barrier_post(F.ctl + CW_BAR, F.MISC + 8);
    if (F.tid == 0) { const unsigned x = xb_xcc_id(); F.MISC[16] = xb_add(F.ctl + CW_RANK + 64 * (x & 7u), 1u); F.MISC[17] = x; }
#endif
    int cvirt = (int)blockIdx.x, vcu2 = F.vcu;
    const int lo = args.ph_lo, hi = args.ph_hi; int ph = 0;
    int gwb = blockIdx.x * NWAVES + F.wave; const int NGW = F.G * NWAVES;
    unsigned char* ws = F.ws;
#define IN() (ph >= lo && ph < hi)
#if MK_PER_PHASE
#define SEAM() do { ++ph; } while (0)
#else
#define SEAM() do { if (ph >= lo && ph + 1 < hi) xcd_barrier(bar); ++ph; } while (0)
#endif
    if (EN_P0 && IN()) for (int rp = 0; rp < REPS(0); ++rp) { REFRESH(); p0_prologue(F); __syncthreads(); }
    SEAM();
#if !MK_PER_PHASE
    if (lo == 0) {
        if (F.tid == 0) { bool ok = (F.G % 8) == 0; for (unsigned jx = 0; jx < 16; ++jx) { const unsigned c_ = xb_ld(F.ctl + CW_BAR + XB_XCNT(jx)); ok = ok && (c_ == (jx < 8 ? (unsigned)F.G / 8u : 0u)); } F.MISC[18] = ok ? 1u : 0u; }
        __syncthreads();
        if (F.MISC[18]) { const int rk = __builtin_amdgcn_readfirstlane((int)F.MISC[16]), xx = __builtin_amdgcn_readfirstlane((int)F.MISC[17]); cvirt = rk * 8 + xx; vcu2 = xx * (F.G / 8) + rk; }
    }
#endif
#pragma unroll 1
    for (int it = 0; it < 12; ++it) {
        const int L = it / 3, sub = it - 3 * L, j = L >> 1; const bool even = (L & 1) == 0;
#define MODL ((const float*)(ws + WS_MOD) + (size_t)L * 9 * NMODC)
        if (EN_ADALN && IN()) for (int rp = 0; rp < REPS(1); ++rp) { REFRESH(); adaln_phase(F, F.a->in[14] + (size_t)(L * 3 + sub) * D, MODL, 3 * sub, 3 * sub + 1); }
        SEAM();
        if (sub != 1) {
            if (EN_G1 && IN()) for (int rp = 0; rp < REPS(2); ++rp) { REFRESH(); const int f = sub >> 1;
                pg8::Gemm g{(const bf16*)(ws + WS_H), (const bf16*)(ws + WS_W1) + (size_t)(L * 2 + f) * 11264 * 2048, MT, 11264, 2048}; pg8::HalfOrder S; S.init(MT, 11264, F.G, cvirt); S.wgm = 6;
                EpiSwiGLU E{(bf16*)(ws + WS_ACT)};
                pg8::gemm_phase<EpiSwiGLU, pg8::HalfOrder, true, true>(F.lds, g, S, E); }
            SEAM();
        } else if (even) {
            if (EN_GAB && IN()) for (int rp = 0; rp < REPS(3); ++rp) { REFRESH(); pg8::Gemm g{(const bf16*)(ws + WS_H), (const bf16*)(ws + WS_WABI) + (size_t)j * 5120 * 2048, MT, 5120, 2048}; pg8::StaticOrder S; S.init(MT, 5120, F.G, cvirt);
                EpiAB E{(bf16*)(ws + WS_XAGA), (bf16*)(ws + WS_QB), (bf16*)(ws + WS_KB), (bf16*)(ws + WS_VT), F.out + O_NAK, F.out + O_NAV, j};
                pg8::gemm_phase<EpiAB, pg8::StaticOrder, true, true>(F.lds, g, S, E); }
            SEAM();
            if (EN_L1 && IN()) for (int rp = 0; rp < REPS(4); ++rp) { REFRESH(); LAS float* scr = (LAS float*)(F.lds + F.wave * SCR_PER_WAVE);
                for (int item = gwb; item < 192 * 16; item += NGW) lru_l1_item(F, j, item, scr); }
            SEAM();
            if (IN()) for (int rp = 0; rp < REPS(5); ++rp) { REFRESH();
                if (EN_NA) for (int grp = vcu2; grp < 8 * 16 * 4 * 2; grp += F.G) na_group(F, j, grp);
                if (EN_DP) for (int grp = vcu2; grp < 16 * 16; grp += F.G) { const int h = grp & 15, b = grp >> 4;
                    const bf16* K = (const bf16*)(ws + WS_KB) + (size_t)b * 256 * 1024 + h * 64; const bf16* V = (const bf16*)(ws + WS_VT) + ((size_t)b * 1024 + h * 64) * 256;
                    dense64_group<2>(F, (const bf16*)(ws + WS_QB), 1024, (size_t)b * 256, 32, 16, h * 64, 0, (bf16*)(ws + WS_YCAT), 1024 + h * 64, 0, K, V, 8, K, V, 0, 1024, 1024 * 256); }
                asm volatile("s_waitcnt vmcnt(0) lgkmcnt(0)" ::: "memory"); __syncthreads();
                if (EN_L3) for (int item = gwb; item < 192 * 32; item += NGW) lru_l3_item(F, j, item);
            }
            SEAM();
        } else {
            if (EN_GCD && IN()) for (int rp = 0; rp < REPS(6); ++rp) { REFRESH(); pg8::Gemm g{(const bf16*)(ws + WS_H), (const bf16*)(ws + WS_WCDI) + (size_t)j * 2816 * 2048, MT, 2816, 2048}; pg8::HalfOrder S; S.init(MT, 2816, F.G, cvirt);
                EpiPlain E{(bf16*)(ws + WS_RAW), 2816};
                pg8::gemm_phase<EpiPlain, pg8::HalfOrder, true, true>(F.lds, g, S, E); }
            SEAM();
            if (EN_POST && IN()) for (int rp = 0; rp < REPS(7); ++rp) { REFRESH(); cd_ctx_convert(F, j);
                for (int blk = (int)blockIdx.x; blk < MT / 64; blk += F.G) for (int i = 0; i < 8; ++i) cd_post_row(F, j, blk * 64 + F.wave * 8 + i); }
            SEAM();
            if (IN()) for (int rp = 0; rp < REPS(8); ++rp) { REFRESH();
                if (EN_GQD) { pg8::Gemm g{(const bf16*)(ws + WS_QA), (const bf16*)(ws + WS_WUQ) + (size_t)j * 1536 * 512, MT, 1536, 512}; pg8::HalfOrder S; S.init(MT, 1536, F.G, cvirt);
                  EpiQD E{(bf16*)(ws + WS_QD), (const float*)(ws + WS_ROPE)};
                  pg8::gemm_phase<EpiQD, pg8::HalfOrder, true, true>(F.lds, g, S, E); }
                if (EN_GKNV) { pg8::Gemm g{(const bf16*)(ws + WS_CKVALL) + (size_t)j * MKV * 512, (const bf16*)(ws + WS_WUKV) + (size_t)j * 2048 * 512, MKV, 2048, 512}; pg8::StaticOrder S; S.init(MKV, 2048, F.G, (int)(F.G - 1 - cvirt));
                  EpiKNV E{(bf16*)(ws + WS_KN), (bf16*)(ws + WS_VDT)};
                  pg8::gemm_phase<EpiKNV, pg8::StaticOrder, true, true>(F.lds, g, S, E); }
            }
            SEAM();
            if (IN()) for (int rp = 0; rp < REPS(9); ++rp) { REFRESH();
                const bf16* QG = (const bf16*)(ws + WS_QG); const bf16* KG = (const bf16*)(ws + WS_KG); const bf16* VGT = (const bf16*)(ws + WS_VGT); bf16* Y = (bf16*)(ws + WS_YCAT);
                if (EN_GQA) for (int grp = vcu2; grp < 8 * 4 * 8; grp += F.G) { const int tg = grp & 7, kvh = (grp >> 3) & 3, b = grp >> 5; const size_t srow = (size_t)MP + b * 1024;
                    dense64_group<4>(F, QG, 1024, srow + 128 * tg, 16, 0, kvh * 256, 64, Y, kvh * 256, 64,
                                     KG + srow * 256 + kvh * 64, VGT + ((srow >> 8) * 256 + kvh * 64) * 256, 32,
                                     (const bf16*)(ws + WS_KCG) + (size_t)(b * 2 + j) * 512 * 256 + kvh * 64, (const bf16*)(ws + WS_VTCG) + ((size_t)((b * 2 + j) * 2) * 256 + kvh * 64) * 256, 16, 256, 256 * 256); }
                if (EN_MLA) for (int grp = vcu2; grp < 8 * 8 * 8; grp += F.G) { const int qg = grp & 7, h = (grp >> 3) & 7, b = grp >> 6; const size_t srow = (size_t)MP + b * 1024;
                    mla_group(F, j, h, srow + 128 * qg, srow, 32, (size_t)MT + b * 512, 16); }
                if (EN_GQA) for (int grp = vcu2; grp < 16 * 4 * 2 * 2; grp += F.G) { const int hp = grp & 1, tg = (grp >> 1) & 1, kvh = (grp >> 2) & 3, b = grp >> 4; const size_t prow = (size_t)b * 256;
                    const bf16* K = KG + prow * 256 + kvh * 64; const bf16* V = VGT + ((size_t)b * 256 + kvh * 64) * 256;
                    dense64_group<2>(F, QG, 1024, prow + 128 * tg, 16, 0, kvh * 256 + hp * 128, 64, Y, kvh * 256 + hp * 128, 64, K, V, 8, K, V, 0, 256, 256 * 256); }
                if (EN_MLA) for (int grp = vcu2; grp < 16 * 8 * 2; grp += F.G) { const int qg = grp & 1, h = (grp >> 1) & 7, b = grp >> 4; const size_t prow = (size_t)b * 256;
                    mla_group(F, j, h, prow + 128 * qg, prow, 8, prow, 0); }
                asm volatile("s_waitcnt vmcnt(0) lgkmcnt(0)" ::: "memory"); __syncthreads();
            }
            SEAM();
        }
        if (EN_RES && IN() && (EN_MIXRES || sub != 1)) { REFRESH(); const bool ffn = sub != 1; const int f = sub >> 1;
            const bf16* A = ffn ? (const bf16*)(ws + WS_ACT) : (const bf16*)(ws + WS_YCAT);
            const bf16* Bt = ffn ? (const bf16*)(ws + WS_W2) + (size_t)(L * 2 + f) * 2048 * 5632 : (even ? (const bf16*)(ws + WS_WABO) : (const bf16*)(ws + WS_WCDO)) + (size_t)j * 2048 * 2048;
            pg8::Gemm g{A, Bt, MT, 2048, ffn ? DFF : 2048};
#if RES_TM == 192
            pg8::StaticOrder S; S.init_tm(MT, 2048, F.G, cvirt, 192);
            EpiResid192 E{(bf16*)(ws + WS_X), MODL + (3 * sub + 2) * 2048, ffn ? 0.5f : 1.0f};
            pg8::gemm_phase<EpiResid192, pg8::StaticOrder, true, true, 192>(F.lds, g, S, E); }
#else
            pg8::HalfOrder S; S.init(MT, 2048, F.G, cvirt);
            EpiResid E{(bf16*)(ws + WS_X), MODL + (3 * sub + 2) * 2048, ffn ? 0.5f : 1.0f};
            pg8::gemm_phase<EpiResid, pg8::HalfOrder, true, true>(F.lds, g, S, E); }
#endif
        SEAM();
    }
    if (EN_FINAL && IN()) for (int rp = 0; rp < REPS(10); ++rp) { REFRESH(); final_phase(F); }
#undef IN
#undef SEAM
}

extern "C" void kernel_launch(void* const* d_in, const int* in_sizes, int n_in, void* d_out, int out_size, void* d_ws, size_t ws_size, hipStream_t stream) {
    static int grid = 0;
    if (grid == 0) {
        if (n_in != 37 || (size_t)out_size != O_END || ws_size < WS_END) { fprintf(stderr, "kernel_launch: unexpected problem shape (n_in %d, out %d, ws %zu); nothing launched\n", n_in, out_size, ws_size); grid = -1; return; }
        int dev = 0, cus = 0;
        if (hipGetDevice(&dev) != hipSuccess || hipDeviceGetAttribute(&cus, hipDeviceAttributeMultiprocessorCount, dev) != hipSuccess) { grid = -1; return; }
        if (hipFuncSetAttribute((const void*)trunk_fwd, hipFuncAttributeMaxDynamicSharedMemorySize, LDS_BYTES) != hipSuccess) { fprintf(stderr, "kernel_launch: hipFuncSetAttribute failed\n"); grid = -1; return; }
        int per_cu = 0;
        if (hipOccupancyMaxActiveBlocksPerMultiprocessor(&per_cu, (const void*)trunk_fwd, NWAVES * 64, LDS_BYTES) != hipSuccess || per_cu < 1) { fprintf(stderr, "kernel_launch: occupancy query says %d blocks per CU\n", per_cu); }
        (void)hipGetLastError();
        grid = cus;
    }
    if (grid < 0) return;
    (void)hipMemsetAsync((char*)d_ws + WS_CTL, 0, CTL_ZERO_BYTES, stream);
    Args a{};
    for (int i = 0; i < 37; ++i) a.in[i] = (const float*)d_in[i];
    a.out = (float*)d_out; a.ws = (unsigned char*)d_ws;
#if MK_PER_PHASE
    for (int p = 0; p < N_PHASES; ++p) { a.ph_lo = p; a.ph_hi = p + 1; hipLaunchKernelGGL(trunk_fwd, dim3(grid), dim3(NWAVES * 64), LDS_BYTES, stream, a); }
#else
    a.ph_lo = 0; a.ph_hi = N_PHASES;
    hipLaunchKernelGGL(trunk_fwd, dim3(grid), dim3(NWAVES * 64), LDS_BYTES, stream, a);
#endif
}
```

```cpp
#include <hip/hip_runtime.h>
#include <cstdio>
#include <cstdint>
namespace pg8 {
#define PG8_LAS __attribute__((address_space(3)))
typedef unsigned short bf16_t;
typedef short bf16x8 __attribute__((ext_vector_type(8)));
typedef float f32x4 __attribute__((ext_vector_type(4)));
typedef unsigned u32x4 __attribute__((ext_vector_type(4)));
constexpr int BM = 256, BK = 64, HALF = 128, HTB = HALF * BK * 2  , STAGE_BYTES = 8 * HTB, NXCD = 8, WGM = 4;

__host__ __device__ __forceinline__ int lds_byte(int r, int c) { const int st = (r >> 4) * 2 + (c >> 5), rr = r & 15, cc = c & 31, ob = rr * 64 + cc * 2; return st * 1024 + (ob ^ (((ob >> 9) & 1) << 5)); }
__host__ __device__ __forceinline__ void stage_rc(int b, int& R, int& C) { const int st = b / 1024, sb = b % 1024, swz = sb ^ (((sb >> 9) & 1) << 5); R = (st >> 1) * 16 + swz / 64; C = (st & 1) * 32 + (swz % 64) / 2; }
__host__ __device__ __forceinline__ int perm32(int rho) { const int n = rho >> 4, i = rho & 15; return 8 * (i >> 2) + 4 * n + (i & 3); }

struct Unit { int pm, pn, mh; };
struct Gemm { const bf16_t* A; const bf16_t* Bt; int M, N, K; };

struct StaticOrder {
    int nM, nN, nwg, G, c, wgm;
    __host__ __device__ void init(int M, int N, int G_, int c_) { nM = M / BM; nN = N / BM; nwg = nM * nN; G = G_; c = c_; wgm = WGM; }
    __host__ __device__ void init_tm(int M, int N, int G_, int c_, int tm) { nM = M / tm; nN = N / BM; nwg = nM * nN; G = G_; c = c_; wgm = WGM; }
    __host__ __device__ bool next(int i, Unit& u) const {
        const long L = (long)i * G + c; if (L >= nwg) return false;
        int wgid = (int)L; { const int q = nwg / NXCD, r = nwg % NXCD, xcd = wgid % NXCD, off = wgid / NXCD; wgid = (xcd < r ? xcd * (q + 1) : r * (q + 1) + (xcd - r) * q) + off; }
        const int nig = wgm * nN, gid = wgid / nig, fm = gid * wgm, gsz = (nM - fm) < wgm ? (nM - fm) : wgm;
        u.pm = fm + ((wgid % nig) % gsz); u.pn = (wgid % nig) / gsz; u.mh = -1; return true;
    }
    __device__ __forceinline__ void a_ready(const Unit&) const {}
    __device__ __forceinline__ void done(const Unit&) const {}
};
struct HalfOrder : StaticOrder {
    __host__ __device__ bool next(int i, Unit& u) const {
        const int R = nwg / G, rem = nwg % G;
        if (i < R) { StaticOrder t = *this; return t.StaticOrder::next(i, u); }
        if (i > R || rem == 0) return false;
        if (2 * rem > G) { StaticOrder t = *this; return t.StaticOrder::next(R, u); }
        if (c >= 2 * rem) return false;
        StaticOrder t = *this; t.c = c >> 1;
        if (!t.StaticOrder::next(R, u)) return false;
        u.mh = c & 1; return true;
    }
};
__device__ __forceinline__ unsigned cvt_pk_bf16(float lo, float hi) { unsigned r; asm volatile("v_cvt_pk_bf16_f32 %0, %1, %2" : "=v"(r) : "v"(lo), "v"(hi)); return r; }
typedef float f32x2 __attribute__((ext_vector_type(2)));
template <class Epi, class Sched, bool ALIGN_EPI = false, bool SP2 = false, int TM = 256>
__device__ __forceinline__ void gemm_phase(PG8_LAS unsigned char* lds, const Gemm g, const Sched& S, const Epi& E) {
    static_assert(SP2, "half-M units are implemented in the SP2 loop only");
    static_assert(TM == 256 || TM == 192, "row tile");
    constexpr int HI_PIECES = TM == 256 ? 2 : 1, HI_M = TM == 256 ? 4 : 2;
    int tid_l = threadIdx.x; asm volatile("" : "+v"(tid_l));
    const int tid = tid_l, wid = __builtin_amdgcn_readfirstlane(tid >> 6), lane = tid & 63, wr = wid >> 2, wc = wid & 3, fr = lane & 15, fq = lane >> 4;
    const int K = g.K, nt = K / BK;
    unsigned voffA[2], voffB[2];
#pragma unroll
    for (int i = 0; i < 2; ++i) { int R, C; stage_rc(tid * 16 + i * 8192, R, C); const int Rb = Epi::PERM ? ((R & ~31) + perm32(R & 31)) : R;
        voffA[i] = (unsigned)(R * K + C) * 2u; voffB[i] = (unsigned)(Rb * K + C) * 2u; }
    const size_t kstep = (size_t)(BK * 2);
    const size_t hstep = (size_t)HALF * K * 2;
    const size_t tstep = 2 * hstep;
    const size_t tstepA = TM == 256 ? tstep : (size_t)192 * K * 2;
    const unsigned ldsw = (unsigned)wid * 1024u;
    const int aoff = lds_byte(wr * 64 + fr, fq * 8), boff = lds_byte(wc * 32 + fr, fq * 8), aoff_hi = TM == 256 ? aoff : lds_byte(wr * 32 + fr, fq * 8);
#define PG8_SA(b, h) (((b) * 2 + (h)) * HTB)
#define PG8_SB(b, h) ((4 + (b) * 2 + (h)) * HTB)
#define PG8_STAGE(bufoff, gbase, voff) do { _Pragma("unroll") for (int _i = 0; _i < 2; ++_i) \
        __builtin_amdgcn_global_load_lds((const unsigned*)((const char*)(gbase) + (voff)[_i]), (PG8_LAS unsigned*)(lds + (bufoff) + ldsw + _i * 8192), 16, 0, 0); } while (0)
#define PG8_STAGE_HI(bufoff, gbase, voff) do { _Pragma("unroll") for (int _i = 0; _i < HI_PIECES; ++_i) \
        __builtin_amdgcn_global_load_lds((const unsigned*)((const char*)(gbase) + (voff)[_i]), (PG8_LAS unsigned*)(lds + (bufoff) + ldsw + _i * 8192), 16, 0, 0); } while (0)
#define PG8_LDA_HI(dst, b) do { _Pragma("unroll") for (int m = 0; m < HI_M; ++m) _Pragma("unroll") for (int k = 0; k < 2; ++k) dst[m][k] = *(const PG8_LAS bf16x8*)(lds + PG8_SA(b, 1) + aoff_hi + m * 2048 + k * 1024); } while (0)
#define PG8_MMA_HI(bj, At, Bt) do { __builtin_amdgcn_s_setprio(1); _Pragma("unroll") for (int m = 0; m < HI_M; ++m) _Pragma("unroll") for (int n = 0; n < 2; ++n) _Pragma("unroll") for (int k = 0; k < 2; ++k) \
        acc[1][bj][m][n] = __builtin_amdgcn_mfma_f32_16x16x32_bf16(Bt[n][k], At[m][k], acc[1][bj][m][n], 0, 0, 0); __builtin_amdgcn_s_setprio(0); } while (0)
#define PG8_WAIT_LOOP do { if constexpr (TM == 256) asm volatile("s_waitcnt vmcnt(8)" ::: "memory"); else asm volatile("s_waitcnt vmcnt(7)" ::: "memory"); } while (0)
#define PG8_LDA(dst, b, h) do { _Pragma("unroll") for (int m = 0; m < 4; ++m) _Pragma("unroll") for (int k = 0; k < 2; ++k) dst[m][k] = *(const PG8_LAS bf16x8*)(lds + PG8_SA(b, h) + aoff + m * 2048 + k * 1024); } while (0)
#define PG8_LDB(dst, b, h) do { _Pragma("unroll") for (int n = 0; n < 2; ++n) _Pragma("unroll") for (int k = 0; k < 2; ++k) dst[n][k] = *(const PG8_LAS bf16x8*)(lds + PG8_SB(b, h) + boff + n * 2048 + k * 1024); } while (0)
#define PG8_MMA(ai, bj, At, Bt) do { __builtin_amdgcn_s_setprio(1); _Pragma("unroll") for (int m = 0; m < 4; ++m) _Pragma("unroll") for (int n = 0; n < 2; ++n) _Pragma("unroll") for (int k = 0; k < 2; ++k) \
        acc[ai][bj][m][n] = __builtin_amdgcn_mfma_f32_16x16x32_bf16(Bt[n][k], At[m][k], acc[ai][bj][m][n], 0, 0, 0); __builtin_amdgcn_s_setprio(0); } while (0)
#define PG8_WAIT_V(n) asm volatile("s_waitcnt vmcnt(" #n ")" ::: "memory")
#define PG8_WAIT_L(n) asm volatile("s_waitcnt lgkmcnt(" #n ")" ::: "memory")
#define PG8_BAR __builtin_amdgcn_s_barrier()
#define PG8_SCHED __builtin_amdgcn_sched_barrier(0)
    Unit cur, nxt; int ui = 0;
    if (!S.next(0, cur)) return;
    f32x4 acc[2][2][4][2];
#pragma unroll
    for (int a = 0; a < 2; ++a)
#pragma unroll
        for (int b = 0; b < 2; ++b)
#pragma unroll
            for (int m = 0; m < 4; ++m)
#pragma unroll
                for (int n = 0; n < 2; ++n) acc[a][b][m][n] = (f32x4){0.f, 0.f, 0.f, 0.f};
    bf16x8 At[4][2], B0[2][2], B1[2][2];
    bool c_half = cur.mh >= 0; size_t c_ahi = c_half ? 0 : hstep;
    const char* cA = (const char*)g.A + (size_t)cur.pm * tstepA + (cur.mh > 0 ? hstep : 0); const char* cB = (const char*)g.Bt + (size_t)cur.pn * tstep;
    S.a_ready(cur);
    if constexpr (SP2) {
        PG8_STAGE(PG8_SB(0, 0), cB, voffB); PG8_STAGE(PG8_SB(0, 1), cB + hstep, voffB); PG8_STAGE(PG8_SA(0, 0), cA, voffA); PG8_STAGE_HI(PG8_SA(0, 1), cA + c_ahi, voffA);
        if (wr == 1) PG8_BAR;
        if constexpr (TM == 256) PG8_WAIT_V(2); else PG8_WAIT_V(1);
        PG8_BAR;
        PG8_STAGE(PG8_SB(1, 0), cB + kstep, voffB); PG8_STAGE(PG8_SA(1, 0), cA + kstep, voffA); PG8_STAGE(PG8_SB(1, 1), cB + hstep + kstep, voffB);
        PG8_WAIT_V(6); PG8_BAR;
    } else {
        PG8_STAGE(PG8_SB(0, 0), cB, voffB); PG8_STAGE(PG8_SA(0, 0), cA, voffA); PG8_STAGE(PG8_SB(0, 1), cB + hstep, voffB); PG8_STAGE(PG8_SA(0, 1), cA + hstep, voffA);
        if (wr == 1) PG8_BAR;
        PG8_WAIT_V(4); PG8_BAR;
        PG8_STAGE(PG8_SB(1, 0), cB + kstep, voffB); PG8_STAGE(PG8_SA(1, 0), cA + kstep, voffA); PG8_STAGE(PG8_SB(1, 1), cB + hstep + kstep, voffB);
        PG8_WAIT_V(6); PG8_BAR;
    }
    for (;;) {
        const bool has_next = S.next(ui + 1, nxt);
        const char* nA = has_next ? (const char*)g.A + (size_t)nxt.pm * tstepA + (nxt.mh > 0 ? hstep : 0) : cA; const char* nB = has_next ? (const char*)g.Bt + (size_t)nxt.pn * tstep : cB;
        const bool n_half = has_next ? (nxt.mh >= 0) : c_half; const size_t n_ahi = n_half ? 0 : hstep;
        for (int t = 0; t < nt; t += 2) {
            const bool last = (t == nt - 2);
            const char* a1 = cA + (size_t)(t + 1) * kstep;
            const char* a2 = last ? nA : cA + (size_t)(t + 2) * kstep; const char* b2 = last ? nB : cB + (size_t)(t + 2) * kstep;
            const char* a3 = a2 + kstep; const char* b3 = b2 + kstep;
            if (last && has_next) S.a_ready(nxt);
            if constexpr (SP2) {
            PG8_LDA(At, 0, 0); PG8_LDB(B0, 0, 0); PG8_LDB(B1, 0, 1); PG8_STAGE_HI(PG8_SA(1, 1), a1 + c_ahi, voffA);
            PG8_WAIT_LOOP; PG8_WAIT_L(0); PG8_BAR; PG8_MMA(0, 0, At, B0); PG8_MMA(0, 1, At, B1); PG8_BAR; PG8_SCHED;
            if (!c_half) PG8_LDA_HI(At, 0); PG8_STAGE(PG8_SB(0, 0), b2, voffB); PG8_STAGE(PG8_SB(0, 1), b2 + hstep, voffB); PG8_STAGE(PG8_SA(0, 0), a2, voffA);
            PG8_WAIT_LOOP; PG8_WAIT_L(0); PG8_BAR; if (!c_half) { PG8_MMA_HI(0, At, B0); PG8_MMA_HI(1, At, B1); } PG8_BAR; PG8_SCHED;
            PG8_LDA(At, 1, 0); PG8_LDB(B0, 1, 0); PG8_LDB(B1, 1, 1); PG8_STAGE_HI(PG8_SA(0, 1), a2 + (last ? n_ahi : c_ahi), voffA);
            PG8_WAIT_LOOP; PG8_WAIT_L(0); PG8_BAR; PG8_MMA(0, 0, At, B0); PG8_MMA(0, 1, At, B1); PG8_BAR; PG8_SCHED;
            if (!c_half) PG8_LDA_HI(At, 1); PG8_STAGE(PG8_SB(1, 0), b3, voffB); PG8_STAGE(PG8_SB(1, 1), b3 + hstep, voffB); PG8_STAGE(PG8_SA(1, 0), a3, voffA);
            PG8_WAIT_LOOP; PG8_WAIT_L(0); PG8_BAR; if (!c_half) { PG8_MMA_HI(0, At, B0); PG8_MMA_HI(1, At, B1); } PG8_BAR; PG8_SCHED;
            } else {
            PG8_LDB(B0, 0, 0); PG8_SCHED; PG8_LDA(At, 0, 0); PG8_STAGE(PG8_SA(1, 1), a1 + hstep, voffA);
            PG8_WAIT_L(8); PG8_BAR; PG8_WAIT_L(0); PG8_MMA(0, 0, At, B0); PG8_BAR; PG8_SCHED;
            PG8_LDB(B1, 0, 1); PG8_STAGE(PG8_SB(0, 0), b2, voffB);
            PG8_BAR; PG8_WAIT_L(0); PG8_MMA(0, 1, At, B1); PG8_BAR;
            PG8_LDA(At, 0, 1); PG8_STAGE(PG8_SA(0, 0), a2, voffA);
            PG8_BAR; PG8_WAIT_L(0); PG8_MMA(1, 0, At, B0); PG8_BAR; PG8_SCHED;
            PG8_STAGE(PG8_SB(0, 1), b2 + hstep, voffB);
            PG8_WAIT_V(6); PG8_BAR; PG8_MMA(1, 1, At, B1); PG8_BAR;
            PG8_LDB(B0, 1, 0); PG8_SCHED; PG8_LDA(At, 1, 0); PG8_STAGE(PG8_SA(0, 1), a2 + hstep, voffA);
            PG8_WAIT_L(8); PG8_BAR; PG8_WAIT_L(0); PG8_MMA(0, 0, At, B0); PG8_BAR; PG8_SCHED;
            PG8_LDB(B1, 1, 1); PG8_STAGE(PG8_SB(1, 0), b3, voffB);
            PG8_BAR; PG8_WAIT_L(0); PG8_MMA(0, 1, At, B1); PG8_BAR;
            PG8_LDA(At, 1, 1); PG8_STAGE(PG8_SA(1, 0), a3, voffA);
            PG8_BAR; PG8_WAIT_L(0); PG8_MMA(1, 0, At, B0); PG8_BAR; PG8_SCHED;
            PG8_STAGE(PG8_SB(1, 1), b3 + hstep, voffB);
            PG8_WAIT_V(6); PG8_BAR; PG8_MMA(1, 1, At, B1); PG8_BAR;
            }
        }
        if constexpr (ALIGN_EPI) { if (wr == 0) PG8_BAR; }
        if constexpr (!Epi::AFTER_DRAIN) { E(acc, cur, wr, wc, fr, fq); S.done(cur); }
        if (!has_next) break;
#pragma unroll
        for (int a = 0; a < 2; ++a)
#pragma unroll
            for (int b = 0; b < 2; ++b)
#pragma unroll
                for (int m = 0; m < 4; ++m)
#pragma unroll
                    for (int n = 0; n < 2; ++n) acc[a][b][m][n] = (f32x4){0.f, 0.f, 0.f, 0.f};
        cur = nxt; cA = nA; cB = nB; c_half = n_half; c_ahi = n_ahi; ++ui;
        if constexpr (ALIGN_EPI) { if (wr == 1) PG8_BAR; }
    }
    PG8_WAIT_V(0);
    if constexpr (!ALIGN_EPI) { if (wr == 0) PG8_BAR; }
    PG8_BAR;
    if constexpr (Epi::AFTER_DRAIN) { E.fused(acc, cur, wr, wc, fr, fq, lds, wid, lane); S.done(cur); }
#undef PG8_SA
#undef PG8_SB
#undef PG8_STAGE
#undef PG8_LDA
#undef PG8_STAGE_HI
#undef PG8_LDA_HI
#undef PG8_MMA_HI
#undef PG8_WAIT_LOOP
#undef PG8_LDB
#undef PG8_MMA
#undef PG8_WAIT_V
#undef PG8_WAIT_L
#undef PG8_BAR
#undef PG8_SCHED
}
}

#define GAS __attribute__((address_space(1)))
#define LAS __attribute__((address_space(3)))
typedef unsigned short bf16;
typedef short bf16x8 __attribute__((ext_vector_type(8)));
typedef float f32x4 __attribute__((ext_vector_type(4)));
typedef unsigned u32x4 __attribute__((ext_vector_type(4)));
typedef unsigned u32x2 __attribute__((ext_vector_type(2)));
#define LDS_WAIT() asm volatile("s_waitcnt lgkmcnt(0)" ::: "memory")
#define VM_WAIT() asm volatile("s_waitcnt vmcnt(0)" ::: "memory")

#ifndef EN_P0
#define EN_P0 1
#endif
#ifndef EN_ADALN
#define EN_ADALN 1
#endif
#ifndef EN_G1
#define EN_G1 1
#endif
#ifndef EN_GAB
#define EN_GAB 1
#endif
#ifndef EN_L1
#define EN_L1 1
#endif
#ifndef EN_NA
#define EN_NA 1
#endif
#ifndef EN_DP
#define EN_DP 1
#endif
#ifndef EN_L3
#define EN_L3 1
#endif
#ifndef EN_GCD
#define EN_GCD 1
#endif
#ifndef EN_POST
#define EN_POST 1
#endif
#ifndef EN_GQD
#define EN_GQD 1
#endif
#ifndef EN_GKNV
#define EN_GKNV 1
#endif
#ifndef EN_GQA
#define EN_GQA 1
#endif
#ifndef EN_MLA
#define EN_MLA 1
#endif
#ifndef EN_RES
#define EN_RES 1
#endif
#ifndef EN_MIXRES
#define EN_MIXRES 1
#endif
#ifndef EN_FINAL
#define EN_FINAL 1
#endif
#ifndef DUP_MASK
#define DUP_MASK 0
#endif
#define REPS(k) (((DUP_MASK >> (k)) & 1) + 1)
#ifndef ATT_DEFER
#define ATT_DEFER 6.0f
#endif
#ifndef RES_TM
#define RES_TM 192
#endif
#ifndef MK_PER_PHASE
#define MK_PER_PHASE 0
#endif

constexpr int D = 2048, DFF = 5632, MP = 4096, MS = 8192, MT = 12288, MKV = 16384;
constexpr int NMODC = 9 * 2048;
constexpr float EPS = 1e-6f;
constexpr float LOG2E = 1.4426950408889634f;
constexpr float QS64 = 0.125f * LOG2E;
constexpr float QS192 = 0.07216878364870322f * LOG2E;
constexpr int NWAVES = 8;
constexpr int N_PHASES = 48;

constexpr size_t O_YP = 0, O_YS = O_YP + (size_t)MP * D, O_SF = O_YS + (size_t)MS * D, O_SB = O_SF + 16 * 2 * 1024, O_NAK = O_SB + 16 * 2 * 1024,
                 O_NAV = O_NAK + (size_t)16 * 2 * 256 * 1024, O_GK = O_NAV + (size_t)16 * 2 * 256 * 1024, O_GV = O_GK + (size_t)16 * 2 * 256 * 256,
                 O_CKV = O_GV + (size_t)16 * 2 * 256 * 256, O_KR = O_CKV + (size_t)16 * 2 * 256 * 512, O_END = O_KR + (size_t)16 * 2 * 256 * 64;

constexpr size_t MiB = 1u << 20;
constexpr size_t WS_CTL = 0, WS_MOD = 1 * MiB, CTL_ZERO_BYTES = 64 * 1024;
constexpr size_t WS_ROPE = 4 * MiB;
constexpr size_t WS_LRUW = 5 * MiB;
constexpr size_t WS_W1 = 8 * MiB;
constexpr size_t WS_W2 = WS_W1 + 352 * MiB;
constexpr size_t WS_WABI = WS_W2 + 176 * MiB;
constexpr size_t WS_WABO = WS_WABI + 40 * MiB;
constexpr size_t WS_WCDI = WS_WABO + 16 * MiB;
constexpr size_t WS_WCDO = WS_WCDI + 22 * MiB;
constexpr size_t WS_WUQ = WS_WCDO + 16 * MiB;
constexpr size_t WS_WUKV = WS_WUQ + 3 * MiB;
constexpr size_t WS_KCNA = WS_WUKV + 4 * MiB;
constexpr size_t WS_VTCNA = WS_KCNA + 16 * MiB;
constexpr size_t WS_KCG = WS_VTCNA + 16 * MiB;
constexpr size_t WS_VTCG = WS_KCG + 4 * MiB;
constexpr size_t WS_CKVALL = WS_VTCG + 4 * MiB;
constexpr size_t WS_KRALL = WS_CKVALL + 32 * MiB;
constexpr size_t WS_X = WS_KRALL + 4 * MiB;
constexpr size_t WS_H = WS_X + 96 * MiB;
constexpr size_t WS_ACT = WS_H + 48 * MiB;
constexpr size_t WS_YCAT = WS_ACT + 132 * MiB;
constexpr size_t WS_XAGA = WS_YCAT + 48 * MiB;
constexpr size_t WS_QB = WS_XAGA + 48 * MiB;
constexpr size_t WS_KB = WS_QB + 24 * MiB;
constexpr size_t WS_VT = WS_KB + 24 * MiB;
constexpr size_t WS_LRU = WS_VT + 24 * MiB;
constexpr size_t WS_AGG = WS_LRU + 96 * MiB;
constexpr size_t WS_RAW = WS_AGG + 4 * MiB;
constexpr size_t WS_QG = WS_RAW + 66 * MiB;
constexpr size_t WS_KG = WS_QG + 24 * MiB;
constexpr size_t WS_VGT = WS_KG + 6 * MiB;
constexpr size_t WS_QA = WS_VGT + 6 * MiB;
constexpr size_t WS_QD = WS_QA + 12 * MiB;
constexpr size_t WS_KN = WS_QD + 36 * MiB;
constexpr size_t WS_VDT = WS_KN + 32 * MiB;
constexpr size_t WS_END = WS_VDT + 32 * MiB;
constexpr int CW_RANK = 9216;
constexpr int CW_BAR = 4096;

constexpr int RING_BYTES = 131072;
constexpr int SCR_PER_WAVE = 16640;
constexpr int MISC_OFF = 135168;
constexpr int LDS_BYTES = 147456;
static_assert(NWAVES * SCR_PER_WAVE <= MISC_OFF && MISC_OFF + 256 <= LDS_BYTES, "LDS map");

typedef float f32x2_t __attribute__((ext_vector_type(2))); typedef __bf16 bf16x2_t __attribute__((ext_vector_type(2)));
__device__ __forceinline__ unsigned pkbf(float lo, float hi) { f32x2_t v = {lo, hi}; bf16x2_t b = __builtin_convertvector(v, bf16x2_t); return __builtin_bit_cast(unsigned, b); }
__device__ __forceinline__ float bflo(unsigned w) { return __uint_as_float(w << 16); }
__device__ __forceinline__ float bfhi(unsigned w) { return __uint_as_float(w & 0xffff0000u); }
__device__ __forceinline__ float fexp2(float x) { return __builtin_amdgcn_exp2f(x); }
__device__ __forceinline__ float frcp(float x) { return __builtin_amdgcn_rcpf(x); }
__device__ __forceinline__ float sigmoidf_(float x) { return frcp(1.0f + fexp2(-x * LOG2E)); }
__device__ __forceinline__ float wave_sum(float v) {
#pragma unroll
    for (int o = 1; o < 64; o <<= 1) v += __shfl_xor(v, o);
    return v;
}
__device__ __forceinline__ int cond_of_row(int m) { return m < MP ? 0 : 1 + ((m - MP) >> 10); }
__device__ __forceinline__ bf16x8 ld16(const bf16* p) { return *(const bf16x8*)p; }

#define XB_TMO      128
#define XB_XCNT(j)  (256  + 64 * (j))
#define XB_XSUB(j)  (1280 + 64 * (j))
#define XB_XGEN(j)  (2304 + 64 * (j))
#define XB_TOP      3328
#define XB_TOPGEN   3392
#define XCD_BAR_WORDS 3456
#define XB_SPIN_CAP (1u << 18)

__device__ __forceinline__ unsigned xb_ld(unsigned* p)              { return __hip_atomic_load(p, __ATOMIC_RELAXED, __HIP_MEMORY_SCOPE_AGENT); }
__device__ __forceinline__ unsigned xb_add(unsigned* p, unsigned v) { return __hip_atomic_fetch_add(p, v, __ATOMIC_RELAXED, __HIP_MEMORY_SCOPE_AGENT); }
__device__ __forceinline__ unsigned xb_xcc_id() { return (unsigned)__builtin_amdgcn_s_getreg((3 << 11) | 20) & 0xFu; }
#define XB_SPIN(cond, bar) do { unsigned _sp = 0; while (cond) { __builtin_amdgcn_s_sleep(1); \
    if ((++_sp & 255u) == 0u) { if (xb_ld(&(bar)[XB_TMO])) break; if (_sp > XB_SPIN_CAP) { atomicAdd(&(bar)[XB_TMO], 1u); break; } } } } while (0)

struct XcdBarrier {
    unsigned* bar; unsigned x;
    volatile LAS unsigned* st;
};

__device__ __forceinline__ XcdBarrier xcd_barrier_post(unsigned* bar, volatile LAS unsigned* st) {
    XcdBarrier b; b.bar = bar; b.x = xb_xcc_id(); b.st = st;
    if (threadIdx.x == 0) (void)xb_add(&bar[XB_XCNT(b.x)], 1u);
    return b;
}
__device__ __forceinline__ void xcd_barrier_complete(unsigned* bar, unsigned x, unsigned& nloc, unsigned& nx) {
    const unsigned G = gridDim.x * gridDim.y * gridDim.z;
    unsigned sum, cnt, mine, sp = 0u;
    for (;;) {
        sum = 0u; cnt = 0u; mine = 0u;
#pragma unroll
        for (unsigned j = 0; j < 16; ++j) { const unsigned c = xb_ld(&bar[XB_XCNT(j)]); sum += c; cnt += (c > 0u) ? 1u : 0u; mine = (j == x) ? c : mine; }
        if (sum == G) break;
        __builtin_amdgcn_s_sleep(1);
        if ((++sp & 255u) == 0u) { if (xb_ld(&bar[XB_TMO])) break; if (sp > XB_SPIN_CAP) { atomicAdd(&bar[XB_TMO], 1u); break; } }
    }
    nloc = mine > 0u ? mine : 1u; nx = cnt > 0u ? cnt : 1u;
}

__device__ __forceinline__ void xcd_barrier(const XcdBarrier& b) {
    asm volatile("s_waitcnt vmcnt(0)" ::: "memory");
    __syncthreads();
    if (threadIdx.x == 0) {
        unsigned* bar = b.bar;
        __builtin_amdgcn_s_waitcnt(0);
        unsigned nloc = b.st[0], nx = b.st[1];
        if (nloc == 0u) { xcd_barrier_complete(bar, b.x, nloc, nx); b.st[0] = nloc; b.st[1] = nx; }
        const unsigned old = xb_add(&bar[XB_XSUB(b.x)], 1u);
        const unsigned gen = old / nloc;
        if (old + 1u == (gen + 1u) * nloc) {
            __builtin_amdgcn_fence(__ATOMIC_RELEASE, "agent");
            asm volatile("s_waitcnt vmcnt(0)" ::: "memory");
            const unsigned og = xb_add(&bar[XB_TOP], 1u);
            const unsigned tg = og / nx;
            if (og + 1u == (tg + 1u) * nx) xb_add(&bar[XB_TOPGEN], 1u);
            else XB_SPIN(xb_ld(&bar[XB_TOPGEN]) == tg, bar);
            __builtin_amdgcn_fence(__ATOMIC_ACQUIRE, "agent");
            xb_add(&bar[XB_XGEN(b.x)], 1u);
            asm volatile("s_waitcnt vmcnt(0)" ::: "memory");
        } else {
            XB_SPIN(xb_ld(&bar[XB_XGEN(b.x)]) == gen, bar);
            __builtin_amdgcn_fence(__ATOMIC_ACQUIRE, "agent");
            asm volatile("s_waitcnt vmcnt(0)" ::: "memory");
        }
    }
    __syncthreads();
}

struct Args { const float* in[37]; float* out; unsigned char* ws; int ph_lo, ph_hi; };
struct Frame {
    LAS unsigned char* lds; volatile LAS unsigned* MISC; unsigned* ctl;
    int tid, lane, wave, vcu, G;
    float* out; unsigned char* ws; const Args* a;
};

__device__ __forceinline__ void tr_item(const float* src, size_t ldsrc, bf16* dst, size_t ldd, LAS float* scr, int lane) {
    float tv[64];
#pragma unroll
    for (int i = 0; i < 64; ++i) tv[i] = __builtin_nontemporal_load(src + (size_t)i * ldsrc + lane);
#pragma unroll
    for (int i = 0; i < 64; ++i) scr[i * 65 + lane] = tv[i];
    LDS_WAIT();
    const int c = lane & 7;
#pragma unroll
    for (int jn = 0; jn < 8; ++jn) { const int n = (lane >> 3) + 8 * jn; const LAS float* s = scr + (8 * c) * 65 + n;
        u32x4 o; o.x = pkbf(s[0 * 65], s[1 * 65]); o.y = pkbf(s[2 * 65], s[3 * 65]); o.z = pkbf(s[4 * 65], s[5 * 65]); o.w = pkbf(s[6 * 65], s[7 * 65]);
        __builtin_nontemporal_store(o, (u32x4*)(dst + (size_t)n * ldd + 8 * c)); }
    LDS_WAIT();
}
__device__ __forceinline__ void cvt_copy(const float* src, bf16* dst, size_t n4, int gt, int ngt) {
    for (size_t i = gt; i < n4; i += ngt) { const f32x4 v = ((const f32x4*)src)[i]; u32x2 o; o.x = pkbf(v.x, v.y); o.y = pkbf(v.z, v.w); ((u32x2*)dst)[i] = o; }
}

__device__ __forceinline__ void p0_prologue(Frame& F) {
    LAS float* scr = (LAS float*)(F.lds + F.wave * SCR_PER_WAVE);
    const int gw = F.vcu * NWAVES + F.wave, NGW = F.G * NWAVES, lane = F.lane;
    unsigned char* ws = F.ws;
    constexpr int I_W1 = 8 * 32 * 176, I_W2 = 8 * 88 * 32, I_ABI = 2 * 32 * 80, I_ABO = 2 * 32 * 32, I_CDI = 2 * 32 * 41, I_CDO = 2 * 32 * 32, I_UQ = 2 * 8 * 24, I_UK = 2 * 8 * 16, I_UV = I_UK,
                  I_LRU = 128, I_VNA = 16 * 8 * 16;
    constexpr int NITEMS = I_W1 + I_W2 + I_ABI + I_ABO + I_CDI + I_CDO + I_UQ + I_UK + I_UV + I_LRU + I_VNA;
    for (int it = gw; it < NITEMS; it += NGW) {
        int r = it;
        if (r < I_W1) { const int mat = r / (32 * 176), q = r % (32 * 176), kb = q / 176, nb = q % 176; const int k0 = 64 * kb, n0 = 64 * nb;
            const int drow = n0 < DFF ? 256 * (n0 >> 7) + (n0 & 127) : 256 * ((n0 - DFF) >> 7) + 128 + ((n0 - DFF) & 127);
            tr_item(F.a->in[15] + (size_t)mat * 2048 * 11264 + (size_t)k0 * 11264 + n0, 11264, (bf16*)(ws + WS_W1) + (size_t)mat * 11264 * 2048 + (size_t)drow * 2048 + k0, 2048, scr, lane); continue; } r -= I_W1;
        if (r < I_W2) { const int mat = r / (88 * 32), q = r % (88 * 32), kb = q / 32, nb = q % 32; const int k0 = 64 * kb, n0 = 64 * nb;
            tr_item(F.a->in[16] + (size_t)mat * 5632 * 2048 + (size_t)k0 * 2048 + n0, 2048, (bf16*)(ws + WS_W2) + (size_t)mat * 2048 * 5632 + (size_t)n0 * 5632 + k0, 5632, scr, lane); continue; } r -= I_W2;
        if (r < I_ABI) { const int mat = r / (32 * 80), q = r % (32 * 80), kb = q / 80, nb = q % 80; const int k0 = 64 * kb, n0 = 64 * nb;
            tr_item(F.a->in[17] + (size_t)mat * 2048 * 5120 + (size_t)k0 * 5120 + n0, 5120, (bf16*)(ws + WS_WABI) + (size_t)mat * 5120 * 2048 + (size_t)n0 * 2048 + k0, 2048, scr, lane); continue; } r -= I_ABI;
        if (r < I_ABO) { const int mat = r / 1024, q = r % 1024, kb = q / 32, nb = q % 32; const int k0 = 64 * kb, n0 = 64 * nb;
            tr_item(F.a->in[26] + (size_t)mat * 2048 * 2048 + (size_t)k0 * 2048 + n0, 2048, (bf16*)(ws + WS_WABO) + (size_t)mat * 2048 * 2048 + (size_t)n0 * 2048 + k0, 2048, scr, lane); continue; } r -= I_ABO;
        if (r < I_CDI) { const int mat = r / (32 * 41), q = r % (32 * 41), kb = q / 41, nb = q % 41; const int k0 = 64 * kb, n0 = 64 * nb;
            tr_item(F.a->in[27] + (size_t)mat * 2048 * 2624 + (size_t)k0 * 2624 + n0, 2624, (bf16*)(ws + WS_WCDI) + (size_t)mat * 2816 * 2048 + (size_t)n0 * 2048 + k0, 2048, scr, lane); continue; } r -= I_CDI;
        if (r < I_CDO) { const int mat = r / 1024, q = r % 1024, kb = q / 32, nb = q % 32; const int k0 = 64 * kb, n0 = 64 * nb;
            tr_item(F.a->in[35] + (size_t)mat * 2048 * 2048 + (size_t)k0 * 2048 + n0, 2048, (bf16*)(ws + WS_WCDO) + (size_t)mat * 2048 * 2048 + (size_t)n0 * 2048 + k0, 2048, scr, lane); continue; } r -= I_CDO;
        if (r < I_UQ) { const int mat = r / (8 * 24), q = r % (8 * 24), kb = q / 24, nb = q % 24; const int k0 = 64 * kb, n0 = 64 * nb;
            tr_item(F.a->in[32] + (size_t)mat * 512 * 1536 + (size_t)k0 * 1536 + n0, 1536, (bf16*)(ws + WS_WUQ) + (size_t)mat * 1536 * 512 + (size_t)n0 * 512 + k0, 512, scr, lane); continue; } r -= I_UQ;
        if (r < I_UK) { const int mat = r / 128, q = r % 128, kb = q / 16, nb = q % 16; const int k0 = 64 * kb, n0 = 64 * nb;
            tr_item(F.a->in[33] + (size_t)mat * 512 * 1024 + (size_t)k0 * 1024 + n0, 1024, (bf16*)(ws + WS_WUKV) + (size_t)mat * 2048 * 512 + (size_t)n0 * 512 + k0, 512, scr, lane); continue; } r -= I_UK;
        if (r < I_UV) { const int mat = r / 128, q = r % 128, kb = q / 16, nb = q % 16; const int k0 = 64 * kb, n0 = 64 * nb;
            tr_item(F.a->in[34] + (size_t)mat * 512 * 1024 + (size_t)k0 * 1024 + n0, 1024, (bf16*)(ws + WS_WUKV) + (size_t)mat * 2048 * 512 + (size_t)(1024 + n0) * 512 + k0, 512, scr, lane); continue; } r -= I_UV;
        if (r < I_LRU) { const int ax = r & 1, blk = r >> 1;
            tr_item((ax ? F.a->in[22] : F.a->in[20]) + (size_t)blk * 4096, 64, (bf16*)(ws + WS_LRUW) + ((size_t)((blk >> 4) * 2 + ax) * 16 + (blk & 15)) * 4096, 64, scr, lane); continue; } r -= I_LRU;
        { const int mat = r / 128, q = r % 128, kb = q / 16, nb = q % 16; const int k0 = 64 * kb, n0 = 64 * nb;
            tr_item(F.a->in[5] + (size_t)mat * 512 * 1024 + (size_t)k0 * 1024 + n0, 1024, (bf16*)(ws + WS_VTCNA) + ((size_t)(mat * 2 + (k0 >> 8)) * 1024 + n0) * 256 + (k0 & 255), 256, scr, lane); }
    }
    const int gt = gw * 64 + lane, ngt = NGW * 64;
    { u32x2* X = (u32x2*)(ws + WS_X); const size_t np4 = (size_t)MP * D / 4, nt4 = (size_t)MT * D / 4;
      for (size_t i = gt; i < nt4; i += ngt) { const f32x4 v = i < np4 ? ((const f32x4*)F.a->in[0])[i] : ((const f32x4*)F.a->in[1])[i - np4]; u32x2 w; w.x = pkbf(v.x, v.y); w.y = pkbf(v.z, v.w); X[i] = w; } }
    cvt_copy(F.a->in[4], (bf16*)(ws + WS_KCNA), (size_t)8 * 2 * 512 * 1024 / 4, gt, ngt);
    for (size_t i = gt; i < (size_t)2 * 192 * 2048 / 8; i += ngt) { const size_t e = i * 8, mat = e / (192 * 2048), rem = e % (192 * 2048);
        *(u32x4*)((bf16*)(ws + WS_WCDI) + (mat * 2816 + 2624) * 2048 + rem) = (u32x4){0u, 0u, 0u, 0u}; }
    if (gt < 1024) { const int pos = gt >> 4, i = gt & 15; const float inv = exp2f(-(float)i * (13.287712379549449f / 16.0f)); const float ang = (float)pos * inv;
        ((float*)(ws + WS_ROPE))[gt] = cosf(ang); ((float*)(ws + WS_ROPE))[1024 + gt] = sinf(ang); }
    __syncthreads();
    LAS float* red = (LAS float*)F.lds;
    typedef float f32x2v __attribute__((ext_vector_type(2)));
    for (int u = F.vcu; u < 4 * 144; u += F.G) {
        const int L = u / 144, cc = u % 144;
        f32x2v acc[9];
#pragma unroll
        for (int c = 0; c < 9; ++c) acc[c] = (f32x2v){0.f, 0.f};
#pragma unroll 1
        for (int kq = 0; kq < 4; ++kq) {
            const int kbase = kq * 512 + F.wave * 64;
            float s[9];
#pragma unroll
            for (int c = 0; c < 9; ++c) { const float v = c == 0 ? F.a->in[11][kbase + lane] : F.a->in[10][(c - 1) * 2048 + kbase + lane]; s[c] = v * sigmoidf_(v); }
            const f32x2v* wp = (const f32x2v*)(F.a->in[12] + ((size_t)L * 2048 + kbase) * NMODC + cc * 128) + lane;
#pragma unroll 32
            for (int i = 0; i < 64; ++i) { const f32x2v w = __builtin_nontemporal_load(wp + (size_t)i * (NMODC / 2));
#pragma unroll
                for (int c = 0; c < 9; ++c) { const float sc = __builtin_bit_cast(float, __builtin_amdgcn_readlane(__builtin_bit_cast(int, s[c]), i)); acc[c] += w * sc; } }
        }
#pragma unroll
        for (int c = 0; c < 9; ++c) *(LAS f32x2v*)(red + (F.wave * 9 + c) * 128 + 2 * lane) = acc[c];
        __syncthreads();
        for (int o = F.tid; o < 9 * 128; o += NWAVES * 64) { float v = 0.f;
#pragma unroll
            for (int w = 0; w < 8; ++w) v += red[w * 9 * 128 + o];
            const int c = o >> 7, col = cc * 128 + (o & 127);
            ((float*)(ws + WS_MOD))[((size_t)L * 9 + c) * NMODC + col] = v + F.a->in[13][(size_t)L * NMODC + col]; }
        __syncthreads();
    }
}

__device__ __forceinline__ void unpk8(const u32x4& w, f32x4& a, f32x4& b) {
    a.x = bflo(w.x); a.y = bfhi(w.x); a.z = bflo(w.y); a.w = bfhi(w.y); b.x = bflo(w.z); b.y = bfhi(w.z); b.z = bflo(w.w); b.w = bfhi(w.w); }
__device__ __forceinline__ void adaln_phase(Frame& F, const float* gain, const float* modL, int jsh, int jsc) {
    const int gw = F.vcu * NWAVES + F.wave, NGW = F.G * NWAVES, lane = F.lane;
    const int per = (MT + NGW - 1) / NGW, r0 = gw * per, r1 = (r0 + per) < MT ? (r0 + per) : MT;
    const bf16* X = (const bf16*)(F.ws + WS_X); bf16* H = (bf16*)(F.ws + WS_H);
    int cur = -1; f32x4 gs[4][2], sh[4][2];
    for (int mb = r0; mb < r1; mb += 3) {
        u32x4 w[3][4];
#pragma unroll
        for (int i = 0; i < 3; ++i) { const int m = (mb + i) < r1 ? (mb + i) : (r1 - 1); const u32x4* xr = (const u32x4*)(X + (size_t)m * D) + lane;
#pragma unroll
            for (int j = 0; j < 4; ++j) w[i][j] = xr[64 * j]; }
#pragma unroll
        for (int i = 0; i < 3; ++i) { const int m = mb + i; if (m < r1) {
            const int cond = cond_of_row(m);
            if (cond != cur) { cur = cond;
#pragma unroll
                for (int j = 0; j < 4; ++j)
#pragma unroll
                    for (int h = 0; h < 2; ++h) { const int col = 8 * lane + 512 * j + 4 * h; const f32x4 g = *(const f32x4*)(gain + col), sc = *(const f32x4*)(modL + (size_t)cond * NMODC + jsc * 2048 + col);
                        gs[j][h] = g * (sc + 1.0f); sh[j][h] = *(const f32x4*)(modL + (size_t)cond * NMODC + jsh * 2048 + col); } }
            f32x4 v[4][2]; float ss = 0.f;
#pragma unroll
            for (int j = 0; j < 4; ++j) { unpk8(w[i][j], v[j][0], v[j][1]);
#pragma unroll
                for (int h = 0; h < 2; ++h) ss += (v[j][h].x * v[j][h].x + v[j][h].y * v[j][h].y) + (v[j][h].z * v[j][h].z + v[j][h].w * v[j][h].w); }
            const float rstd = 1.0f / sqrtf(wave_sum(ss) * (1.0f / D) + EPS);
            u32x4* o = (u32x4*)(H + (size_t)m * D) + lane;
#pragma unroll
            for (int j = 0; j < 4; ++j) { const f32x4 y0 = v[j][0] * rstd * gs[j][0] + sh[j][0], y1 = v[j][1] * rstd * gs[j][1] + sh[j][1];
                u32x4 q; q.x = pkbf(y0.x, y0.y); q.y = pkbf(y0.z, y0.w); q.z = pkbf(y1.x, y1.y); q.w = pkbf(y1.z, y1.w); o[64 * j] = q; } } }
    }
}
__device__ __forceinline__ void final_phase(Frame& F) {
    const int gw = F.vcu * NWAVES + F.wave, NGW = F.G * NWAVES, lane = F.lane;
    const bf16* X = (const bf16*)(F.ws + WS_X); const float* gain = F.a->in[36];
    f32x4 g[4][2];
#pragma unroll
    for (int j = 0; j < 4; ++j)
#pragma unroll
        for (int h = 0; h < 2; ++h) g[j][h] = *(const f32x4*)(gain + 8 * lane + 512 * j + 4 * h);
    for (int m = gw; m < MT; m += NGW) {
        const u32x4* xr = (const u32x4*)(X + (size_t)m * D) + lane; u32x4 w[4]; f32x4 v[4][2]; float ss = 0.f;
#pragma unroll
        for (int j = 0; j < 4; ++j) w[j] = xr[64 * j];
#pragma unroll
        for (int j = 0; j < 4; ++j) { unpk8(w[j], v[j][0], v[j][1]);
#pragma unroll
            for (int h = 0; h < 2; ++h) ss += (v[j][h].x * v[j][h].x + v[j][h].y * v[j][h].y) + (v[j][h].z * v[j][h].z + v[j][h].w * v[j][h].w); }
        const float rstd = 1.0f / sqrtf(wave_sum(ss) * (1.0f / D) + EPS);
        f32x4* o = (f32x4*)(F.out + O_YP + (size_t)m * D) + 2 * lane;
#pragma unroll
        for (int j = 0; j < 4; ++j) { o[128 * j] = v[j][0] * rstd * g[j][0]; o[128 * j + 1] = v[j][1] * rstd * g[j][1]; }
    }
}

typedef pg8::Unit Unit;
struct EpiSwiGLU {
    static constexpr bool PERM = true, AFTER_DRAIN = false;
    bf16* O;
    __device__ __forceinline__ void operator()(const f32x4 (&acc)[2][2][4][2], const Unit& u, int wr, int wc, int fr, int fq) const {
        const int row0 = u.pm * 256 + (u.mh > 0 ? 128 : 0) + wr * 64 + fr, col0 = u.pn * 128 + wc * 32 + 8 * fq; const int nai = u.mh < 0 ? 2 : 1;
#pragma unroll
        for (int ai = 0; ai < 2; ++ai) if (ai < nai)
#pragma unroll
            for (int m = 0; m < 4; ++m) { bf16* rowp = O + (size_t)(row0 + ai * 128 + m * 16) * DFF + col0;
                float r[8];
#pragma unroll
                for (int n = 0; n < 2; ++n)
#pragma unroll
                    for (int i = 0; i < 4; ++i) { const float g = acc[ai][0][m][n][i], uu = acc[ai][1][m][n][i]; r[4 * n + i] = g * sigmoidf_(g) * uu; }
                u32x4 w; w.x = pkbf(r[0], r[1]); w.y = pkbf(r[2], r[3]); w.z = pkbf(r[4], r[5]); w.w = pkbf(r[6], r[7]);
                *(u32x4*)rowp = w; }
    }
};
struct EpiResid {
    static constexpr bool PERM = true, AFTER_DRAIN = false;
    bf16* X; const float* gate; float s;
    __device__ __forceinline__ void operator()(const f32x4 (&acc)[2][2][4][2], const Unit& u, int wr, int wc, int fr, int fq) const {
        const int row0 = u.pm * 256 + (u.mh > 0 ? 128 : 0) + wr * 64 + fr, col0 = u.pn * 256 + wc * 32 + 8 * fq; const int nai = u.mh < 0 ? 2 : 1;
        const float* gp = gate + (size_t)cond_of_row(u.pm * 256) * NMODC + col0;
        f32x4 gv[2][2];
#pragma unroll
        for (int bj = 0; bj < 2; ++bj)
#pragma unroll
            for (int h = 0; h < 2; ++h) gv[bj][h] = *(const f32x4*)(gp + bj * 128 + 4 * h) * s;
#pragma unroll
        for (int ai = 0; ai < 2; ++ai) if (ai < nai) {
            u32x4 w[4][2];
#pragma unroll
            for (int m = 0; m < 4; ++m)
#pragma unroll
                for (int bj = 0; bj < 2; ++bj) w[m][bj] = *(const u32x4*)(X + (size_t)(row0 + ai * 128 + m * 16) * D + col0 + bj * 128);
#pragma unroll
            for (int m = 0; m < 4; ++m)
#pragma unroll
                for (int bj = 0; bj < 2; ++bj) { f32x4 x0, x1; unpk8(w[m][bj], x0, x1);
                    x0 = x0 + gv[bj][0] * acc[ai][bj][m][0]; x1 = x1 + gv[bj][1] * acc[ai][bj][m][1];
                    u32x4 q; q.x = pkbf(x0.x, x0.y); q.y = pkbf(x0.z, x0.w); q.z = pkbf(x1.x, x1.y); q.w = pkbf(x1.z, x1.w);
                    *(u32x4*)(X + (size_t)(row0 + ai * 128 + m * 16) * D + col0 + bj * 128) = q; } }
    }
};
struct EpiResid192 {
    static constexpr bool PERM = true, AFTER_DRAIN = false;
    bf16* X; const float* gate; float s;
    __device__ __forceinline__ void operator()(const f32x4 (&acc)[2][2][4][2], const Unit& u, int wr, int wc, int fr, int fq) const {
        const int col0 = u.pn * 256 + wc * 32 + 8 * fq;
#pragma unroll
        for (int ai = 0; ai < 2; ++ai) {
            const int rbase = u.pm * 192 + (ai ? 128 + wr * 32 : wr * 64), nm = ai ? 2 : 4;
            const float* gp = gate + (size_t)cond_of_row(rbase) * NMODC + col0;
            f32x4 gv[2][2];
#pragma unroll
            for (int bj = 0; bj < 2; ++bj)
#pragma unroll
                for (int h = 0; h < 2; ++h) gv[bj][h] = *(const f32x4*)(gp + bj * 128 + 4 * h) * s;
            u32x4 w[4][2];
#pragma unroll
            for (int m = 0; m < 4; ++m) if (m < nm)
#pragma unroll
                for (int bj = 0; bj < 2; ++bj) w[m][bj] = *(const u32x4*)(X + (size_t)(rbase + fr + m * 16) * D + col0 + bj * 128);
#pragma unroll
            for (int m = 0; m < 4; ++m) if (m < nm)
#pragma unroll
                for (int bj = 0; bj < 2; ++bj) { f32x4 x0, x1; unpk8(w[m][bj], x0, x1);
                    x0 = x0 + gv[bj][0] * acc[ai][bj][m][0]; x1 = x1 + gv[bj][1] * acc[ai][bj][m][1];
                    u32x4 q; q.x = pkbf(x0.x, x0.y); q.y = pkbf(x0.z, x0.w); q.z = pkbf(x1.x, x1.y); q.w = pkbf(x1.z, x1.w);
                    *(u32x4*)(X + (size_t)(rbase + fr + m * 16) * D + col0 + bj * 128) = q; } }
    }
};
struct EpiPlain {
    static constexpr bool PERM = true, AFTER_DRAIN = false;
    bf16* O; int ldc;
    __device__ __forceinline__ void operator()(const f32x4 (&acc)[2][2][4][2], const Unit& u, int wr, int wc, int fr, int fq) const {
        const int row0 = u.pm * 256 + (u.mh > 0 ? 128 : 0) + wr * 64 + fr, col0 = u.pn * 256 + wc * 32 + 8 * fq; const int nai = u.mh < 0 ? 2 : 1;
#pragma unroll
        for (int ai = 0; ai < 2; ++ai) if (ai < nai)
#pragma unroll
            for (int m = 0; m < 4; ++m) { bf16* rowp = O + (size_t)(row0 + ai * 128 + m * 16) * ldc + col0;
#pragma unroll
                for (int bj = 0; bj < 2; ++bj) { const f32x4 v0 = acc[ai][bj][m][0], v1 = acc[ai][bj][m][1];
                    u32x4 w; w.x = pkbf(v0[0], v0[1]); w.y = pkbf(v0[2], v0[3]); w.z = pkbf(v1[0], v1[1]); w.w = pkbf(v1[2], v1[3]);
                    *(u32x4*)(rowp + bj * 128) = w; } }
    }
};
__device__ __forceinline__ void vt_store8(bf16* VT, int C, int pm, int c, int r, const f32x4& v0, const f32x4& v1) {
    bf16* p = VT + ((size_t)pm * C + c) * 256 + r;
    const unsigned w0 = pkbf(v0[0], v0[1]), w1 = pkbf(v0[2], v0[3]), w2 = pkbf(v1[0], v1[1]), w3 = pkbf(v1[2], v1[3]);
    p[0 * 256] = (bf16)(w0 & 0xffffu); p[1 * 256] = (bf16)(w0 >> 16); p[2 * 256] = (bf16)(w1 & 0xffffu); p[3 * 256] = (bf16)(w1 >> 16);
    p[4 * 256] = (bf16)(w2 & 0xffffu); p[5 * 256] = (bf16)(w2 >> 16); p[6 * 256] = (bf16)(w3 & 0xffffu); p[7 * 256] = (bf16)(w3 >> 16);
}
struct EpiAB {
    static constexpr bool PERM = true, AFTER_DRAIN = false;
    bf16 *XAGA, *QB, *KB, *VT; float* ock; float* ocv; int j;
    __device__ __forceinline__ void operator()(const f32x4 (&acc)[2][2][4][2], const Unit& u, int wr, int wc, int fr, int fq) const {
        const int rt0 = wr * 64 + fr, ct0 = wc * 32 + 8 * fq;
        const int pn = u.pn, pm = u.pm;
        if (pn < 16) {
            char* dst; int ldc; float sc = 1.0f;
            if (pn < 8) { dst = (char*)(XAGA + pn * 256); ldc = 2048; } else if (pn < 12) { dst = (char*)(QB + (pn - 8) * 256); ldc = 1024; sc = QS64; } else { dst = (char*)(KB + (pn - 12) * 256); ldc = 1024; }
            dst += (size_t)pm * 256 * ldc * 2;
            const unsigned vo = (unsigned)(rt0 * ldc + ct0) * 2u;
            const bool cache = pn >= 12 && pm < 16;
            char* oc = (char*)(ock + ((size_t)(pm * 2 + j) * 256) * 1024 + (pn - 12) * 256);
            const unsigned vc = (unsigned)(rt0 * 1024 + ct0) * 4u;
#pragma unroll
            for (int ai = 0; ai < 2; ++ai)
#pragma unroll
                for (int m = 0; m < 4; ++m) { const int ro = ai * 128 + m * 16;
#pragma unroll
                    for (int bj = 0; bj < 2; ++bj) { const f32x4 v0 = acc[ai][bj][m][0] * sc, v1 = acc[ai][bj][m][1] * sc;
                        u32x4 w; w.x = pkbf(v0[0], v0[1]); w.y = pkbf(v0[2], v0[3]); w.z = pkbf(v1[0], v1[1]); w.w = pkbf(v1[2], v1[3]);
                        *(u32x4*)(dst + (size_t)(ro * ldc + bj * 128) * 2 + vo) = w;
                        if (cache) { char* o = oc + (size_t)(ro * 1024 + bj * 128) * 4; *(f32x4*)(o + vc) = v0; *(f32x4*)(o + vc + 16) = v1; } }
                    asm volatile("" ::: "memory"); }
        } else {
            const int c0 = (pn - 16) * 256;
            char* vt = (char*)(VT + ((size_t)pm * 1024 + c0) * 256);
            const unsigned vv = (unsigned)(ct0 * 256 + rt0) * 2u;
            char* oc = (char*)(ocv + ((size_t)(pm * 2 + j) * 256) * 1024 + c0);
            const unsigned vc = (unsigned)(rt0 * 1024 + ct0) * 4u;
#pragma unroll
            for (int ai = 0; ai < 2; ++ai)
#pragma unroll
                for (int m = 0; m < 4; ++m) { const int ro = ai * 128 + m * 16;
#pragma unroll
                    for (int bj = 0; bj < 2; ++bj) { const f32x4 v0 = acc[ai][bj][m][0], v1 = acc[ai][bj][m][1];
                        const unsigned w0 = pkbf(v0[0], v0[1]), w1 = pkbf(v0[2], v0[3]), w2 = pkbf(v1[0], v1[1]), w3 = pkbf(v1[2], v1[3]);
                        char* p = vt + (size_t)(bj * 128 * 256 + ro) * 2;
                        *(bf16*)(p + vv + 0 * 512) = (bf16)(w0 & 0xffffu); *(bf16*)(p + vv + 1 * 512) = (bf16)(w0 >> 16); *(bf16*)(p + vv + 2 * 512) = (bf16)(w1 & 0xffffu); *(bf16*)(p + vv + 3 * 512) = (bf16)(w1 >> 16);
                        *(bf16*)(p + vv + 4 * 512) = (bf16)(w2 & 0xffffu); *(bf16*)(p + vv + 5 * 512) = (bf16)(w2 >> 16); *(bf16*)(p + vv + 6 * 512) = (bf16)(w3 & 0xffffu); *(bf16*)(p + vv + 7 * 512) = (bf16)(w3 >> 16);
                        if (pm < 16) { char* o = oc + (size_t)(ro * 1024 + bj * 128) * 4; *(f32x4*)(o + vc) = v0; *(f32x4*)(o + vc + 16) = v1; } }
                    asm volatile("" ::: "memory"); }
        }
    }
};
struct EpiQD {
    static constexpr bool PERM = false, AFTER_DRAIN = false;
    bf16* QD; const float* rope;
    __device__ __forceinline__ void operator()(const f32x4 (&acc)[2][2][4][2], const Unit& u, int wr, int wc, int fr, int fq) const {
        const bool smp = u.pm >= 16; const int nai = u.mh < 0 ? 2 : 1, mho = u.mh > 0 ? 128 : 0;
#pragma unroll
        for (int ai = 0; ai < 2; ++ai) if (ai < nai)
#pragma unroll
            for (int m = 0; m < 4; ++m) { const int row = u.pm * 256 + mho + ai * 128 + wr * 64 + m * 16 + fr; const int t = (row - MP) & 1023;
#pragma unroll
                for (int bj = 0; bj < 2; ++bj) { const int cg = u.pn * 256 + bj * 128 + wc * 32; const int eg = cg % 192;
                    f32x4 x1 = acc[ai][bj][m][0], x2 = acc[ai][bj][m][1];
                    if (smp && eg >= 128) { const int pos = (eg == 160) ? (t & 63) : (t >> 6);
                        const f32x4 cs = *(const f32x4*)(rope + pos * 16 + 4 * fq), sn = *(const f32x4*)(rope + 1024 + pos * 16 + 4 * fq);
                        const f32x4 o1 = x1 * cs - x2 * sn, o2 = x2 * cs + x1 * sn; x1 = o1; x2 = o2; }
                    x1 = x1 * QS192; x2 = x2 * QS192;
                    bf16* p = QD + (size_t)row * 1536 + cg + 4 * fq;
                    u32x2 w1; w1.x = pkbf(x1[0], x1[1]); w1.y = pkbf(x1[2], x1[3]); *(u32x2*)p = w1;
                    u32x2 w2; w2.x = pkbf(x2[0], x2[1]); w2.y = pkbf(x2[2], x2[3]); *(u32x2*)(p + 16) = w2; } }
    }
};
struct EpiKNV {
    static constexpr bool PERM = true, AFTER_DRAIN = false;
    bf16 *KN, *VDT;
    __device__ __forceinline__ void operator()(const f32x4 (&acc)[2][2][4][2], const Unit& u, int wr, int wc, int fr, int fq) const {
        const int rt0 = wr * 64 + fr, ct0 = wc * 32 + 8 * fq;
        if (u.pn < 4) { char* dst = (char*)(KN + (size_t)u.pm * 256 * 1024 + u.pn * 256); const unsigned vo = (unsigned)(rt0 * 1024 + ct0) * 2u;
#pragma unroll
            for (int ai = 0; ai < 2; ++ai)
#pragma unroll
                for (int m = 0; m < 4; ++m) { const int ro = ai * 128 + m * 16;
#pragma unroll
                    for (int bj = 0; bj < 2; ++bj) { const f32x4 v0 = acc[ai][bj][m][0], v1 = acc[ai][bj][m][1];
                        u32x4 w; w.x = pkbf(v0[0], v0[1]); w.y = pkbf(v0[2], v0[3]); w.z = pkbf(v1[0], v1[1]); w.w = pkbf(v1[2], v1[3]);
                        *(u32x4*)(dst + (size_t)(ro * 1024 + bj * 128) * 2 + vo) = w; }
                    asm volatile("" ::: "memory"); }
        } else { char* vt = (char*)(VDT + ((size_t)u.pm * 1024 + (u.pn - 4) * 256) * 256); const unsigned vv = (unsigned)(ct0 * 256 + rt0) * 2u;
#pragma unroll
            for (int ai = 0; ai < 2; ++ai)
#pragma unroll
                for (int m = 0; m < 4; ++m) { const int ro = ai * 128 + m * 16;
#pragma unroll
                    for (int bj = 0; bj < 2; ++bj) { const f32x4 v0 = acc[ai][bj][m][0], v1 = acc[ai][bj][m][1];
                        const unsigned w0 = pkbf(v0[0], v0[1]), w1 = pkbf(v0[2], v0[3]), w2 = pkbf(v1[0], v1[1]), w3 = pkbf(v1[2], v1[3]);
                        char* p = vt + (size_t)(bj * 128 * 256 + ro) * 2;
                        *(bf16*)(p + vv + 0 * 512) = (bf16)(w0 & 0xffffu); *(bf16*)(p + vv + 1 * 512) = (bf16)(w0 >> 16); *(bf16*)(p + vv + 2 * 512) = (bf16)(w1 & 0xffffu); *(bf16*)(p + vv + 3 * 512) = (bf16)(w1 >> 16);
                        *(bf16*)(p + vv + 4 * 512) = (bf16)(w2 & 0xffffu); *(bf16*)(p + vv + 5 * 512) = (bf16)(w2 >> 16); *(bf16*)(p + vv + 6 * 512) = (bf16)(w3 & 0xffffu); *(bf16*)(p + vv + 7 * 512) = (bf16)(w3 >> 16); }
                    asm volatile("" ::: "memory"); }
        }
    }
};

__device__ __forceinline__ void prow16(float x, float& lo, float& hi) { auto s_ = __builtin_amdgcn_permlane16_swap(__float_as_uint(x), __float_as_uint(x), false, false); lo = __uint_as_float(s_[0]); hi = __uint_as_float(s_[1]); }
__device__ __forceinline__ void prow32(float x, float& lo, float& hi) { auto s_ = __builtin_amdgcn_permlane32_swap(__float_as_uint(x), __float_as_uint(x), false, false); lo = __uint_as_float(s_[0]); hi = __uint_as_float(s_[1]); }
__device__ __forceinline__ float rows_up16(float x, int fq) { float a, b, c, d, e, f; prow16(x, a, b); prow32(x, c, d); prow16(c, e, f); return fq == 2 ? f : a; }
__device__ __forceinline__ float rows_up32(float x) { float c, d; prow32(x, c, d); return c; }
__device__ __forceinline__ float rows_last(float x) { float c, d, e, f; prow32(x, c, d); prow16(d, e, f); return f; }
__device__ __forceinline__ float rows_dn16(float x, int fq) { float a, b, c, d, e, f; prow16(x, a, b); prow32(x, c, d); prow16(d, e, f); return fq == 1 ? e : b; }
__device__ __forceinline__ float rows_dn32(float x) { float c, d; prow32(x, c, d); return d; }
__device__ __forceinline__ float rows_first(float x) { float c, d, e, f; prow32(x, c, d); prow16(c, e, f); return e; }
__device__ __forceinline__ void lru_scan_store(const float (&a)[4][4], const float (&u)[4][4], bool rev, int fr, int fq, bf16* Ao, bf16* Ho, float& TAo, float& TUo) {
    float cA = 1.f, cU = 0.f;
#pragma unroll
    for (int mi = 0; mi < 4; ++mi) { const int mt = rev ? 3 - mi : mi;
        float ia[4], iu[4]; float A, U;
        if (!rev) { A = a[mt][0]; U = u[mt][0]; ia[0] = A; iu[0] = U;
#pragma unroll
            for (int r = 1; r < 4; ++r) { U = a[mt][r] * U + u[mt][r]; A *= a[mt][r]; ia[r] = A; iu[r] = U; } }
        else { A = a[mt][3]; U = u[mt][3]; ia[3] = A; iu[3] = U;
#pragma unroll
            for (int r = 2; r >= 0; --r) { U = a[mt][r] * U + u[mt][r]; A *= a[mt][r]; ia[r] = A; iu[r] = U; } }
        float PA = A, PU = U, qa, qu, EA, EU, TA, TU;
        if (!rev) {
            qa = rows_up16(PA, fq); qu = rows_up16(PU, fq); if (fq >= 1) { PU = PA * qu + PU; PA = qa * PA; }
            qa = rows_up32(PA); qu = rows_up32(PU); if (fq >= 2) { PU = PA * qu + PU; PA = qa * PA; }
            EA = rows_up16(PA, fq); EU = rows_up16(PU, fq); if (fq == 0) { EA = 1.f; EU = 0.f; }
            TA = rows_last(PA); TU = rows_last(PU);
        } else {
            qa = rows_dn16(PA, fq); qu = rows_dn16(PU, fq); if (fq <= 2) { PU = PA * qu + PU; PA = qa * PA; }
            qa = rows_dn32(PA); qu = rows_dn32(PU); if (fq <= 1) { PU = PA * qu + PU; PA = qa * PA; }
            EA = rows_dn16(PA, fq); EU = rows_dn16(PU, fq); if (fq == 3) { EA = 1.f; EU = 0.f; }
            TA = rows_first(PA); TU = rows_first(PU);
        }
        const float preA = cA * EA, preU = EA * cU + EU;
#pragma unroll
        for (int r = 0; r < 4; ++r) { const float Ac = preA * ia[r], Hc = ia[r] * preU + iu[r]; const size_t off = (size_t)(16 * mt + 4 * fq + r) * 1024;
            Ao[off] = (bf16)(pkbf(Ac, 0.f) & 0xffffu); Ho[off] = (bf16)(pkbf(Hc, 0.f) & 0xffffu); }
        cU = TA * cU + TU; cA = cA * TA;
    }
    TAo = cA; TUo = cU;
}
__device__ __forceinline__ void lru_l1_item(Frame& F, int j, int item, LAS float* scr) {
    const int tt = item >> 4, n = item & 15, lane = F.lane, fr = lane & 15, fq = lane >> 4;
    const int m0 = tt * 64;
    const int s0 = m0 < MP ? (m0 & ~255) : MP + ((m0 - MP) & ~1023);
    const int Lq = m0 < MP ? 256 : 1024, t0 = m0 - s0;
    const bf16* XA = (const bf16*)(F.ws + WS_XAGA);
    const float* convw = F.a->in[18] + (size_t)j * 4 * 1024; const float* convb = F.a->in[19] + (size_t)j * 1024;
    bf16x8 af[4][2];
#pragma unroll
    for (int ks = 0; ks < 2; ++ks) { const int ch0 = 64 * n + 32 * ks + 8 * fq;
        float w[4][8], cb[8];
#pragma unroll
        for (int jj = 0; jj < 4; ++jj) { const f32x4 a = *(const f32x4*)(convw + jj * 1024 + ch0), b = *(const f32x4*)(convw + jj * 1024 + ch0 + 4);
            w[jj][0] = a.x; w[jj][1] = a.y; w[jj][2] = a.z; w[jj][3] = a.w; w[jj][4] = b.x; w[jj][5] = b.y; w[jj][6] = b.z; w[jj][7] = b.w; }
        { const f32x4 a = *(const f32x4*)(convb + ch0), b = *(const f32x4*)(convb + ch0 + 4); cb[0] = a.x; cb[1] = a.y; cb[2] = a.z; cb[3] = a.w; cb[4] = b.x; cb[5] = b.y; cb[6] = b.z; cb[7] = b.w; }
        u32x4 xin[4][4];
#pragma unroll
        for (int mt = 0; mt < 4; ++mt)
#pragma unroll
            for (int jj = 0; jj < 4; ++jj) { int tq = t0 + 16 * mt + fr + jj - 2; tq = tq < 0 ? 0 : (tq > Lq - 1 ? Lq - 1 : tq); xin[mt][jj] = *(const u32x4*)(XA + (size_t)(s0 + tq) * 2048 + ch0); }
#pragma unroll
        for (int mt = 0; mt < 4; ++mt) { const int t = t0 + 16 * mt + fr;
            float acc[8];
#pragma unroll
            for (int e = 0; e < 8; ++e) acc[e] = cb[e];
#pragma unroll
            for (int jj = 0; jj < 4; ++jj) { const int tq = t + jj - 2; const bool in = tq >= 0 && tq < Lq;
                u32x4 xv = xin[mt][jj]; xv.x = in ? xv.x : 0u; xv.y = in ? xv.y : 0u; xv.z = in ? xv.z : 0u; xv.w = in ? xv.w : 0u;
                acc[0] += bflo(xv.x) * w[jj][0]; acc[1] += bfhi(xv.x) * w[jj][1]; acc[2] += bflo(xv.y) * w[jj][2]; acc[3] += bfhi(xv.y) * w[jj][3];
                acc[4] += bflo(xv.z) * w[jj][4]; acc[5] += bfhi(xv.z) * w[jj][5]; acc[6] += bflo(xv.w) * w[jj][6]; acc[7] += bfhi(xv.w) * w[jj][7]; }
            LAS float* sp = scr + (16 * mt + fr) * 65 + 32 * ks + 8 * fq;
#pragma unroll
            for (int e = 0; e < 8; ++e) sp[e] = acc[e];
            u32x4 pk; pk.x = pkbf(acc[0], acc[1]); pk.y = pkbf(acc[2], acc[3]); pk.z = pkbf(acc[4], acc[5]); pk.w = pkbf(acc[6], acc[7]);
            af[mt][ks] = __builtin_bit_cast(bf16x8, pk); } }
    LDS_WAIT();
#pragma unroll 1
    for (int dir = 0; dir < 2; ++dir) {
        const bf16* waT = (const bf16*)(F.ws + WS_LRUW) + ((size_t)((j * 2 + dir) * 2 + 0) * 16 + n) * 4096;
        const bf16* wxT = waT + (size_t)16 * 4096;
        bf16* Ao = (bf16*)(F.ws + WS_LRU) + (size_t)(dir * 2 + 0) * MT * 1024; bf16* Ho = (bf16*)(F.ws + WS_LRU) + (size_t)(dir * 2 + 1) * MT * 1024;
#pragma unroll 1
        for (int nt = 0; nt < 4; ++nt) {
            const int ch = 64 * n + 16 * nt + fr;
            bf16x8 ba[2], bx[2];
#pragma unroll
            for (int ks = 0; ks < 2; ++ks) { ba[ks] = ld16(waT + (16 * nt + fr) * 64 + 32 * ks + 8 * fq); bx[ks] = ld16(wxT + (16 * nt + fr) * 64 + 32 * ks + 8 * fq); }
            const float bav = F.a->in[21][(size_t)(j * 2 + dir) * 1024 + ch], bxv = F.a->in[23][(size_t)(j * 2 + dir) * 1024 + ch], lam = F.a->in[24][(size_t)(j * 2 + dir) * 1024 + ch];
            const float clam = -8.0f * log1pf(expf(-lam));
            float a[4][4], u[4][4];
#pragma unroll
            for (int mt = 0; mt < 4; ++mt) { f32x4 ra = (f32x4){0.f, 0.f, 0.f, 0.f}, ga = (f32x4){0.f, 0.f, 0.f, 0.f};
#pragma unroll
                for (int ks = 0; ks < 2; ++ks) { ra = __builtin_amdgcn_mfma_f32_16x16x32_bf16(af[mt][ks], ba[ks], ra, 0, 0, 0); ga = __builtin_amdgcn_mfma_f32_16x16x32_bf16(af[mt][ks], bx[ks], ga, 0, 0, 0); }
#pragma unroll
                for (int r = 0; r < 4; ++r) { const float rg = sigmoidf_(ra[r] + bav), gi = sigmoidf_(ga[r] + bxv); const float la = clam * rg;
                    const float av = fexp2(la * LOG2E), x2 = 2.0f * la;
                    const float m2s = -x2 * (1.0f + x2 * (0.5f + x2 * (0.16666667f + x2 * (0.041666668f + x2 * (0.0083333338f + x2 * 0.0013888889f)))));
                    const float m2 = x2 > -0.5f ? m2s : 1.0f - av * av;
                    const float mult = __builtin_amdgcn_sqrtf(m2); const float xcv = scr[(16 * mt + 4 * fq + r) * 65 + 16 * nt + fr];
                    a[mt][r] = av; u[mt][r] = mult * gi * xcv; } }
            float TA, TU;
            lru_scan_store(a, u, dir == 1, fr, fq, Ao + (size_t)m0 * 1024 + ch, Ho + (size_t)m0 * 1024 + ch, TA, TU);
            if (fq == 0) { float* ag = (float*)(F.ws + WS_AGG) + ((size_t)(tt * 2 + dir) * 2) * 1024 + ch; ag[0] = TA; ag[1024] = TU; }
        }
    }
    LDS_WAIT();
}
__device__ __forceinline__ float gelu_tanh(float x) { const float z = 0.7978845608028654f * (x + 0.044715f * x * x * x); const float e = fexp2(2.0f * LOG2E * z); const float th = 1.0f - 2.0f * frcp(e + 1.0f); return 0.5f * x * (1.0f + th); }
__device__ __forceinline__ void lru_l3_item(Frame& F, int j, int item) {
    const int tt = item >> 5, rs = (item >> 2) & 7, q = item & 3, lane = F.lane, c0 = 256 * q + 4 * lane;
    const int m0 = tt * 64; const bool smp = m0 >= MP;
    const int s0 = smp ? MP + ((m0 - MP) & ~1023) : (m0 & ~255);
    const int first = s0 >> 6, last = first + (smp ? 16 : 4) - 1;
    const float* AG = (const float*)(F.ws + WS_AGG);
    const bf16* AF = (const bf16*)(F.ws + WS_LRU); const bf16* HF = AF + (size_t)MT * 1024; const bf16* AB = HF + (size_t)MT * 1024; const bf16* HB = AB + (size_t)MT * 1024;
    const bf16* GA = (const bf16*)(F.ws + WS_XAGA) + 1024; bf16* Y = (bf16*)(F.ws + WS_YCAT);
    u32x2 af[8], hf[8], ab[8], hb[8], ga[8];
#pragma unroll
    for (int r = 0; r < 8; ++r) { const size_t m = (size_t)m0 + 8 * rs + r, o = m * 1024 + c0;
        af[r] = *(const u32x2*)(AF + o); hf[r] = *(const u32x2*)(HF + o); ab[r] = *(const u32x2*)(AB + o); hb[r] = *(const u32x2*)(HB + o); ga[r] = *(const u32x2*)(GA + m * 2048 + c0); }
    f32x4 cf = (f32x4){0.f, 0.f, 0.f, 0.f}, cb = cf;
    if (smp) { const int b = (m0 - MP) >> 10; cf = *(const f32x4*)(F.a->in[2] + ((size_t)b * 2 + j) * 1024 + c0); cb = *(const f32x4*)(F.a->in[3] + ((size_t)b * 2 + j) * 1024 + c0); }
    for (int p = first; p < tt; ++p) { const f32x4 A = *(const f32x4*)(AG + ((size_t)(p * 2 + 0) * 2 + 0) * 1024 + c0), U = *(const f32x4*)(AG + ((size_t)(p * 2 + 0) * 2 + 1) * 1024 + c0); cf = A * cf + U; }
    for (int p = last; p > tt; --p) { const f32x4 A = *(const f32x4*)(AG + ((size_t)(p * 2 + 1) * 2 + 0) * 1024 + c0), U = *(const f32x4*)(AG + ((size_t)(p * 2 + 1) * 2 + 1) * 1024 + c0); cb = A * cb + U; }
#pragma unroll
    for (int r = 0; r < 8; ++r) { const size_t m = (size_t)m0 + 8 * rs + r;
        f32x4 vf, vb, g;
        vf.x = bflo(af[r].x) * cf.x + bflo(hf[r].x); vf.y = bfhi(af[r].x) * cf.y + bfhi(hf[r].x); vf.z = bflo(af[r].y) * cf.z + bflo(hf[r].y); vf.w = bfhi(af[r].y) * cf.w + bfhi(hf[r].y);
        vb.x = bflo(ab[r].x) * cb.x + bflo(hb[r].x); vb.y = bfhi(ab[r].x) * cb.y + bfhi(hb[r].x); vb.z = bflo(ab[r].y) * cb.z + bflo(hb[r].y); vb.w = bfhi(ab[r].y) * cb.w + bfhi(hb[r].y);
        g.x = gelu_tanh(bflo(ga[r].x)); g.y = gelu_tanh(bfhi(ga[r].x)); g.z = gelu_tanh(bflo(ga[r].y)); g.w = gelu_tanh(bfhi(ga[r].y));
        const f32x4 y = (vf + vb) * g;
        u32x2 w; w.x = pkbf(y.x, y.y); w.y = pkbf(y.z, y.w);
        *(u32x2*)(Y + m * 2048 + c0) = w;
        if (!smp) { const int t = (int)(m - s0), b = s0 >> 8;
            if (t == 255) *(f32x4*)(F.out + O_SF + ((size_t)b * 2 + j) * 1024 + c0) = vf;
            if (t == 0) *(f32x4*)(F.out + O_SB + ((size_t)b * 2 + j) * 1024 + c0) = vb; }
    }
}

__device__ __forceinline__ float xrow16_max(float x) {
    auto s = __builtin_amdgcn_permlane16_swap(__float_as_uint(x), __float_as_uint(x), false, false); x = fmaxf(__uint_as_float(s[0]), __uint_as_float(s[1]));
    auto t = __builtin_amdgcn_permlane32_swap(__float_as_uint(x), __float_as_uint(x), false, false); return fmaxf(__uint_as_float(t[0]), __uint_as_float(t[1]));
}
__device__ __forceinline__ float xrow16_sum(float x) {
    auto s = __builtin_amdgcn_permlane16_swap(__float_as_uint(x), __float_as_uint(x), false, false); x = __uint_as_float(s[0]) + __uint_as_float(s[1]);
    auto t = __builtin_amdgcn_permlane32_swap(__float_as_uint(x), __float_as_uint(x), false, false); return __uint_as_float(t[0]) + __uint_as_float(t[1]);
}
template <int NKS, int NDT, int QT, class Src>
__device__ __forceinline__ void attn_core(const Src& S, const bf16x8 (&qf)[QT][NKS], f32x4 (&o)[QT][NDT], float (&lsum)[QT]) {
    float mrun[QT];
#pragma unroll
    for (int qt = 0; qt < QT; ++qt) { mrun[qt] = -1e30f; lsum[qt] = 0.f;
#pragma unroll
        for (int dt = 0; dt < NDT; ++dt) o[qt][dt] = (f32x4){0.f, 0.f, 0.f, 0.f}; }
    bf16x8 kf[2][NKS], vf[NDT];
    const int nt = S.ntiles();
    S.loadk(0, kf); S.loadv(0, vf);
#pragma unroll 1
    for (int i = 0; i < nt; ++i) {
        f32x4 sc[QT][2];
#pragma unroll
        for (int qt = 0; qt < QT; ++qt)
#pragma unroll
            for (int s = 0; s < 2; ++s) { f32x4 a = (f32x4){0.f, 0.f, 0.f, 0.f};
#pragma unroll
                for (int ks = 0; ks < NKS; ++ks) a = __builtin_amdgcn_mfma_f32_16x16x32_bf16(kf[s][ks], qf[qt][ks], a, 0, 0, 0);
                sc[qt][s] = a; }
        if (i + 1 < nt) S.loadk(i + 1, kf);
#pragma unroll
        for (int qt = 0; qt < QT; ++qt) {
            S.adjust(i, qt, sc[qt]);
            float tm = fmaxf(fmaxf(fmaxf(sc[qt][0][0], sc[qt][0][1]), fmaxf(sc[qt][0][2], sc[qt][0][3])), fmaxf(fmaxf(sc[qt][1][0], sc[qt][1][1]), fmaxf(sc[qt][1][2], sc[qt][1][3])));
            tm = xrow16_max(tm);
            const float mn = fmaxf(mrun[qt], tm), alpha = fexp2(mrun[qt] - mn); mrun[qt] = mn;
            float p[8]; float ps = 0.f;
#pragma unroll
            for (int s = 0; s < 2; ++s)
#pragma unroll
                for (int r = 0; r < 4; ++r) { p[4 * s + r] = fexp2(sc[qt][s][r] - mn); ps += p[4 * s + r]; }
            lsum[qt] = lsum[qt] * alpha + ps;
#pragma unroll
            for (int dt = 0; dt < NDT; ++dt) o[qt][dt] = o[qt][dt] * alpha;
            u32x4 pk; pk.x = pkbf(p[0], p[1]); pk.y = pkbf(p[2], p[3]); pk.z = pkbf(p[4], p[5]); pk.w = pkbf(p[6], p[7]);
            const bf16x8 pf = __builtin_bit_cast(bf16x8, pk);
#pragma unroll
            for (int dt = 0; dt < NDT; ++dt) o[qt][dt] = __builtin_amdgcn_mfma_f32_16x16x32_bf16(vf[dt], pf, o[qt][dt], 0, 0, 0);
        }
        if (i + 1 < nt) S.loadv(i + 1, vf);
    }
}
template <int NDT>
__device__ __forceinline__ void attn_store(const f32x4 (&o)[NDT], float lsum, bf16* yrow  , int fq) {
    const float l = xrow16_sum(lsum);
    const float inv = 1.0f / l;
#pragma unroll
    for (int dt = 0; dt < NDT; ++dt) { const f32x4 v = o[dt] * inv; u32x2 w; w.x = pkbf(v[0], v[1]); w.y = pkbf(v[2], v[3]); *(u32x2*)(yrow + 16 * dt + 4 * fq) = w; }
}
template <int NKS, int NDT, bool MLA>
struct SegSrc {
    const bf16 *kA, *kB, *rA, *rB, *vA, *vB;
    int nA, nt, ldk, vts, kap0, kap1;
    __device__ __forceinline__ int ntiles() const { return nt; }
    __device__ __forceinline__ void loadk(int i, bf16x8 (&kf)[2][NKS]) const {
        const bool sb = i >= nA; const int key0 = 32 * (sb ? i - nA : i); const bf16* kb = sb ? kB : kA;
        const bf16* p0 = kb + (size_t)(key0 + kap0) * ldk; const bf16* p1 = kb + (size_t)(key0 + kap1) * ldk;
#pragma unroll
        for (int ks = 0; ks < (MLA ? 4 : NKS); ++ks) { kf[0][ks] = ld16(p0 + 32 * ks); kf[1][ks] = ld16(p1 + 32 * ks); }
        if (MLA) { const bf16* rb = sb ? rB : rA; const bf16* r0 = rb + (size_t)(key0 + kap0) * 64; const bf16* r1 = rb + (size_t)(key0 + kap1) * 64;
#pragma unroll
            for (int ks = 4; ks < NKS; ++ks) { kf[0][ks] = ld16(r0 + 32 * (ks - 4)); kf[1][ks] = ld16(r1 + 32 * (ks - 4)); } }
    }
    __device__ __forceinline__ void loadv(int i, bf16x8 (&vf)[NDT]) const {
        const bool sb = i >= nA; const int key0 = 32 * (sb ? i - nA : i); const bf16* p = (sb ? vB : vA) + (size_t)(key0 >> 8) * vts + (key0 & 255);
#pragma unroll
        for (int dt = 0; dt < NDT; ++dt) vf[dt] = ld16(p + dt * 16 * 256);
    }
    __device__ __forceinline__ void adjust(int, int, f32x4 (&)[2]) const {}
};
struct NaSrc {
    const bf16 *kloc, *kctx, *vloc, *vctx; const float* bias;
    int r, rstart, cs, qcol, cstq, kap0, kap1, fq;
    __device__ __forceinline__ int ntiles() const { return 24; }
    __device__ __forceinline__ void loadk(int i, bf16x8 (&kf)[2][2]) const {
        const bf16* kb; int key0;
        if (i < 8) { kb = kloc; key0 = 64 * (rstart + i) + cs; } else { kb = kctx; key0 = 32 * (i - 8); }
        const bf16* p0 = kb + (size_t)(key0 + kap0) * 1024; const bf16* p1 = kb + (size_t)(key0 + kap1) * 1024;
        kf[0][0] = ld16(p0); kf[0][1] = ld16(p0 + 32); kf[1][0] = ld16(p1); kf[1][1] = ld16(p1 + 32);
    }
    __device__ __forceinline__ void loadv(int i, bf16x8 (&vf)[4]) const {
        const bf16* vb; int key0;
        if (i < 8) { vb = vloc; key0 = 64 * (rstart + i) + cs; } else { vb = vctx; key0 = 32 * (i - 8); }
        const bf16* p = vb + (size_t)(key0 >> 8) * (1024 * 256) + (key0 & 255);
#pragma unroll
        for (int dt = 0; dt < 4; ++dt) vf[dt] = ld16(p + dt * 16 * 256);
    }
    __device__ __forceinline__ void adjust(int i, int, f32x4 (&sc)[2]) const {
        if (i < 8) { const int relr = rstart + i - r + 7;
#pragma unroll
            for (int s = 0; s < 2; ++s)
#pragma unroll
                for (int g = 0; g < 4; ++g) { const int ck = cs + 8 * fq + 4 * s + g; const bool ok = ck >= cstq && ck < cstq + 16; int relc = ck - qcol + 15; relc = relc < 0 ? 0 : (relc > 30 ? 30 : relc);
                    const float bv = bias[relr * 31 + relc]; sc[s][g] = ok ? sc[s][g] + bv * LOG2E : -1e30f; } }
    }
};

__device__ __forceinline__ void na_item(Frame& F, int j, int item) {
    const int qi = item & 3, r = (item >> 2) & 15, h = (item >> 6) & 15, b = item >> 10, lane = F.lane, fr = lane & 15, fq = lane >> 4;
    const int srow = MP + b * 1024, c0 = 16 * qi, qcol = c0 + fr;
    const int cs = qi == 0 ? 0 : (qi == 1 ? 8 : (qi == 2 ? 24 : 32));
    const int rs = r - 4 < 0 ? 0 : (r - 4 > 8 ? 8 : r - 4);
    NaSrc S; S.r = r; S.rstart = rs; S.cs = cs; S.qcol = qcol; S.cstq = qcol - 8 < 0 ? 0 : (qcol - 8 > 48 ? 48 : qcol - 8); S.fq = fq;
    S.kap0 = 8 * (fr >> 2) + (fr & 3); S.kap1 = S.kap0 + 4;
    S.kloc = (const bf16*)(F.ws + WS_KB) + (size_t)srow * 1024 + h * 64 + 8 * fq;
    S.kctx = (const bf16*)(F.ws + WS_KCNA) + (size_t)(b * 2 + j) * 512 * 1024 + h * 64 + 8 * fq;
    S.vloc = (const bf16*)(F.ws + WS_VT) + ((size_t)(srow >> 8) * 1024 + h * 64 + fr) * 256 + 8 * fq;
    S.vctx = (const bf16*)(F.ws + WS_VTCNA) + ((size_t)((b * 2 + j) * 2) * 1024 + h * 64 + fr) * 256 + 8 * fq;
    S.bias = F.a->in[25] + (size_t)(j * 16 + h) * 15 * 31;
    const size_t qrow = (size_t)srow + 64 * r + qcol;
    bf16x8 qf[1][2]; const bf16* qp = (const bf16*)(F.ws + WS_QB) + qrow * 1024 + h * 64 + 8 * fq; qf[0][0] = ld16(qp); qf[0][1] = ld16(qp + 32);
    f32x4 o[1][4]; float ls[1];
    attn_core<2, 4, 1, NaSrc>(S, qf, o, ls);
    attn_store<4>(o[0], ls[0], (bf16*)(F.ws + WS_YCAT) + qrow * 2048 + 1024 + h * 64, fq);
}
template <int QT>
__device__ __forceinline__ void dense64_item(Frame& F, const bf16* Q, int ldq, size_t qrow0, int qstep, int qcol0, int qcstep, bf16* Y, int ycol0, int ycstep,
                                             const bf16* KA, const bf16* VA, int nA, const bf16* KB_, const bf16* VB_, int nB, int ldk, int vts) {
    const int lane = F.lane, fr = lane & 15, fq = lane >> 4;
    SegSrc<2, 4, false> S; S.kap0 = 8 * (fr >> 2) + (fr & 3); S.kap1 = S.kap0 + 4; S.nA = nA; S.nt = nA + nB; S.ldk = ldk; S.vts = vts;
    S.kA = KA + 8 * fq; S.kB = KB_ + 8 * fq; S.rA = nullptr; S.rB = nullptr; S.vA = VA + (size_t)fr * 256 + 8 * fq; S.vB = VB_ + (size_t)fr * 256 + 8 * fq;
    bf16x8 qf[QT][2];
#pragma unroll
    for (int qt = 0; qt < QT; ++qt) { const bf16* qp = Q + (qrow0 + (size_t)qstep * qt + fr) * ldq + qcol0 + qcstep * qt + 8 * fq; qf[qt][0] = ld16(qp); qf[qt][1] = ld16(qp + 32); }
    f32x4 o[QT][4]; float ls[QT];
    attn_core<2, 4, QT, SegSrc<2, 4, false>>(S, qf, o, ls);
#pragma unroll
    for (int qt = 0; qt < QT; ++qt) attn_store<4>(o[qt], ls[qt], Y + (qrow0 + (size_t)qstep * qt + fr) * 2048 + ycol0 + ycstep * qt, fq);
}
__device__ __forceinline__ void mla_item(Frame& F, int j, int h, size_t qrow0, size_t krowA, int nA, size_t krowB, int nB) {
    const int lane = F.lane, fr = lane & 15, fq = lane >> 4;
    const bf16* KN = (const bf16*)(F.ws + WS_KN); const bf16* KR = (const bf16*)(F.ws + WS_KRALL) + (size_t)j * MKV * 64; const bf16* VDT = (const bf16*)(F.ws + WS_VDT);
    SegSrc<6, 8, true> S; S.kap0 = 8 * (fr >> 2) + (fr & 3); S.kap1 = S.kap0 + 4; S.nA = nA; S.nt = nA + nB; S.ldk = 1024; S.vts = 1024 * 256;
    S.kA = KN + krowA * 1024 + h * 128 + 8 * fq; S.kB = KN + krowB * 1024 + h * 128 + 8 * fq;
    S.rA = KR + krowA * 64 + 8 * fq; S.rB = KR + krowB * 64 + 8 * fq;
    S.vA = VDT + ((size_t)(krowA >> 8) * 1024 + h * 128 + fr) * 256 + 8 * fq; S.vB = VDT + ((size_t)(krowB >> 8) * 1024 + h * 128 + fr) * 256 + 8 * fq;
    bf16x8 qf[1][6];
    { const bf16* qp = (const bf16*)(F.ws + WS_QD) + (qrow0 + fr) * 1536 + h * 192 + 8 * fq;
#pragma unroll
      for (int ks = 0; ks < 6; ++ks) qf[0][ks] = ld16(qp + 32 * ks); }
    f32x4 o[1][8]; float ls[1];
    attn_core<6, 8, 1, SegSrc<6, 8, true>>(S, qf, o, ls);
    attn_store<8>(o[0], ls[0], (bf16*)(F.ws + WS_YCAT) + (qrow0 + fr) * 2048 + 1024 + h * 128, fq);
}

constexpr int RING_D = 4;
template <int N> __device__ __forceinline__ void wait_vm() { asm volatile("s_waitcnt vmcnt(%0)" :: "n"(N) : "memory"); }
template <int NF8> struct RingPlan { const char* bA[NF8]; const char* bB[NF8]; unsigned voff[NF8]; unsigned pitch[NF8]; bool isv[NF8]; };
template <int NKS, int NDT, class Src>
__device__ __forceinline__ void ring_issue(LAS unsigned char* slot, const Src& S, const RingPlan<(2 * NKS + NDT + 7) / 8>& P, int t, int wave) {
    constexpr int NF = 2 * NKS + NDT, NF8 = (NF + 7) / 8;
    bool segB; unsigned key0; S.tile(t, segB, key0);
    const unsigned offv = S.voffset(key0);
#pragma unroll
    for (int k = 0; k < NF8; ++k) { const int f = wave + 8 * k;
        const char* ub = (segB ? P.bB[k] : P.bA[k]) + (P.isv[k] ? (size_t)offv : (size_t)key0 * P.pitch[k]);
        __builtin_amdgcn_global_load_lds((const unsigned*)(ub + P.voff[k]), (LAS unsigned*)(slot + f * 1024), 16, 0, 0); }
}
template <int NKS, int NDT, int QT, class Src>
__device__ __forceinline__ void attn_ring(LAS unsigned char* ring, const Src& S, const bf16x8 (&qf)[QT][NKS], f32x4 (&o)[QT][NDT], float (&lsum)[QT], int wave, int lane) {
    constexpr int NF = 2 * NKS + NDT, NF8 = (NF + 7) / 8, SLOTB = NF8 * 8 * 1024;
    static_assert(RING_D == 4, "the tile loop is unrolled by the ring depth so that every slot offset is a compile-time constant (else hipcc drains vmcnt ahead of the ds_reads)");
    float mrun[QT]; f32x4 osum[QT];
#pragma unroll
    for (int qt = 0; qt < QT; ++qt) { mrun[qt] = 0.f; osum[qt] = (f32x4){0.f, 0.f, 0.f, 0.f};
#pragma unroll
        for (int dt = 0; dt < NDT; ++dt) o[qt][dt] = (f32x4){0.f, 0.f, 0.f, 0.f}; }
    bool first = true;
    const bf16x8 ones = __builtin_bit_cast(bf16x8, (u32x4){0x3F803F80u, 0x3F803F80u, 0x3F803F80u, 0x3F803F80u});
    const int nt = S.ntiles();
    RingPlan<NF8> P;
#pragma unroll
    for (int k = 0; k < NF8; ++k) { const int f = wave + 8 * k; S.plan(f < NF ? f : f - 8, P.bA[k], P.bB[k], P.voff[k], P.pitch[k], P.isv[k]); }
    asm volatile("s_waitcnt vmcnt(0) lgkmcnt(0)" ::: "memory"); __builtin_amdgcn_s_barrier(); asm volatile("" ::: "memory");
#pragma unroll
    for (int t = 0; t < RING_D - 1; ++t) ring_issue<NKS, NDT, Src>(ring + t * SLOTB, S, P, t, wave);
    f32x4 scE[QT][2], scO[QT][2];
#define ATT_SPROD(dst, slotidx) do { const LAS unsigned char* sl_ = ring + (slotidx) * SLOTB + lane * 16; bf16x8 kf[2][NKS]; \
        _Pragma("unroll") for (int s = 0; s < 2; ++s) _Pragma("unroll") for (int ks = 0; ks < NKS; ++ks) kf[s][ks] = *(const LAS bf16x8*)(sl_ + (s * NKS + ks) * 1024); \
        _Pragma("unroll") for (int qt = 0; qt < QT; ++qt) _Pragma("unroll") for (int s = 0; s < 2; ++s) { const float nm = -mrun[qt]; f32x4 a = (f32x4){nm, nm, nm, nm}; \
            _Pragma("unroll") for (int ks = 0; ks < NKS; ++ks) a = __builtin_amdgcn_mfma_f32_16x16x32_bf16(kf[s][ks], qf[qt][ks], a, 0, 0, 0); dst[qt][s] = a; } } while (0)
    wait_vm<(RING_D - 2) * NF8>(); __builtin_amdgcn_s_barrier(); asm volatile("" ::: "memory");
    bool cur_ok = S.active(0);
    if (cur_ok) ATT_SPROD(scE, 0);
#pragma unroll 1
    for (int i0 = 0; i0 < nt; i0 += RING_D) {
#pragma unroll
        for (int ph = 0; ph < RING_D; ++ph) { const int i = i0 + ph;
        f32x4 (&scC)[QT][2] = (ph & 1) ? scO : scE; f32x4 (&scN)[QT][2] = (ph & 1) ? scE : scO;
        if (i + 1 < nt) { if (i + 2 < nt) wait_vm<NF8>(); else wait_vm<0>(); }
        asm volatile("s_waitcnt lgkmcnt(0)" ::: "memory");
        __builtin_amdgcn_s_barrier(); asm volatile("" ::: "memory");
        if (i + RING_D - 1 < nt) ring_issue<NKS, NDT, Src>(ring + ((ph + RING_D - 1) & (RING_D - 1)) * SLOTB, S, P, i + RING_D - 1, wave);
        const bool nxt_ok = (i + 1 < nt) && S.active(i + 1);
        if (nxt_ok) ATT_SPROD(scN, (ph + 1) & (RING_D - 1));
        if (cur_ok) {
            const LAS unsigned char* slot = ring + ph * SLOTB + lane * 16;
            bf16x8 vf[NDT];
#pragma unroll
            for (int dt = 0; dt < NDT; ++dt) vf[dt] = *(const LAS bf16x8*)(slot + (2 * NKS + dt) * 1024);
#pragma unroll
            for (int qt = 0; qt < QT; ++qt) {
                S.adjust(i, qt, scC[qt]);
                float tm = fmaxf(fmaxf(fmaxf(scC[qt][0][0], scC[qt][0][1]), fmaxf(scC[qt][0][2], scC[qt][0][3])), fmaxf(fmaxf(scC[qt][1][0], scC[qt][1][1]), fmaxf(scC[qt][1][2], scC[qt][1][3])));
                tm = xrow16_max(tm);
                if (first || __builtin_amdgcn_ballot_w64(tm > ATT_DEFER) != 0ull) {
                    const float d = first ? tm : fmaxf(tm, 0.f), alpha = first ? 0.f : fexp2(-d); mrun[qt] += d; osum[qt] = osum[qt] * alpha;
#pragma unroll
                    for (int dt = 0; dt < NDT; ++dt) o[qt][dt] = o[qt][dt] * alpha;
#pragma unroll
                    for (int s = 0; s < 2; ++s) { scC[qt][s] = scC[qt][s] - d; if (nxt_ok) scN[qt][s] = scN[qt][s] - d; } }
                u32x4 pk; pk.x = pkbf(fexp2(scC[qt][0][0]), fexp2(scC[qt][0][1])); pk.y = pkbf(fexp2(scC[qt][0][2]), fexp2(scC[qt][0][3]));
                pk.z = pkbf(fexp2(scC[qt][1][0]), fexp2(scC[qt][1][1])); pk.w = pkbf(fexp2(scC[qt][1][2]), fexp2(scC[qt][1][3]));
                const bf16x8 pf = __builtin_bit_cast(bf16x8, pk);
#pragma unroll
                for (int dt = 0; dt < NDT; ++dt) o[qt][dt] = __builtin_amdgcn_mfma_f32_16x16x32_bf16(vf[dt], pf, o[qt][dt], 0, 0, 0);
                osum[qt] = __builtin_amdgcn_mfma_f32_16x16x32_bf16(ones, pf, osum[qt], 0, 0, 0);
            }
            first = false;
        }
        cur_ok = nxt_ok;
        __builtin_amdgcn_sched_barrier(0);
        }
    }
    asm volatile("s_waitcnt lgkmcnt(0)" ::: "memory");
#undef ATT_SPROD
#pragma unroll
    for (int qt = 0; qt < QT; ++qt) lsum[qt] = osum[qt][0] * 0.25f;
}
template <int NKS, int NDT, int QT, class Src>
__device__ __forceinline__ void attn_ring_np(LAS unsigned char* ring, const Src& S, const bf16x8 (&qf)[QT][NKS], f32x4 (&o)[QT][NDT], float (&lsum)[QT], int wave, int lane) {
    constexpr int NF = 2 * NKS + NDT, NF8 = (NF + 7) / 8, SLOTB = NF8 * 8 * 1024;
    static_assert(RING_D == 4, "the tile loop is unrolled by the ring depth so that every slot offset is a compile-time constant (else hipcc drains vmcnt ahead of the ds_reads)");
    float mrun[QT]; f32x4 osum[QT];
#pragma unroll
    for (int qt = 0; qt < QT; ++qt) { mrun[qt] = 0.f; osum[qt] = (f32x4){0.f, 0.f, 0.f, 0.f};
#pragma unroll
        for (int dt = 0; dt < NDT; ++dt) o[qt][dt] = (f32x4){0.f, 0.f, 0.f, 0.f}; }
    bool first = true;
    const bf16x8 ones = __builtin_bit_cast(bf16x8, (u32x4){0x3F803F80u, 0x3F803F80u, 0x3F803F80u, 0x3F803F80u});
    const int nt = S.ntiles();
    RingPlan<NF8> P;
#pragma unroll
    for (int k = 0; k < NF8; ++k) { const int f = wave + 8 * k; S.plan(f < NF ? f : f - 8, P.bA[k], P.bB[k], P.voff[k], P.pitch[k], P.isv[k]); }
    asm volatile("s_waitcnt vmcnt(0) lgkmcnt(0)" ::: "memory"); __builtin_amdgcn_s_barrier(); asm volatile("" ::: "memory");
#pragma unroll
    for (int t = 0; t < RING_D - 1; ++t) ring_issue<NKS, NDT, Src>(ring + t * SLOTB, S, P, t, wave);
#pragma unroll 1
    for (int i0 = 0; i0 < nt; i0 += RING_D) {
#pragma unroll
        for (int ph = 0; ph < RING_D; ++ph) { const int i = i0 + ph;
        if (i + RING_D - 1 <= nt) wait_vm<(RING_D - 2) * NF8>(); else wait_vm<0>();
        __builtin_amdgcn_s_barrier(); asm volatile("" ::: "memory");
        if (i + RING_D - 1 < nt) ring_issue<NKS, NDT, Src>(ring + ((ph + RING_D - 1) & (RING_D - 1)) * SLOTB, S, P, i + RING_D - 1, wave);
        if (S.active(i)) {
            const LAS unsigned char* slot = ring + ph * SLOTB + lane * 16;
            f32x4 sc[QT][2];
            { bf16x8 kf[2][NKS];
#pragma unroll
              for (int s = 0; s < 2; ++s)
#pragma unroll
                for (int ks = 0; ks < NKS; ++ks) kf[s][ks] = *(const LAS bf16x8*)(slot + (s * NKS + ks) * 1024);
#pragma unroll
              for (int qt = 0; qt < QT; ++qt)
#pragma unroll
                for (int s = 0; s < 2; ++s) { const float nm = -mrun[qt]; f32x4 a = (f32x4){nm, nm, nm, nm};
#pragma unroll
                    for (int ks = 0; ks < NKS; ++ks) a = __builtin_amdgcn_mfma_f32_16x16x32_bf16(kf[s][ks], qf[qt][ks], a, 0, 0, 0);
                    sc[qt][s] = a; } }
            __builtin_amdgcn_sched_barrier(0);
            bf16x8 vf[NDT];
#pragma unroll
            for (int dt = 0; dt < NDT; ++dt) vf[dt] = *(const LAS bf16x8*)(slot + (2 * NKS + dt) * 1024);
#pragma unroll
            for (int qt = 0; qt < QT; ++qt) {
                S.adjust(i, qt, sc[qt]);
                float tm = fmaxf(fmaxf(fmaxf(sc[qt][0][0], sc[qt][0][1]), fmaxf(sc[qt][0][2], sc[qt][0][3])), fmaxf(fmaxf(sc[qt][1][0], sc[qt][1][1]), fmaxf(sc[qt][1][2], sc[qt][1][3])));
                tm = xrow16_max(tm);
                if (first || __builtin_amdgcn_ballot_w64(tm > ATT_DEFER) != 0ull) {
                    const float d = first ? tm : fmaxf(tm, 0.f), alpha = first ? 0.f : fexp2(-d); mrun[qt] += d; osum[qt] = osum[qt] * alpha;
#pragma unroll
                    for (int dt = 0; dt < NDT; ++dt) o[qt][dt] = o[qt][dt] * alpha;
#pragma unroll
                    for (int s = 0; s < 2; ++s) sc[qt][s] = sc[qt][s] - d; }
                u32x4 pk; pk.x = pkbf(fexp2(sc[qt][0][0]), fexp2(sc[qt][0][1])); pk.y = pkbf(fexp2(sc[qt][0][2]), fexp2(sc[qt][0][3]));
                pk.z = pkbf(fexp2(sc[qt][1][0]), fexp2(sc[qt][1][1])); pk.w = pkbf(fexp2(sc[qt][1][2]), fexp2(sc[qt][1][3]));
                const bf16x8 pf = __builtin_bit_cast(bf16x8, pk);
#pragma unroll
                for (int dt = 0; dt < NDT; ++dt) o[qt][dt] = __builtin_amdgcn_mfma_f32_16x16x32_bf16(vf[dt], pf, o[qt][dt], 0, 0, 0);
                osum[qt] = __builtin_amdgcn_mfma_f32_16x16x32_bf16(ones, pf, osum[qt], 0, 0, 0);
            }
            first = false;
        }
        asm volatile("s_waitcnt lgkmcnt(0)" ::: "memory");
        __builtin_amdgcn_sched_barrier(0);
        }
    }
#pragma unroll
    for (int qt = 0; qt < QT; ++qt) lsum[qt] = osum[qt][0] * 0.25f;
}
template <int NKS, int NDT, bool MLA>
struct RingSeg {
    const bf16 *kA, *kB, *rA, *rB, *vA, *vB;
    unsigned oK0, oK1, oR0, oR1, oV;
    int nA, nt, ldk, vts;
    __device__ __forceinline__ void lanes(int fr, int fq) { const int kap0 = 8 * (fr >> 2) + (fr & 3), kap1 = kap0 + 4;
        oK0 = (unsigned)(kap0 * ldk + 8 * fq) * 2u; oK1 = (unsigned)(kap1 * ldk + 8 * fq) * 2u; oR0 = (unsigned)(kap0 * 64 + 8 * fq) * 2u; oR1 = (unsigned)(kap1 * 64 + 8 * fq) * 2u; oV = (unsigned)(fr * 256 + 8 * fq) * 2u; }
    __device__ __forceinline__ int ntiles() const { return nt; }
    __device__ __forceinline__ bool active(int) const { return true; }
    __device__ __forceinline__ void adjust(int, int, f32x4 (&)[2]) const {}
    __device__ __forceinline__ void tile(int t, bool& segB, unsigned& key0) const { segB = t >= nA; key0 = 32u * (unsigned)(segB ? t - nA : t); }
    __device__ __forceinline__ unsigned voffset(unsigned key0) const { return ((key0 >> 8) * (unsigned)vts + (key0 & 255u)) * 2u; }
    __device__ __forceinline__ void plan(int f, const char*& bA, const char*& bB, unsigned& voff, unsigned& pitch, bool& isv) const {
        if (f < 2 * NKS) { const int s = f >= NKS ? 1 : 0, ks = f - s * NKS; isv = false;
            if (MLA && ks >= 4) { voff = s ? oR1 : oR0; pitch = 128u; bA = (const char*)(rA + 32 * (ks - 4)); bB = (const char*)(rB + 32 * (ks - 4)); }
            else { voff = s ? oK1 : oK0; pitch = (unsigned)ldk * 2u; bA = (const char*)(kA + 32 * ks); bB = (const char*)(kB + 32 * ks); } }
        else { isv = true; voff = oV; pitch = 0u; bA = (const char*)(vA + (f - 2 * NKS) * 16 * 256); bB = (const char*)(vB + (f - 2 * NKS) * 16 * 256); }
    }
};
struct RingNa {
    const bf16 *kloc, *kctx, *vloc, *vctx; const LAS float* biasl;
    unsigned oK0, oK1, oV;
    int R0, r, rstart, cs, qcol, cstq, fq;
    __device__ __forceinline__ int ntiles() const { return 28; }
    __device__ __forceinline__ bool active(int i) const { const int kr = R0 + i; return i >= 12 || (kr >= rstart && kr < rstart + 8); }
    __device__ __forceinline__ void tile(int t, bool& segB, unsigned& key0) const { segB = t >= 12; key0 = segB ? 32u * (unsigned)(t - 12) : (unsigned)(64 * (R0 + t) + cs); }
    __device__ __forceinline__ unsigned voffset(unsigned key0) const { return ((key0 >> 8) * (1024u * 256u) + (key0 & 255u)) * 2u; }
    __device__ __forceinline__ void plan(int f, const char*& bA, const char*& bB, unsigned& voff, unsigned& pitch, bool& isv) const {
        if (f < 4) { const int s = f >> 1, ks = f & 1; isv = false; voff = s ? oK1 : oK0; pitch = 2048u; bA = (const char*)(kloc + 32 * ks); bB = (const char*)(kctx + 32 * ks); }
        else { isv = true; voff = oV; pitch = 0u; bA = (const char*)(vloc + (f - 4) * 16 * 256); bB = (const char*)(vctx + (f - 4) * 16 * 256); }
    }
    __device__ __forceinline__ void adjust(int i, int, f32x4 (&sc)[2]) const {
        if (i < 12) { const int relr = R0 + i - r + 7; float bv[8];
#pragma unroll
            for (int k = 0; k < 8; ++k) { const int ck = cs + 8 * fq + k; int relc = ck - qcol + 15; relc = relc < 0 ? 0 : (relc > 30 ? 30 : relc); bv[k] = biasl[relr * 31 + relc]; }
            asm volatile("" : "+v"(bv[0]), "+v"(bv[1]), "+v"(bv[2]), "+v"(bv[3]), "+v"(bv[4]), "+v"(bv[5]), "+v"(bv[6]), "+v"(bv[7]));
#pragma unroll
            for (int s = 0; s < 2; ++s)
#pragma unroll
                for (int g = 0; g < 4; ++g) { const int ck = cs + 8 * fq + 4 * s + g; const bool ok = ck >= cstq && ck < cstq + 16;
                    sc[s][g] = ok ? sc[s][g] + bv[4 * s + g] * LOG2E : -1e30f; } }
    }
};
constexpr int RING_BIAS_OFF = 100 * 1024;
__device__ __forceinline__ void na_group(Frame& F, int j, int grp) {
    const int rh = grp & 1, qi = (grp >> 1) & 3, h = (grp >> 3) & 15, b = grp >> 7, lane = F.lane, fr = lane & 15, fq = lane >> 4;
    const int r = 8 * rh + F.wave, srow = MP + b * 1024, c0 = 16 * qi, qcol = c0 + fr;
    LAS float* bl = (LAS float*)(F.lds + RING_BIAS_OFF);
    asm volatile("s_waitcnt lgkmcnt(0)" ::: "memory"); __builtin_amdgcn_s_barrier();
    for (int e = F.tid; e < 15 * 31; e += NWAVES * 64) bl[e] = F.a->in[25][(size_t)(j * 16 + h) * 15 * 31 + e];
    RingNa S; S.R0 = rh ? 4 : 0; S.r = r; S.rstart = r - 4 < 0 ? 0 : (r - 4 > 8 ? 8 : r - 4); S.cs = qi == 0 ? 0 : (qi == 1 ? 8 : (qi == 2 ? 24 : 32)); S.qcol = qcol;
    S.cstq = qcol - 8 < 0 ? 0 : (qcol - 8 > 48 ? 48 : qcol - 8); S.fq = fq; S.biasl = bl;
    { const int kap0 = 8 * (fr >> 2) + (fr & 3); S.oK0 = (unsigned)(kap0 * 1024 + 8 * fq) * 2u; S.oK1 = (unsigned)((kap0 + 4) * 1024 + 8 * fq) * 2u; S.oV = (unsigned)(fr * 256 + 8 * fq) * 2u; }
    S.kloc = (const bf16*)(F.ws + WS_KB) + (size_t)srow * 1024 + h * 64;
    S.kctx = (const bf16*)(F.ws + WS_KCNA) + (size_t)(b * 2 + j) * 512 * 1024 + h * 64;
    S.vloc = (const bf16*)(F.ws + WS_VT) + ((size_t)(srow >> 8) * 1024 + h * 64) * 256;
    S.vctx = (const bf16*)(F.ws + WS_VTCNA) + ((size_t)((b * 2 + j) * 2) * 1024 + h * 64) * 256;
    const size_t qrow = (size_t)srow + 64 * r + qcol;
    bf16x8 qf[1][2]; const bf16* qp = (const bf16*)(F.ws + WS_QB) + qrow * 1024 + h * 64 + 8 * fq; qf[0][0] = ld16(qp); qf[0][1] = ld16(qp + 32);
    f32x4 o[1][4]; float ls[1];
    attn_ring<2, 4, 1, RingNa>(F.lds, S, qf, o, ls, F.wave, lane);
    attn_store<4>(o[0], ls[0], (bf16*)(F.ws + WS_YCAT) + qrow * 2048 + 1024 + h * 64, fq);
}
template <int QT>
__device__ __forceinline__ void dense64_group(Frame& F, const bf16* Q, int ldq, size_t qrow0, int wq, int qstep, int qcol0, int qcstep, bf16* Y, int ycol0, int ycstep,
                                              const bf16* KA, const bf16* VA, int nA, const bf16* KB_, const bf16* VB_, int nB, int ldk, int vts) {
    const int lane = F.lane, fr = lane & 15, fq = lane >> 4;
    RingSeg<2, 4, false> S; S.nA = nA; S.nt = nA + nB; S.ldk = ldk; S.vts = vts; S.lanes(fr, fq);
    S.kA = KA; S.kB = KB_; S.rA = nullptr; S.rB = nullptr; S.vA = VA; S.vB = VB_;
    const size_t qr = qrow0 + (size_t)wq * F.wave;
    bf16x8 qf[QT][2];
#pragma unroll
    for (int qt = 0; qt < QT; ++qt) { const bf16* qp = Q + (qr + (size_t)qstep * qt + fr) * ldq + qcol0 + qcstep * qt + 8 * fq; qf[qt][0] = ld16(qp); qf[qt][1] = ld16(qp + 32); }
    f32x4 o[QT][4]; float ls[QT];
    if constexpr (QT >= 4) attn_ring_np<2, 4, QT, RingSeg<2, 4, false>>(F.lds, S, qf, o, ls, F.wave, lane);
    else attn_ring<2, 4, QT, RingSeg<2, 4, false>>(F.lds, S, qf, o, ls, F.wave, lane);
#pragma unroll
    for (int qt = 0; qt < QT; ++qt) attn_store<4>(o[qt], ls[qt], Y + (qr + (size_t)qstep * qt + fr) * 2048 + ycol0 + ycstep * qt, fq);
}
__device__ __forceinline__ void mla_group(Frame& F, int j, int h, size_t qrow0, size_t krowA, int nA, size_t krowB, int nB) {
    const int lane = F.lane, fr = lane & 15, fq = lane >> 4;
    const bf16* KN = (const bf16*)(F.ws + WS_KN); const bf16* KR = (const bf16*)(F.ws + WS_KRALL) + (size_t)j * MKV * 64; const bf16* VDT = (const bf16*)(F.ws + WS_VDT);
    RingSeg<6, 8, true> S; S.nA = nA; S.nt = nA + nB; S.ldk = 1024; S.vts = 1024 * 256; S.lanes(fr, fq);
    S.kA = KN + krowA * 1024 + h * 128; S.kB = KN + krowB * 1024 + h * 128;
    S.rA = KR + krowA * 64; S.rB = KR + krowB * 64;
    S.vA = VDT + ((size_t)(krowA >> 8) * 1024 + h * 128) * 256; S.vB = VDT + ((size_t)(krowB >> 8) * 1024 + h * 128) * 256;
    const size_t qr = qrow0 + 16 * F.wave;
    bf16x8 qf[1][6];
    { const bf16* qp = (const bf16*)(F.ws + WS_QD) + (qr + fr) * 1536 + h * 192 + 8 * fq;
#pragma unroll
      for (int ks = 0; ks < 6; ++ks) qf[0][ks] = ld16(qp + 32 * ks); }
    f32x4 o[1][8]; float ls[1];
    attn_ring<6, 8, 1, RingSeg<6, 8, true>>(F.lds, S, qf, o, ls, F.wave, lane);
    attn_store<8>(o[0], ls[0], (bf16*)(F.ws + WS_YCAT) + (qr + fr) * 2048 + 1024 + h * 128, fq);
}

__device__ __forceinline__ void cd_ctx_convert(Frame& F, int j) {
    LAS float* scr = (LAS float*)(F.lds + F.wave * SCR_PER_WAVE);
    const int gw = (int)blockIdx.x * NWAVES + F.wave, NGW = F.G * NWAVES, lane = F.lane; unsigned char* ws = F.ws;
    for (int it = gw; it < 8 * 32; it += NGW) { const int b = it >> 5, q = it & 31, kb = q >> 2, nb = q & 3, k0 = 64 * kb, n0 = 64 * nb, mat = b * 2 + j;
        tr_item(F.a->in[7] + (size_t)mat * 512 * 256 + (size_t)k0 * 256 + n0, 256, (bf16*)(ws + WS_VTCG) + ((size_t)(mat * 2 + (k0 >> 8)) * 256 + n0) * 256 + (k0 & 255), 256, scr, lane); }
    const int gt = gw * 64 + lane, ngt = NGW * 64;
    for (int i = gt; i < 8 * 512 * 256 / 4; i += ngt) { const int e = i * 4, b = e / (512 * 256), rem = e % (512 * 256); const size_t o = (size_t)(b * 2 + j) * 512 * 256 + rem;
        const f32x4 v = *(const f32x4*)(F.a->in[6] + o); u32x2 w; w.x = pkbf(v.x, v.y); w.y = pkbf(v.z, v.w); *(u32x2*)((bf16*)(ws + WS_KCG) + o) = w; }
    for (int i = gt; i < 8 * 512 * 512 / 4; i += ngt) { const int e = i * 4, b = e / (512 * 512), rem = e % (512 * 512);
        const f32x4 v = *(const f32x4*)(F.a->in[8] + (size_t)(b * 2 + j) * 512 * 512 + rem); u32x2 w; w.x = pkbf(v.x, v.y); w.y = pkbf(v.z, v.w);
        *(u32x2*)((bf16*)(ws + WS_CKVALL) + ((size_t)j * MKV + MT + b * 512) * 512 + rem) = w; }
    for (int i = gt; i < 8 * 512 * 64 / 4; i += ngt) { const int e = i * 4, b = e / (512 * 64), rem = e % (512 * 64);
        const f32x4 v = *(const f32x4*)(F.a->in[9] + (size_t)(b * 2 + j) * 512 * 64 + rem); u32x2 w; w.x = pkbf(v.x, v.y); w.y = pkbf(v.z, v.w);
        *(u32x2*)((bf16*)(ws + WS_KRALL) + ((size_t)j * MKV + MT + b * 512) * 64 + rem) = w; }
}
__device__ __forceinline__ void cd_post_row(Frame& F, int j, int m) {
    const int lane = F.lane, l16 = lane & 15, hg = lane >> 4;
    const bool smp = m >= MP; const int t = smp ? ((m - MP) & 1023) : (m & 255), b = smp ? ((m - MP) >> 10) : (m >> 8);
    const bf16* raw = (const bf16*)(F.ws + WS_RAW) + (size_t)m * 2816; const float* rope = (const float*)(F.ws + WS_ROPE);
    const int d0 = 4 * l16;
    const int pos = d0 >= 32 ? (t & 63) : (t >> 6); const bool isx2 = (d0 & 31) >= 16; const int fi = d0 & 15;
    const f32x4 rc = *(const f32x4*)(rope + pos * 16 + fi), rs = *(const f32x4*)(rope + 1024 + pos * 16 + fi);
#pragma unroll
    for (int g = 0; g < 5; ++g) { const int col = (g < 4 ? (4 * g + hg) * 64 : 1024 + hg * 64) + d0;
        const u32x2 rw = *(const u32x2*)(raw + col); f32x4 v = (f32x4){bflo(rw.x), bfhi(rw.x), bflo(rw.y), bfhi(rw.y)};
        float ss = (v.x * v.x + v.y * v.y) + (v.z * v.z + v.w * v.w); ss += __shfl_xor(ss, 1); ss += __shfl_xor(ss, 2); ss += __shfl_xor(ss, 4); ss += __shfl_xor(ss, 8);
        const float rstd = 1.0f / sqrtf(ss * (1.0f / 64.0f) + EPS);
        const f32x4 gn = *(const f32x4*)((g < 4 ? F.a->in[28] : F.a->in[29]) + j * 64 + d0);
        v = v * rstd * gn;
        if (g == 4 && !smp) *(f32x4*)(F.out + O_GK + ((size_t)(b * 2 + j) * 256 + t) * 256 + hg * 64 + d0) = v;
        f32x4 pr; pr.x = __shfl_xor(v.x, 4); pr.y = __shfl_xor(v.y, 4); pr.z = __shfl_xor(v.z, 4); pr.w = __shfl_xor(v.w, 4);
        if (smp) v = isx2 ? v * rc + pr * rs : v * rc - pr * rs;
        if (g < 4) { v = v * QS64; u32x2 w; w.x = pkbf(v.x, v.y); w.y = pkbf(v.z, v.w); *(u32x2*)((bf16*)(F.ws + WS_QG) + (size_t)m * 1024 + (4 * g + hg) * 64 + d0) = w; }
        else { u32x2 w; w.x = pkbf(v.x, v.y); w.y = pkbf(v.z, v.w); *(u32x2*)((bf16*)(F.ws + WS_KG) + (size_t)m * 256 + hg * 64 + d0) = w; } }
    { const u32x2 rw = *(const u32x2*)(raw + 1280 + 4 * lane); const f32x4 v = (f32x4){bflo(rw.x), bfhi(rw.x), bflo(rw.y), bfhi(rw.y)};
      if (!smp) *(f32x4*)(F.out + O_GV + ((size_t)(b * 2 + j) * 256 + t) * 256 + 4 * lane) = v;
      bf16* p = (bf16*)(F.ws + WS_VGT) + ((size_t)(m >> 8) * 256 + 4 * lane) * 256 + (m & 255);
      p[0] = (bf16)(rw.x & 0xffffu); p[256] = (bf16)(rw.x >> 16); p[512] = (bf16)(rw.y & 0xffffu); p[768] = (bf16)(rw.y >> 16); }
#pragma unroll
    for (int which = 0; which < 2; ++which) { const u32x4 rw = *(const u32x4*)(raw + (which ? 2048 : 1536) + 8 * lane);
        float v[8] = {bflo(rw.x), bfhi(rw.x), bflo(rw.y), bfhi(rw.y), bflo(rw.z), bfhi(rw.z), bflo(rw.w), bfhi(rw.w)};
        float ss = 0.f;
#pragma unroll
        for (int e = 0; e < 8; ++e) ss += v[e] * v[e];
        const float rstd = 1.0f / sqrtf(wave_sum(ss) * (1.0f / 512.0f) + EPS);
        const float* gp = (which ? F.a->in[31] : F.a->in[30]) + j * 512 + 8 * lane; const f32x4 g0 = *(const f32x4*)gp, g1 = *(const f32x4*)(gp + 4);
        v[0] *= rstd * g0.x; v[1] *= rstd * g0.y; v[2] *= rstd * g0.z; v[3] *= rstd * g0.w; v[4] *= rstd * g1.x; v[5] *= rstd * g1.y; v[6] *= rstd * g1.z; v[7] *= rstd * g1.w;
        u32x4 w; w.x = pkbf(v[0], v[1]); w.y = pkbf(v[2], v[3]); w.z = pkbf(v[4], v[5]); w.w = pkbf(v[6], v[7]);
        if (which == 0) *(u32x4*)((bf16*)(F.ws + WS_QA) + (size_t)m * 512 + 8 * lane) = w;
        else { *(u32x4*)((bf16*)(F.ws + WS_CKVALL) + ((size_t)j * MKV + m) * 512 + 8 * lane) = w;
            if (!smp) { float* o = F.out + O_CKV + ((size_t)(b * 2 + j) * 256 + t) * 512 + 8 * lane; *(f32x4*)o = (f32x4){v[0], v[1], v[2], v[3]}; *(f32x4*)(o + 4) = (f32x4){v[4], v[5], v[6], v[7]}; } } }
    { const u32x2 rw = *(const u32x2*)(raw + 2560 + d0); f32x4 v = (f32x4){bflo(rw.x), bfhi(rw.x), bflo(rw.y), bfhi(rw.y)};
      if (!smp && lane < 16) *(f32x4*)(F.out + O_KR + ((size_t)(b * 2 + j) * 256 + t) * 64 + d0) = v;
      f32x4 pr; pr.x = __shfl_xor(v.x, 4); pr.y = __shfl_xor(v.y, 4); pr.z = __shfl_xor(v.z, 4); pr.w = __shfl_xor(v.w, 4);
      if (smp) v = isx2 ? v * rc + pr * rs : v * rc - pr * rs;
      if (lane < 16) { u32x2 w; w.x = pkbf(v.x, v.y); w.y = pkbf(v.z, v.w); *(u32x2*)((bf16*)(F.ws + WS_KRALL) + ((size_t)j * MKV + m) * 64 + d0) = w; } }
}

__global__ void __launch_bounds__(NWAVES * 64, 2) trunk_fwd(Args args) {
    extern __shared__ __attribute__((aligned(16))) unsigned char lds[];
    Frame F;
    F.lds = (LAS unsigned char*)lds; F.MISC = (volatile LAS unsigned*)(F.lds + MISC_OFF);
    F.tid = threadIdx.x; F.lane = F.tid & 63; F.wave = __builtin_amdgcn_readfirstlane(F.tid >> 6);
    F.G = gridDim.x; { const int bx = blockIdx.x; F.vcu = (F.G % 8 == 0) ? (bx % 8) * (F.G / 8) + bx / 8 : bx; }
    F.a = &args; F.out = args.out; F.ws = args.ws; F.ctl = (unsigned*)(args.ws + WS_CTL);
#define REFRESH() do { unsigned t_ = threadIdx.x; asm volatile("" : "+v"(t_)); F.tid = (int)t_; F.lane = (int)(t_ & 63u); F.wave = __builtin_amdgcn_readfirstlane((int)(t_ >> 6)); \
        unsigned long long w_ = (unsigned long long)args.ws, o_ = (unsigned long long)args.out; asm volatile("" : "+s"(w_), "+s"(o_)); \
        F.ws = (unsigned char*)(__attribute__((address_space(1))) unsigned char*)w_; F.out = (float*)(__attribute__((address_space(1))) float*)o_; ws = F.ws;        \
        gwb = (int)blockIdx.x * NWAVES + F.wave; } while (0)
    for (int u = F.tid; u < (LDS_BYTES - MISC_OFF) / 4; u += NWAVES * 64) ((LAS unsigned*)(F.lds + MISC_OFF))[u] = 0u;
    __syncthreads();
#if !MK_PER_PHASE
    XcdBarrier bar = xcd_barrier_post(F.ctl + CW_BAR, F.MISC + 8);
    if (F.tid == 0) { const unsigned x = xb_xcc_id(); F.MISC[16] = xb_add(F.ctl + CW_RANK + 64 * (x & 7u), 1u); F.MISC[17] = x; }
#endif
    int cvirt = (int)blockIdx.x, vcu2 = F.vcu;
    const int lo = args.ph_lo, hi = args.ph_hi; int ph = 0;
    int gwb = blockIdx.x * NWAVES + F.wave; const int NGW = F.G * NWAVES;
    unsigned char* ws = F.ws;
#define IN() (ph >= lo && ph < hi)
#if MK_PER_PHASE
#define SEAM() do { ++ph; } while (0)
#else
#define SEAM() do { if (ph >= lo && ph + 1 < hi) xcd_barrier(bar); ++ph; } while (0)
#endif
    if (EN_P0 && IN()) for (int rp = 0; rp < REPS(0); ++rp) { REFRESH(); p0_prologue(F); __syncthreads(); }
    SEAM();
#if !MK_PER_PHASE
    if (lo == 0) {
        if (F.tid == 0) { bool ok = (F.G % 8) == 0; for (unsigned jx = 0; jx < 16; ++jx) { const unsigned c_ = xb_ld(F.ctl + CW_BAR + XB_XCNT(jx)); ok = ok && (c_ == (jx < 8 ? (unsigned)F.G / 8u : 0u)); } F.MISC[18] = ok ? 1u : 0u; }
        __syncthreads();
        if (F.MISC[18]) { const int rk = __builtin_amdgcn_readfirstlane((int)F.MISC[16]), xx = __builtin_amdgcn_readfirstlane((int)F.MISC[17]); cvirt = rk * 8 + xx; vcu2 = xx * (F.G / 8) + rk; }
    }
#endif
#pragma unroll 1
    for (int it = 0; it < 12; ++it) {
        const int L = it / 3, sub = it - 3 * L, j = L >> 1; const bool even = (L & 1) == 0;
#define MODL ((const float*)(ws + WS_MOD) + (size_t)L * 9 * NMODC)
        if (EN_ADALN && IN()) for (int rp = 0; rp < REPS(1); ++rp) { REFRESH(); adaln_phase(F, F.a->in[14] + (size_t)(L * 3 + sub) * D, MODL, 3 * sub, 3 * sub + 1); }
        SEAM();
        if (sub != 1) {
            if (EN_G1 && IN()) for (int rp = 0; rp < REPS(2); ++rp) { REFRESH(); const int f = sub >> 1;
                pg8::Gemm g{(const bf16*)(ws + WS_H), (const bf16*)(ws + WS_W1) + (size_t)(L * 2 + f) * 11264 * 2048, MT, 11264, 2048}; pg8::HalfOrder S; S.init(MT, 11264, F.G, cvirt); S.wgm = 6;
                EpiSwiGLU E{(bf16*)(ws + WS_ACT)};
                pg8::gemm_phase<EpiSwiGLU, pg8::HalfOrder, true, true>(F.lds, g, S, E); }
            SEAM();
        } else if (even) {
            if (EN_GAB && IN()) for (int rp = 0; rp < REPS(3); ++rp) { REFRESH(); pg8::Gemm g{(const bf16*)(ws + WS_H), (const bf16*)(ws + WS_WABI) + (size_t)j * 5120 * 2048, MT, 5120, 2048}; pg8::StaticOrder S; S.init(MT, 5120, F.G, cvirt);
                EpiAB E{(bf16*)(ws + WS_XAGA), (bf16*)(ws + WS_QB), (bf16*)(ws + WS_KB), (bf16*)(ws + WS_VT), F.out + O_NAK, F.out + O_NAV, j};
                pg8::gemm_phase<EpiAB, pg8::StaticOrder, true, true>(F.lds, g, S, E); }
            SEAM();
            if (EN_L1 && IN()) for (int rp = 0; rp < REPS(4); ++rp) { REFRESH(); LAS float* scr = (LAS float*)(F.lds + F.wave * SCR_PER_WAVE);
                for (int item = gwb; item < 192 * 16; item += NGW) lru_l1_item(F, j, item, scr); }
            SEAM();
            if (IN()) for (int rp = 0; rp < REPS(5); ++rp) { REFRESH();
                if (EN_NA) for (int grp = vcu2; grp < 8 * 16 * 4 * 2; grp += F.G) na_group(F, j, grp);
                if (EN_DP) for (int grp = vcu2; grp < 16 * 16; grp += F.G) { const int h = grp & 15, b = grp >> 4;
                    const bf16* K = (const bf16*)(ws + WS_KB) + (size_t)b * 256 * 1024 + h * 64; const bf16* V = (const bf16*)(ws + WS_VT) + ((size_t)b * 1024 + h * 64) * 256;
                    dense64_group<2>(F, (const bf16*)(ws + WS_QB), 1024, (size_t)b * 256, 32, 16, h * 64, 0, (bf16*)(ws + WS_YCAT), 1024 + h * 64, 0, K, V, 8, K, V, 0, 1024, 1024 * 256); }
                asm volatile("s_waitcnt vmcnt(0) lgkmcnt(0)" ::: "memory"); __syncthreads();
                if (EN_L3) for (int item = gwb; item < 192 * 32; item += NGW) lru_l3_item(F, j, item);
            }
            SEAM();
        } else {
            if (EN_GCD && IN()) for (int rp = 0; rp < REPS(6); ++rp) { REFRESH(); pg8::Gemm g{(const bf16*)(ws + WS_H), (const bf16*)(ws + WS_WCDI) + (size_t)j * 2816 * 2048, MT, 2816, 2048}; pg8::HalfOrder S; S.init(MT, 2816, F.G, cvirt);
                EpiPlain E{(bf16*)(ws + WS_RAW), 2816};
                pg8::gemm_phase<EpiPlain, pg8::HalfOrder, true, true>(F.lds, g, S, E); }
            SEAM();
            if (EN_POST && IN()) for (int rp = 0; rp < REPS(7); ++rp) { REFRESH(); cd_ctx_convert(F, j);
                for (int blk = (int)blockIdx.x; blk < MT / 64; blk += F.G) for (int i = 0; i < 8; ++i) cd_post_row(F, j, blk * 64 + F.wave * 8 + i); }
            SEAM();
            if (IN()) for (int rp = 0; rp < REPS(8); ++rp) { REFRESH();
                if (EN_GQD) { pg8::Gemm g{(const bf16*)(ws + WS_QA), (const bf16*)(ws + WS_WUQ) + (size_t)j * 1536 * 512, MT, 1536, 512}; pg8::HalfOrder S; S.init(MT, 1536, F.G, cvirt);
                  EpiQD E{(bf16*)(ws + WS_QD), (const float*)(ws + WS_ROPE)};
                  pg8::gemm_phase<EpiQD, pg8::HalfOrder, true, true>(F.lds, g, S, E); }
                if (EN_GKNV) { pg8::Gemm g{(const bf16*)(ws + WS_CKVALL) + (size_t)j * MKV * 512, (const bf16*)(ws + WS_WUKV) + (size_t)j * 2048 * 512, MKV, 2048, 512}; pg8::StaticOrder S; S.init(MKV, 2048, F.G, (int)(F.G - 1 - cvirt));
                  EpiKNV E{(bf16*)(ws + WS_KN), (bf16*)(ws + WS_VDT)};
                  pg8::gemm_phase<EpiKNV, pg8::StaticOrder, true, true>(F.lds, g, S, E); }
            }
            SEAM();
            if (IN()) for (int rp = 0; rp < REPS(9); ++rp) { REFRESH();
                const bf16* QG = (const bf16*)(ws + WS_QG); const bf16* KG = (const bf16*)(ws + WS_KG); const bf16* VGT = (const bf16*)(ws + WS_VGT); bf16* Y = (bf16*)(ws + WS_YCAT);
                if (EN_GQA) for (int grp = vcu2; grp < 8 * 4 * 8; grp += F.G) { const int tg = grp & 7, kvh = (grp >> 3) & 3, b = grp >> 5; const size_t srow = (size_t)MP + b * 1024;
                    dense64_group<4>(F, QG, 1024, srow + 128 * tg, 16, 0, kvh * 256, 64, Y, kvh * 256, 64,
                                     KG + srow * 256 + kvh * 64, VGT + ((srow >> 8) * 256 + kvh * 64) * 256, 32,
                                     (const bf16*)(ws + WS_KCG) + (size_t)(b * 2 + j) * 512 * 256 + kvh * 64, (const bf16*)(ws + WS_VTCG) + ((size_t)((b * 2 + j) * 2) * 256 + kvh * 64) * 256, 16, 256, 256 * 256); }
                if (EN_MLA) for (int grp = vcu2; grp < 8 * 8 * 8; grp += F.G) { const int qg = grp & 7, h = (grp >> 3) & 7, b = grp >> 6; const size_t srow = (size_t)MP + b * 1024;
                    mla_group(F, j, h, srow + 128 * qg, srow, 32, (size_t)MT + b * 512, 16); }
                if (EN_GQA) for (int grp = vcu2; grp < 16 * 4 * 2 * 2; grp += F.G) { const int hp = grp & 1, tg = (grp >> 1) & 1, kvh = (grp >> 2) & 3, b = grp >> 4; const size_t prow = (size_t)b * 256;
                    const bf16* K = KG + prow * 256 + kvh * 64; const bf16* V = VGT + ((size_t)b * 256 + kvh * 64) * 256;
                    dense64_group<2>(F, QG, 1024, prow + 128 * tg, 16, 0, kvh * 256 + hp * 128, 64, Y, kvh * 256 + hp * 128, 64, K, V, 8, K, V, 0, 256, 256 * 256); }
                if (EN_MLA) for (int grp = vcu2; grp < 16 * 8 * 2; grp += F.G) { const int qg = grp & 1, h = (grp >> 1) & 7, b = grp >> 4; const size_t prow = (size_t)b * 256;
                    mla_group(F, j, h, prow + 128 * qg, prow, 8, prow, 0); }
                asm volatile("s_waitcnt vmcnt(0) lgkmcnt(0)" ::: "memory"); __syncthreads();
            }
            SEAM();
        }
        if (EN_RES && IN() && (EN_MIXRES || sub != 1)) { REFRESH(); const bool ffn = sub != 1; const int f = sub >> 1;
            const bf16* A = ffn ? (const bf16*)(ws + WS_ACT) : (const bf16*)(ws + WS_YCAT);
            const bf16* Bt = ffn ? (const bf16*)(ws + WS_W2) + (size_t)(L * 2 + f) * 2048 * 5632 : (even ? (const bf16*)(ws + WS_WABO) : (const bf16*)(ws + WS_WCDO)) + (size_t)j * 2048 * 2048;
            pg8::Gemm g{A, Bt, MT, 2048, ffn ? DFF : 2048};
#if RES_TM == 192
            pg8::StaticOrder S; S.init_tm(MT, 2048, F.G, cvirt, 192);
            EpiResid192 E{(bf16*)(ws + WS_X), MODL + (3 * sub + 2) * 2048, ffn ? 0.5f : 1.0f};
            pg8::gemm_phase<EpiResid192, pg8::StaticOrder, true, true, 192>(F.lds, g, S, E); }
#else
            pg8::HalfOrder S; S.init(MT, 2048, F.G, cvirt);
            EpiResid E{(bf16*)(ws + WS_X), MODL + (3 * sub + 2) * 2048, ffn ? 0.5f : 1.0f};
            pg8::gemm_phase<EpiResid, pg8::HalfOrder, true, true>(F.lds, g, S, E); }
#endif
        SEAM();
    }
    if (EN_FINAL && IN()) for (int rp = 0; rp < REPS(10); ++rp) { REFRESH(); final_phase(F); }
#undef IN
#undef SEAM
}

extern "C" void kernel_launch(void* const* d_in, const int* in_sizes, int n_in, void* d_out, int out_size, void* d_ws, size_t ws_size, hipStream_t stream) {
    static int grid = 0;
    if (grid == 0) {
        if (n_in != 37 || (size_t)out_size != O_END || ws_size < WS_END) { fprintf(stderr, "kernel_launch: unexpected problem shape (n_in %d, out %d, ws %zu); nothing launched\n", n_in, out_size, ws_size); grid = -1; return; }
        int dev = 0, cus = 0;
        if (hipGetDevice(&dev) != hipSuccess || hipDeviceGetAttribute(&cus, hipDeviceAttributeMultiprocessorCount, dev) != hipSuccess) { grid = -1; return; }
        if (hipFuncSetAttribute((const void*)trunk_fwd, hipFuncAttributeMaxDynamicSharedMemorySize, LDS_BYTES) != hipSuccess) { fprintf(stderr, "kernel_launch: hipFuncSetAttribute failed\n"); grid = -1; return; }
        int per_cu = 0;
        if (hipOccupancyMaxActiveBlocksPerMultiprocessor(&per_cu, (const void*)trunk_fwd, NWAVES * 64, LDS_BYTES) != hipSuccess || per_cu < 1) { fprintf(stderr, "kernel_launch: occupancy query says %d blocks per CU\n", per_cu); }
        (void)hipGetLastError();
        grid = cus;
    }
    if (grid < 0) return;
    (void)hipMemsetAsync((char*)d_ws + WS_CTL, 0, CTL_ZERO_BYTES, stream);
    Args a{};
    for (int i = 0; i < 37; ++i) a.in[i] = (const float*)d_in[i];
    a.out = (float*)d_out; a.ws = (unsigned char*)d_ws;
#if MK_PER_PHASE
    for (int p = 0; p < N_PHASES; ++p) { a.ph_lo = p; a.ph_hi = p + 1; hipLaunchKernelGGL(trunk_fwd, dim3(grid), dim3(NWAVES * 64), LDS_BYTES, stream, a); }
#else
    a.ph_lo = 0; a.ph_hi = N_PHASES;
    hipLaunchKernelGGL(trunk_fwd, dim3(grid), dim3(NWAVES * 64), LDS_BYTES, stream, a);
#endif
}
```
